# Optimizing an MI355X kernel written in HIP

```python
import math
import jax, jax.numpy as jnp
from jax import lax
import numpy as np

D_MODEL = 1024
BATCH = 8
SEQ = 8192
DEPTH = 1
DEC_BATCH = 8
DEC_SEQ = 2048
PAST_LEN = 128

N_MEM = 256
HEAD_DIM = 64
D_HY = 384
N_ATT_HEADS = 6
D_ATT = N_ATT_HEADS * HEAD_DIM
N_MEM_HEADS = 4
D_MEM = N_MEM_HEADS * HEAD_DIM
D_MIX = D_HY + D_ATT + D_MEM
D_IN = 3 * D_HY + 3 * D_ATT + D_MEM + D_MIX
FILTER_BANDS = 16
FILTER_EMB = 1 + 2 * FILTER_BANDS
FILTER_HIDDEN = 64
DECAY_TARGET = 1e-2
FAST_DECAY_PCT = 0.3
SLOW_DECAY_PCT = 1.5
DILATED_CONFIGS = ((128, 1), (512, 4), (2048, 16))
N_BUCKETS = 32
MAX_DISTANCE = 1024
RMS_EPS = 1e-6
NEG_INF = -1e30

kernel_name = 'hymba_hyena_dilated_memxattn_encoder'


def rms_norm(x, g):
    x32 = x.astype(jnp.float32)
    y = x32 * lax.rsqrt(jnp.mean(x32 * x32, axis=-1, keepdims=True) + RMS_EPS) * g.astype(jnp.float32)
    return y.astype(x.dtype)


def head_rms(x, g):
    x32 = x.astype(jnp.float32)
    return x32 * lax.rsqrt(jnp.mean(x32 * x32, axis=-1, keepdims=True) + RMS_EPS) * g.astype(jnp.float32)


def short_conv3(z, w, b):
    zp = jnp.pad(z, ((0, 0), (1, 1), (0, 0)))
    return zp[:, :-2] * w[0] + zp[:, 1:-1] * w[1] + zp[:, 2:] * w[2] + b


def hyena_filter(L, w1, b1, freq, w2, b2, w3):
    f32 = jnp.float32
    pos = jnp.arange(L, dtype=f32)[:, None]
    t = pos / max(L - 1, 1)
    bands = jnp.linspace(1e-4, FILTER_BANDS - 1, FILTER_BANDS, dtype=f32)[None, :]
    ang = (2.0 * math.pi / L) * pos * bands
    feats = jnp.concatenate([t, jnp.cos(ang), -jnp.sin(ang)], axis=-1)
    fr = freq.astype(f32)
    h = jnp.sin(fr * (feats @ w1.astype(f32) + b1.astype(f32)))
    h = jnp.sin(fr * (h @ w2.astype(f32) + b2.astype(f32)))
    h = (h @ w3.astype(f32)).reshape(L, 2, D_HY)
    deltas = jnp.abs(jnp.linspace(math.log(DECAY_TARGET) / SLOW_DECAY_PCT,
                                  math.log(DECAY_TARGET) / FAST_DECAY_PCT, D_HY, dtype=f32))
    h = h * jnp.exp(-t * deltas)[:, None, :]
    fwd, bwd = h[:, 0], h[:, 1]
    k = jnp.concatenate([fwd[:1] + bwd[:1], fwd[1:], jnp.zeros((1, D_HY), f32), bwd[:0:-1]], axis=0)
    return k * lax.rsqrt(jnp.sum(k * k, axis=0, keepdims=True) + 1e-12)


def hyena_branch(z_hy, conv_w, conv_b, w1, b1, freq, w2, b2, w3, skip):
    B, L, _ = z_hy.shape
    u = short_conv3(z_hy.astype(jnp.float32), conv_w.astype(jnp.float32), conv_b.astype(jnp.float32))
    x0, x1, v = jnp.split(u, 3, axis=-1)
    s = x1 * v
    k = hyena_filter(L, w1, b1, freq, w2, b2, w3)
    S = jnp.fft.rfft(s, n=2 * L, axis=1)
    K = jnp.fft.rfft(k, axis=0)
    conv = jnp.fft.irfft(S * K[None], n=2 * L, axis=1)[:, :L]
    return x0 * (conv + s * skip.astype(jnp.float32))


def t5_bucket(rel):
    half = N_BUCKETS // 2
    max_exact = half // 2
    ret = jnp.where(rel > 0, half, 0)
    n = jnp.abs(rel)
    large = max_exact + (jnp.log(jnp.maximum(n, 1).astype(jnp.float32) / max_exact)
                         / math.log(MAX_DISTANCE / max_exact) * (half - max_exact)).astype(jnp.int32)
    large = jnp.minimum(large, half - 1)
    return ret + jnp.where(n < max_exact, n, large)


def dilated_attention(q, k, v, rel_bias):
    B, L, H, E = q.shape
    scale = E ** -0.5
    outs, lses = [], []
    for window, dil in DILATED_CONFIGS:
        R = window // (2 * dil)
        blk = R
        n = L // dil
        nblk = -(-n // blk)
        pad = nblk * blk - n

        def to_blocks(a):
            a = a.reshape(B, n, dil, H, E).transpose(0, 2, 1, 3, 4)
            a = jnp.pad(a, ((0, 0), (0, 0), (0, pad), (0, 0), (0, 0)))
            return a.reshape(B, dil, nblk, blk, H, E)

        def band(a):
            ap = jnp.pad(a, ((0, 0), (0, 0), (1, 1), (0, 0), (0, 0), (0, 0)))
            return jnp.concatenate([ap[:, :, :-2], ap[:, :, 1:-1], ap[:, :, 2:]], axis=3)

        def from_blocks(a):
            a = a.reshape((B, dil, nblk * blk) + a.shape[4:])[:, :, :n]
            a = jnp.moveaxis(a, 1, 2)
            return a.reshape((B, L) + a.shape[3:])

        qb = to_blocks(q)
        kb = band(to_blocks(k))
        vb = band(to_blocks(v))
        qi = jnp.arange(blk)[:, None]
        kj = jnp.arange(3 * blk)[None, :]
        rel = kj - blk - qi
        kpos = jnp.arange(nblk)[:, None, None] * blk - blk + kj[None]
        valid = (jnp.abs(rel) <= R)[None] & (kpos >= 0) & (kpos < n)
        bias = rel_bias[t5_bucket(rel * dil)].astype(jnp.float32).transpose(2, 0, 1)
        logits = jnp.einsum('bdnqhe,bdnkhe->bdnhqk', qb, kb) * scale + bias
        logits = jnp.where(valid[None, None, :, None], logits, NEG_INF)
        m = jnp.max(logits, axis=-1, keepdims=True)
        p = jnp.exp(logits - m)
        s = jnp.sum(p, axis=-1, keepdims=True)
        o = jnp.einsum('bdnhqk,bdnkhe->bdnqhe', p, vb) / jnp.swapaxes(s, 3, 4)
        lse = jnp.swapaxes((m + jnp.log(s))[..., 0], 3, 4)
        outs.append(from_blocks(o))
        lses.append(from_blocks(lse))
    wts = jax.nn.softmax(jnp.stack(lses, axis=0), axis=0)
    return jnp.sum(wts[..., None] * jnp.stack(outs, axis=0), axis=0)


def memory_attention(qm, mem, mem_norm, w_mem_kv, k_gain):
    B, M, _ = mem.shape
    kv = (rms_norm(mem, mem_norm) @ w_mem_kv).reshape(B, M, 2, N_MEM_HEADS, HEAD_DIM)
    km = head_rms(kv[:, :, 0], k_gain)
    vm = kv[:, :, 1].astype(jnp.float32)
    logits = jnp.einsum('blhe,bmhe->bhlm', qm, km) * (HEAD_DIM ** -0.5)
    p = jax.nn.softmax(logits, axis=-1)
    return jnp.einsum('bhlm,bmhe->blhe', p, vm)


def encoder_layer(x, mem, norm_in, w_in, hy_conv_w, hy_conv_b, hy_filt_w1, hy_filt_b1, hy_filt_freq,
                  hy_filt_w2, hy_filt_b2, hy_filt_w3, hy_skip, att_q_norm, att_k_norm,
                  mem_norm, w_mem_kv, mem_q_norm, mem_k_norm, w_out, rel_bias):
    B, L, _ = x.shape
    h = rms_norm(x, norm_in)
    z = h @ w_in
    i0 = 3 * D_HY
    i1 = i0 + 3 * D_ATT
    i2 = i1 + D_MEM
    z_hy, z_att, z_mq, gate = z[..., :i0], z[..., i0:i1], z[..., i1:i2], z[..., i2:]
    y_hy = hyena_branch(z_hy, hy_conv_w, hy_conv_b, hy_filt_w1, hy_filt_b1, hy_filt_freq,
                        hy_filt_w2, hy_filt_b2, hy_filt_w3, hy_skip)
    qkv = z_att.reshape(B, L, 3, N_ATT_HEADS, HEAD_DIM)
    q = head_rms(qkv[:, :, 0], att_q_norm)
    k = head_rms(qkv[:, :, 1], att_k_norm)
    v = qkv[:, :, 2].astype(jnp.float32)
    y_att = dilated_attention(q, k, v, rel_bias).reshape(B, L, D_ATT)
    qm = head_rms(z_mq.reshape(B, L, N_MEM_HEADS, HEAD_DIM), mem_q_norm)
    y_mem = memory_attention(qm, mem, mem_norm, w_mem_kv, mem_k_norm).reshape(B, L, D_MEM)
    mixed = jnp.concatenate([y_hy, y_att, y_mem], axis=-1) * jax.nn.silu(gate.astype(jnp.float32))
    return x + mixed.astype(x.dtype) @ w_out


def setup_inputs(seed: int = 0) -> dict:
    key = jax.random.key(seed)
    ks = jax.random.split(key, 24)
    f32 = jnp.float32
    nrm = lambda k, shape, s: jax.random.normal(k, shape, f32) * s
    gain = lambda k, shape: 1.0 + 0.02 * jax.random.normal(k, shape, f32)
    return {
        'x_prompt': jax.random.normal(ks[0], (BATCH, SEQ, D_MODEL), f32),
        'x_sample': jax.random.normal(ks[1], (DEC_BATCH, DEC_SEQ, D_MODEL), f32),
        'mem_prompt': jax.random.normal(ks[2], (BATCH, N_MEM, D_MODEL), f32),
        'mem_sample': jax.random.normal(ks[3], (DEC_BATCH, N_MEM, D_MODEL), f32),
        'norm_in': gain(ks[4], (DEPTH, D_MODEL)),
        'w_in': nrm(ks[5], (DEPTH, D_MODEL, D_IN), D_MODEL ** -0.5),
        'hy_conv_w': nrm(ks[6], (DEPTH, 3, 3 * D_HY), 3 ** -0.5),
        'hy_conv_b': nrm(ks[7], (DEPTH, 3 * D_HY), 0.02),
        'hy_filt_w1': nrm(ks[8], (DEPTH, FILTER_EMB, FILTER_HIDDEN), FILTER_EMB ** -0.5),
        'hy_filt_b1': nrm(ks[9], (DEPTH, FILTER_HIDDEN), 0.02),
        'hy_filt_freq': gain(ks[10], (DEPTH, FILTER_HIDDEN)),
        'hy_filt_w2': nrm(ks[11], (DEPTH, FILTER_HIDDEN, FILTER_HIDDEN), FILTER_HIDDEN ** -0.5),
        'hy_filt_b2': nrm(ks[12], (DEPTH, FILTER_HIDDEN), 0.02),
        'hy_filt_w3': nrm(ks[13], (DEPTH, FILTER_HIDDEN, 2 * D_HY), FILTER_HIDDEN ** -0.5),
        'hy_skip': nrm(ks[14], (DEPTH, D_HY), 1.0),
        'att_q_norm': gain(ks[15], (DEPTH, HEAD_DIM)),
        'att_k_norm': gain(ks[16], (DEPTH, HEAD_DIM)),
        'mem_norm': gain(ks[17], (DEPTH, D_MODEL)),
        'w_mem_kv': nrm(ks[18], (DEPTH, D_MODEL, 2 * D_MEM), D_MODEL ** -0.5),
        'mem_q_norm': gain(ks[19], (DEPTH, HEAD_DIM)),
        'mem_k_norm': gain(ks[20], (DEPTH, HEAD_DIM)),
        'w_out': nrm(ks[21], (DEPTH, D_MIX, D_MODEL), D_MIX ** -0.5),
        'rel_bias': nrm(ks[22], (N_BUCKETS, N_ATT_HEADS), 0.1),
    }


def reference(x_prompt, x_sample, mem_prompt, mem_sample, norm_in, w_in, hy_conv_w, hy_conv_b,
              hy_filt_w1, hy_filt_b1, hy_filt_freq, hy_filt_w2, hy_filt_b2, hy_filt_w3, hy_skip,
              att_q_norm, att_k_norm, mem_norm, w_mem_kv, mem_q_norm, mem_k_norm, w_out, rel_bias):
    def trunk(x, mem):
        for l in range(DEPTH):
            x = encoder_layer(x, mem, norm_in[l], w_in[l], hy_conv_w[l], hy_conv_b[l],
                              hy_filt_w1[l], hy_filt_b1[l], hy_filt_freq[l], hy_filt_w2[l],
                              hy_filt_b2[l], hy_filt_w3[l], hy_skip[l], att_q_norm[l], att_k_norm[l],
                              mem_norm[l], w_mem_kv[l], mem_q_norm[l], mem_k_norm[l], w_out[l], rel_bias)
        return x

    y_prompt = trunk(x_prompt, mem_prompt)
    y_sample = trunk(x_sample, mem_sample)
    return (y_prompt, y_sample)
```

```cpp
#include <hip/hip_runtime.h>
#include <cstdio>
#include <cstdint>
namespace pg8 {
#define PG8_LAS __attribute__((address_space(3)))
typedef unsigned short bf16_t;
typedef short bf16x8 __attribute__((ext_vector_type(8)));
typedef float f32x4 __attribute__((ext_vector_type(4)));
typedef unsigned u32x4 __attribute__((ext_vector_type(4)));
constexpr int BM = 256, BK = 64, HALF = 128, HTB = HALF * BK * 2  , STAGE_BYTES = 8 * HTB, NXCD = 8, WGM = 8;

__host__ __device__ __forceinline__ int lds_byte(int r, int c) { const int st = (r >> 4) * 2 + (c >> 5), rr = r & 15, cc = c & 31, ob = rr * 64 + cc * 2; return st * 1024 + (ob ^ (((ob >> 9) & 1) << 5)); }
__host__ __device__ __forceinline__ void stage_rc(int b, int& R, int& C) { const int st = b / 1024, sb = b % 1024, swz = sb ^ (((sb >> 9) & 1) << 5); R = (st >> 1) * 16 + swz / 64; C = (st & 1) * 32 + (swz % 64) / 2; }
__host__ __device__ __forceinline__ int perm32(int rho) { const int n = rho >> 4, i = rho & 15; return 8 * (i >> 2) + 4 * n + (i & 3); }

struct Unit { int pm, pn; };
struct Gemm { const bf16_t* A; const bf16_t* Bt; int M, N, K; };

struct StaticOrder {
    int nM, nN, nwg, G, c;
    __host__ __device__ void init(int M, int N, int G_, int c_) { nM = M / BM; nN = N / BM; nwg = nM * nN; G = G_; c = c_; }
    __host__ __device__ bool next(int i, Unit& u) const {
        const long L = (long)i * G + c; if (L >= nwg) return false;
        int wgid = (int)L; { const int q = nwg / NXCD, r = nwg % NXCD, xcd = wgid % NXCD, off = wgid / NXCD; wgid = (xcd < r ? xcd * (q + 1) : r * (q + 1) + (xcd - r) * q) + off; }
        const int nig = WGM * nN, gid = wgid / nig, fm = gid * WGM, gsz = (nM - fm) < WGM ? (nM - fm) : WGM;
        u.pm = fm + ((wgid % nig) % gsz); u.pn = (wgid % nig) / gsz; return true;
    }
    __device__ __forceinline__ void a_ready(const Unit&) const {}
    __device__ __forceinline__ void done(const Unit&) const {}
};

__device__ __forceinline__ unsigned cvt_pk_bf16(float lo, float hi) { unsigned r; asm volatile("v_cvt_pk_bf16_f32 %0, %1, %2" : "=v"(r) : "v"(lo), "v"(hi)); return r; }
typedef float f32x2 __attribute__((ext_vector_type(2)));
template <class Epi, class Sched, bool ALIGN_EPI = false, bool SP2 = false>
__device__ __forceinline__ void gemm_phase(PG8_LAS unsigned char* lds, const Gemm g, const Sched& S, const Epi& E) {
    const int tid = threadIdx.x, wid = __builtin_amdgcn_readfirstlane(tid >> 6), lane = tid & 63, wr = wid >> 2, wc = wid & 3, fr = lane & 15, fq = lane >> 4;
    const int K = g.K, nt = K / BK;
    unsigned voffA[2], voffB[2];
#pragma unroll
    for (int i = 0; i < 2; ++i) { int R, C; stage_rc(tid * 16 + i * 8192, R, C); const int Rb = Epi::PERM ? ((R & ~31) + perm32(R & 31)) : R;
        voffA[i] = (unsigned)(R * K + C) * 2u; voffB[i] = (unsigned)(Rb * K + C) * 2u; }
    const size_t kstep = (size_t)(BK * 2);
    const size_t hstep = (size_t)HALF * K * 2;
    const size_t tstep = 2 * hstep;
    const unsigned ldsw = (unsigned)wid * 1024u;
    const int aoff = lds_byte(wr * 64 + fr, fq * 8), boff = lds_byte(wc * 32 + fr, fq * 8);
#define PG8_SA(b, h) (((b) * 2 + (h)) * HTB)
#define PG8_SB(b, h) ((4 + (b) * 2 + (h)) * HTB)
#define PG8_STAGE(bufoff, gbase, voff) do { _Pragma("unroll") for (int _i = 0; _i < 2; ++_i) \
        __builtin_amdgcn_global_load_lds((const unsigned*)((const char*)(gbase) + (voff)[_i]), (PG8_LAS unsigned*)(lds + (bufoff) + ldsw + _i * 8192), 16, 0, 0); } while (0)
#define PG8_LDA(dst, b, h) do { _Pragma("unroll") for (int m = 0; m < 4; ++m) _Pragma("unroll") for (int k = 0; k < 2; ++k) dst[m][k] = *(const PG8_LAS bf16x8*)(lds + PG8_SA(b, h) + aoff + m * 2048 + k * 1024); } while (0)
#define PG8_LDB(dst, b, h) do { _Pragma("unroll") for (int n = 0; n < 2; ++n) _Pragma("unroll") for (int k = 0; k < 2; ++k) dst[n][k] = *(const PG8_LAS bf16x8*)(lds + PG8_SB(b, h) + boff + n * 2048 + k * 1024); } while (0)
#define PG8_MMA(ai, bj, At, Bt) do { __builtin_amdgcn_s_setprio(1); _Pragma("unroll") for (int m = 0; m < 4; ++m) _Pragma("unroll") for (int n = 0; n < 2; ++n) _Pragma("unroll") for (int k = 0; k < 2; ++k) \
        acc[ai][bj][m][n] = __builtin_amdgcn_mfma_f32_16x16x32_bf16(Bt[n][k], At[m][k], acc[ai][bj][m][n], 0, 0, 0); __builtin_amdgcn_s_setprio(0); } while (0)
#define PG8_WAIT_V(n) asm volatile("s_waitcnt vmcnt(" #n ")" ::: "memory")
#define PG8_WAIT_L(n) asm volatile("s_waitcnt lgkmcnt(" #n ")" ::: "memory")
#define PG8_BAR __builtin_amdgcn_s_barrier()
#define PG8_SCHED __builtin_amdgcn_sched_barrier(0)
    Unit cur, nxt; int ui = 0;
    if (!S.next(0, cur)) return;
    f32x4 acc[2][2][4][2];
#pragma unroll
    for (int a = 0; a < 2; ++a)
#pragma unroll
        for (int b = 0; b < 2; ++b)
#pragma unroll
            for (int m = 0; m < 4; ++m)
#pragma unroll
                for (int n = 0; n < 2; ++n) acc[a][b][m][n] = (f32x4){0.f, 0.f, 0.f, 0.f};
    bf16x8 At[4][2], B0[2][2], B1[2][2];
    const char* cA = (const char*)g.A + (size_t)cur.pm * tstep; const char* cB = (const char*)g.Bt + (size_t)cur.pn * tstep;
    S.a_ready(cur);
    if constexpr (SP2) {
        PG8_STAGE(PG8_SB(0, 0), cB, voffB); PG8_STAGE(PG8_SB(0, 1), cB + hstep, voffB); PG8_STAGE(PG8_SA(0, 0), cA, voffA); PG8_STAGE(PG8_SA(0, 1), cA + hstep, voffA);
        if (wr == 1) PG8_BAR;
        PG8_WAIT_V(2); PG8_BAR;
        PG8_STAGE(PG8_SB(1, 0), cB + kstep, voffB); PG8_STAGE(PG8_SA(1, 0), cA + kstep, voffA); PG8_STAGE(PG8_SB(1, 1), cB + hstep + kstep, voffB);
        PG8_WAIT_V(6); PG8_BAR;
    } else {
        PG8_STAGE(PG8_SB(0, 0), cB, voffB); PG8_STAGE(PG8_SA(0, 0), cA, voffA); PG8_STAGE(PG8_SB(0, 1), cB + hstep, voffB); PG8_STAGE(PG8_SA(0, 1), cA + hstep, voffA);
        if (wr == 1) PG8_BAR;
        PG8_WAIT_V(4); PG8_BAR;
        PG8_STAGE(PG8_SB(1, 0), cB + kstep, voffB); PG8_STAGE(PG8_SA(1, 0), cA + kstep, voffA); PG8_STAGE(PG8_SB(1, 1), cB + hstep + kstep, voffB);
        PG8_WAIT_V(6); PG8_BAR;
    }
    for (;;) {
        const bool has_next = S.next(ui + 1, nxt);
        const char* nA = has_next ? (const char*)g.A + (size_t)nxt.pm * tstep : cA; const char* nB = has_next ? (const char*)g.Bt + (size_t)nxt.pn * tstep : cB;
        for (int t = 0; t < nt; t += 2) {
            const bool last = (t == nt - 2);
            const char* a1 = cA + (size_t)(t + 1) * kstep;
            const char* a2 = last ? nA : cA + (size_t)(t + 2) * kstep; const char* b2 = last ? nB : cB + (size_t)(t + 2) * kstep;
            const char* a3 = a2 + kstep; const char* b3 = b2 + kstep;
            if (last && has_next) S.a_ready(nxt);
            if constexpr (SP2) {
            PG8_LDB(B0, 0, 0); PG8_LDB(B1, 0, 1); PG8_SCHED; PG8_LDA(At, 0, 0); PG8_STAGE(PG8_SA(1, 1), a1 + hstep, voffA);
            PG8_WAIT_V(8); PG8_WAIT_L(0); PG8_BAR; PG8_MMA(0, 0, At, B0); PG8_MMA(0, 1, At, B1); PG8_BAR; PG8_SCHED;
            PG8_LDA(At, 0, 1); PG8_STAGE(PG8_SB(0, 0), b2, voffB); PG8_STAGE(PG8_SB(0, 1), b2 + hstep, voffB); PG8_STAGE(PG8_SA(0, 0), a2, voffA);
            PG8_WAIT_V(8); PG8_WAIT_L(0); PG8_BAR; PG8_MMA(1, 0, At, B0); PG8_MMA(1, 1, At, B1); PG8_BAR; PG8_SCHED;
            PG8_LDB(B0, 1, 0); PG8_LDB(B1, 1, 1); PG8_SCHED; PG8_LDA(At, 1, 0); PG8_STAGE(PG8_SA(0, 1), a2 + hstep, voffA);
            PG8_WAIT_V(8); PG8_WAIT_L(0); PG8_BAR; PG8_MMA(0, 0, At, B0); PG8_MMA(0, 1, At, B1); PG8_BAR; PG8_SCHED;
            PG8_LDA(At, 1, 1); PG8_STAGE(PG8_SB(1, 0), b3, voffB); PG8_STAGE(PG8_SB(1, 1), b3 + hstep, voffB); PG8_STAGE(PG8_SA(1, 0), a3, voffA);
            PG8_WAIT_V(8); PG8_WAIT_L(0); PG8_BAR; PG8_MMA(1, 0, At, B0); PG8_MMA(1, 1, At, B1); PG8_BAR; PG8_SCHED;
            } else {
            PG8_LDB(B0, 0, 0); PG8_SCHED; PG8_LDA(At, 0, 0); PG8_STAGE(PG8_SA(1, 1), a1 + hstep, voffA);
            PG8_WAIT_L(8); PG8_BAR; PG8_WAIT_L(0); PG8_MMA(0, 0, At, B0); PG8_BAR; PG8_SCHED;
            PG8_LDB(B1, 0, 1); PG8_STAGE(PG8_SB(0, 0), b2, voffB);
            PG8_BAR; PG8_WAIT_L(0); PG8_MMA(0, 1, At, B1); PG8_BAR;
            PG8_LDA(At, 0, 1); PG8_STAGE(PG8_SA(0, 0), a2, voffA);
            PG8_BAR; PG8_WAIT_L(0); PG8_MMA(1, 0, At, B0); PG8_BAR; PG8_SCHED;
            PG8_STAGE(PG8_SB(0, 1), b2 + hstep, voffB);
            PG8_WAIT_V(6); PG8_BAR; PG8_MMA(1, 1, At, B1); PG8_BAR;
            PG8_LDB(B0, 1, 0); PG8_SCHED; PG8_LDA(At, 1, 0); PG8_STAGE(PG8_SA(0, 1), a2 + hstep, voffA);
            PG8_WAIT_L(8); PG8_BAR; PG8_WAIT_L(0); PG8_MMA(0, 0, At, B0); PG8_BAR; PG8_SCHED;
            PG8_LDB(B1, 1, 1); PG8_STAGE(PG8_SB(1, 0), b3, voffB);
            PG8_BAR; PG8_WAIT_L(0); PG8_MMA(0, 1, At, B1); PG8_BAR;
            PG8_LDA(At, 1, 1); PG8_STAGE(PG8_SA(1, 0), a3, voffA);
            PG8_BAR; PG8_WAIT_L(0); PG8_MMA(1, 0, At, B0); PG8_BAR; PG8_SCHED;
            PG8_STAGE(PG8_SB(1, 1), b3 + hstep, voffB);
            PG8_WAIT_V(6); PG8_BAR; PG8_MMA(1, 1, At, B1); PG8_BAR;
            }
        }
        if constexpr (ALIGN_EPI) { if (wr == 0) PG8_BAR; }
        if constexpr (!Epi::AFTER_DRAIN) { E(acc, cur, wr, wc, fr, fq); S.done(cur); }
        if (!has_next) break;
#pragma unroll
        for (int a = 0; a < 2; ++a)
#pragma unroll
            for (int b = 0; b < 2; ++b)
#pragma unroll
                for (int m = 0; m < 4; ++m)
#pragma unroll
                    for (int n = 0; n < 2; ++n) acc[a][b][m][n] = (f32x4){0.f, 0.f, 0.f, 0.f};
        cur = nxt; cA = nA; cB = nB; ++ui;
        if constexpr (ALIGN_EPI) { if (wr == 1) PG8_BAR; }
    }
    PG8_WAIT_V(0);
    if constexpr (!ALIGN_EPI) { if (wr == 0) PG8_BAR; }
    PG8_BAR;
    if constexpr (Epi::AFTER_DRAIN) { E.fused(acc, cur, wr, wc, fr, fq, lds, wid, lane); S.done(cur); }
#undef PG8_SA
#undef PG8_SB
#undef PG8_STAGE
#undef PG8_LDA
#undef PG8_LDB
#undef PG8_MMA
#undef PG8_WAIT_V
#undef PG8_WAIT_L
#undef PG8_BAR
#undef PG8_SCHED
}
}

#define GAS __attribute__((address_space(1)))
#define LAS __attribute__((address_space(3)))
typedef unsigned short bf16;
typedef unsigned v4u __attribute__((ext_vector_type(4)));
typedef float f32x4 __attribute__((ext_vector_type(4)));
typedef short bf16x8 __attribute__((ext_vector_type(8)));
typedef GAS unsigned gu32;
typedef GAS unsigned long long gu64;
#define RLX_AGENT __ATOMIC_RELAXED, __HIP_MEMORY_SCOPE_AGENT
#define LDS_WAIT() asm volatile("s_waitcnt lgkmcnt(0)" ::: "memory")
#define VM_WAIT() asm volatile("s_waitcnt vmcnt(0)" ::: "memory")
__device__ __forceinline__ unsigned long long rt() { return __builtin_amdgcn_s_memrealtime(); }
__device__ __forceinline__ unsigned f2bf(float f) { unsigned u = __builtin_bit_cast(unsigned, f); return (u + 0x7fffu + ((u >> 16) & 1u)) >> 16; }
__device__ __forceinline__ unsigned pk2(float lo, float hi) { return f2bf(lo) | (f2bf(hi) << 16); }

#define XB_TMO      128
#define XB_XCNT(j)  (256  + 64 * (j))
#define XB_XSUB(j)  (1280 + 64 * (j))
#define XB_XGEN(j)  (2304 + 64 * (j))
#define XB_TOP      3328
#define XB_TOPGEN   3392
#define XCD_BAR_WORDS 3456
#define XB_SPIN_CAP (1u << 18)

__device__ __forceinline__ unsigned xb_ld(unsigned* p)              { return __hip_atomic_load(p, __ATOMIC_RELAXED, __HIP_MEMORY_SCOPE_AGENT); }
__device__ __forceinline__ unsigned xb_add(unsigned* p, unsigned v) { return __hip_atomic_fetch_add(p, v, __ATOMIC_RELAXED, __HIP_MEMORY_SCOPE_AGENT); }
__device__ __forceinline__ unsigned xb_xcc_id() { return (unsigned)__builtin_amdgcn_s_getreg((3 << 11) | 20) & 0xFu; }
#define XB_SPIN(cond, bar) do { unsigned _sp = 0; while (cond) { __builtin_amdgcn_s_sleep(1); \
    if ((++_sp & 255u) == 0u) { if (xb_ld(&(bar)[XB_TMO])) break; if (_sp > XB_SPIN_CAP) { atomicAdd(&(bar)[XB_TMO], 1u); break; } } } } while (0)

struct XcdBarrier {
    unsigned* bar; unsigned x;
    volatile LAS unsigned* st;
};

__device__ __forceinline__ XcdBarrier xcd_barrier_post(unsigned* bar, volatile LAS unsigned* st) {
    XcdBarrier b; b.bar = bar; b.x = xb_xcc_id(); b.st = st;
    if (threadIdx.x == 0) (void)xb_add(&bar[XB_XCNT(b.x)], 1u);
    return b;
}
__device__ __forceinline__ void xcd_barrier_complete(unsigned* bar, unsigned x, unsigned& nloc, unsigned& nx) {
    const unsigned G = gridDim.x * gridDim.y * gridDim.z;
    unsigned sum, cnt, mine, sp = 0u;
    for (;;) {
        sum = 0u; cnt = 0u; mine = 0u;
#pragma unroll
        for (unsigned j = 0; j < 16; ++j) { const unsigned c = xb_ld(&bar[XB_XCNT(j)]); sum += c; cnt += (c > 0u) ? 1u : 0u; mine = (j == x) ? c : mine; }
        if (sum == G) break;
        __builtin_amdgcn_s_sleep(1);
        if ((++sp & 255u) == 0u) { if (xb_ld(&bar[XB_TMO])) break; if (sp > XB_SPIN_CAP) { atomicAdd(&bar[XB_TMO], 1u); break; } }
    }
    nloc = mine > 0u ? mine : 1u; nx = cnt > 0u ? cnt : 1u;
}

__device__ __forceinline__ void xcd_barrier(const XcdBarrier& b) {
    asm volatile("s_waitcnt vmcnt(0)" ::: "memory");
    __syncthreads();
    if (threadIdx.x == 0) {
        unsigned* bar = b.bar;
        __builtin_amdgcn_s_waitcnt(0);
        unsigned nloc = b.st[0], nx = b.st[1];
        if (nloc == 0u) { xcd_barrier_complete(bar, b.x, nloc, nx); b.st[0] = nloc; b.st[1] = nx; }
        const unsigned old = xb_add(&bar[XB_XSUB(b.x)], 1u);
        const unsigned gen = old / nloc;
        if (old + 1u == (gen + 1u) * nloc) {
            __builtin_amdgcn_fence(__ATOMIC_RELEASE, "agent");
            asm volatile("s_waitcnt vmcnt(0)" ::: "memory");
            const unsigned og = xb_add(&bar[XB_TOP], 1u);
            const unsigned tg = og / nx;
            if (og + 1u == (tg + 1u) * nx) xb_add(&bar[XB_TOPGEN], 1u);
            else XB_SPIN(xb_ld(&bar[XB_TOPGEN]) == tg, bar);
            __builtin_amdgcn_fence(__ATOMIC_ACQUIRE, "agent");
            xb_add(&bar[XB_XGEN(b.x)], 1u);
            asm volatile("s_waitcnt vmcnt(0)" ::: "memory");
        } else {
            XB_SPIN(xb_ld(&bar[XB_XGEN(b.x)]) == gen, bar);
            __builtin_amdgcn_fence(__ATOMIC_ACQUIRE, "agent");
            asm volatile("s_waitcnt vmcnt(0)" ::: "memory");
        }
    }
    __syncthreads();
}


constexpr int NWAVES = 8;
#ifndef MK_N_LAUNCHES
#define MK_N_LAUNCHES 6
#endif
constexpr int PER_PHASE = 6;
constexpr int N_LAUNCHES = MK_N_LAUNCHES;

constexpr int DM = 1024, DIN = 3584, LP = 8192, LS = 2048, NBATCH = 8;
constexpr int MP = NBATCH * LP, MS = NBATCH * LS, MT = MP + MS;
constexpr int DHY = 384, NH = 6, NHM = 4, HD = 64, NMEM = 256, DMKV = 512;
constexpr int MMEM = 2 * NBATCH * NMEM;
constexpr float RMS_EPS = 1e-6f;

constexpr size_t MiB = 1u << 20;
constexpr size_t WS_CTL = 0, CTL_ZERO_BYTES = 1 * MiB;
constexpr size_t WS_WTIN = 2 * MiB;
constexpr size_t WS_WTOUT = 10 * MiB;
constexpr size_t WS_WTMKV = 12 * MiB;
constexpr size_t WS_MEMB = 13 * MiB;
constexpr size_t WS_KM = 21 * MiB;
constexpr size_t WS_VM = 23 * MiB;
constexpr size_t WS_H2P = 25 * MiB;
constexpr size_t WS_H2S = 27 * MiB;
constexpr size_t WS_BIAS = 28 * MiB;
constexpr size_t WS_GAINS = 28 * MiB + 65536;
constexpr size_t WS_KSP = 29 * MiB;
constexpr size_t WS_KSS = 77 * MiB;
constexpr size_t WS_XB = 90 * MiB;
constexpr size_t WS_ST = 90 * MiB;
constexpr size_t WS_CT = 150 * MiB;
constexpr size_t WS_ZHY = 250 * MiB;
constexpr size_t WS_Q = 430 * MiB, WS_K = 490 * MiB, WS_V = 550 * MiB;
constexpr size_t WS_MQ = 610 * MiB;
constexpr size_t WS_MIX = 650 * MiB;
constexpr size_t WS_END = 810 * MiB;
static_assert(WS_VM - WS_KM >= (size_t)16 * 4 * 256 * 64 * 2 && WS_H2P - WS_VM >= (size_t)16 * 4 * 256 * 64 * 2 && WS_KSS - WS_KSP >= (size_t)384 * 2 * 8192 * 8 && WS_XB - WS_KSS >= (size_t)384 * 2 * 2048 * 8, "ws map");
static_assert(WS_ZHY - WS_XB >= (size_t)81920 * 1024 * 2 && WS_CT - WS_ST >= (size_t)81920 * 384 * 2 && WS_ZHY - WS_CT >= (size_t)81920 * 384 * 2 && WS_Q - WS_ZHY >= (size_t)81920 * 1152 * 2, "ws map");
static_assert(WS_K - WS_Q >= (size_t)81920 * 384 * 2 && WS_MQ - WS_V >= (size_t)81920 * 384 * 2 && WS_MIX - WS_MQ >= (size_t)81920 * 256 * 2 && WS_END - WS_MIX >= (size_t)81920 * 1024 * 2, "ws map");
constexpr int CW_TMO = 0, CW_CODE = 1, CW_BAR = 4096;

constexpr int RING_OFF = 0, RING_BYTES = 131072;
constexpr int LDSCTL_OFF = RING_BYTES, MISC_OFF = LDSCTL_OFF + 320;
constexpr int LDS_BYTES = 147456;

typedef float cf2 __attribute__((ext_vector_type(2)));
typedef unsigned u32x2 __attribute__((ext_vector_type(2)));

__device__ __forceinline__ float bf2f(unsigned short h) { return __builtin_bit_cast(float, (unsigned)h << 16); }
__device__ __forceinline__ float bflo(unsigned w) { return __builtin_bit_cast(float, w << 16); }
__device__ __forceinline__ float bfhi(unsigned w) { return __builtin_bit_cast(float, w & 0xffff0000u); }
__device__ __forceinline__ cf2 cmul(cf2 a, cf2 b) { return (cf2){a.x * b.x - a.y * b.y, a.x * b.y + a.y * b.x}; }
__device__ __forceinline__ cf2 cmulc(cf2 a, cf2 b) { return (cf2){a.x * b.x + a.y * b.y, a.y * b.x - a.x * b.y}; }

__device__ __forceinline__ int bb_rowbase(int bb) { return bb < 8 ? bb * LP : MP + (bb - 8) * LS; }
__device__ __forceinline__ int bb_len(int bb) { return bb < 8 ? LP : LS; }
__device__ __forceinline__ void row_to_bt(int row, int& bb, int& t) { if (row < MP) { bb = row >> 13; t = row & (LP - 1); } else { const int r = row - MP; bb = 8 + (r >> 11); t = r & (LS - 1); } }

struct Frame {
    LAS unsigned char* lds;
    volatile LAS unsigned* MISC;
    gu32* ctl;
    int tid, lane, wave, vcu, G;
    const float *xp, *xs, *memp, *mems, *norm_in, *w_in, *conv_w, *conv_b, *fw1, *fb1, *ffreq, *fw2, *fb2, *fw3, *skip, *gq, *gk, *mem_norm, *w_mkv, *gmq, *gmk, *w_out, *rel_bias;
    float* out;
    bf16 *WTin, *WTout, *WTmkv, *MEMB, *KM, *VM, *XB, *ST, *CT, *ZHY, *Q, *K, *V, *MQ, *MIX;
    float *H2P, *H2S, *BIAS, *GAINS;
    cf2 *KSP, *KSS;
};

namespace pg8 {
__device__ __forceinline__ u32x4 pack8(f32x4 a, f32x4 b) { u32x4 w; w.x = cvt_pk_bf16(a[0], a[1]); w.y = cvt_pk_bf16(a[2], a[3]); w.z = cvt_pk_bf16(b[0], b[1]); w.w = cvt_pk_bf16(b[2], b[3]); return w; }
__device__ __forceinline__ float dot4(f32x4 a) { return (a[0] * a[0] + a[1] * a[1]) + (a[2] * a[2] + a[3] * a[3]); }
__device__ __forceinline__ float silu_f(float x) { return x * __builtin_amdgcn_rcpf(1.0f + __builtin_amdgcn_exp2f(-1.4426950408889634f * x)); }
__device__ __forceinline__ f32x4 silu4(f32x4 a) { return (f32x4){silu_f(a[0]), silu_f(a[1]), silu_f(a[2]), silu_f(a[3])}; }

struct EpiZ {
    static constexpr bool PERM = true, AFTER_DRAIN = false;
    unsigned char* ws; const float* gains;
    __device__ __forceinline__ void operator()(const f32x4 (&acc)[2][2][4][2], const Unit& u, int wr, int wc, int fr, int fq) const {
        const int G = u.pn * 4 + wc, hc0 = 8 * fq;
        const int row0 = u.pm * BM + wr * 64 + fr;
        int bb, t0; row_to_bt(u.pm * BM, bb, t0);
        const int rb = bb_rowbase(bb), L = bb_len(bb);
        if (G < 18) {
#pragma unroll
            for (int ai = 0; ai < 2; ++ai)
#pragma unroll
                for (int m = 0; m < 4; ++m) { const int row = row0 + ai * HALF + m * 16; bf16_t* d = (bf16_t*)(ws + WS_ZHY) + (size_t)row * 1152 + G * 64 + hc0;
                    *(u32x4*)d = pack8(acc[ai][0][m][0], acc[ai][0][m][1]); *(u32x4*)(d + 32) = pack8(acc[ai][1][m][0], acc[ai][1][m][1]); }
        } else if (G < 40) {
            const bool ismq = G >= 36;
            const int part = ismq ? 0 : (G - 18) / 6;
            const int h = ismq ? G - 36 : (G - 18) - 6 * part;
            const bool isv = (part == 2);
            const int nh = ismq ? NHM : NH;
            bf16_t* base = (bf16_t*)(ws + (ismq ? WS_MQ : WS_Q + (size_t)part * (WS_K - WS_Q)));
            const float* gain = gains + (ismq ? 128 : (part == 0 ? 0 : 64));
            const float scale = (ismq || part == 0) ? 0.125f : 1.0f;
            f32x4 g0 = {1.f, 1.f, 1.f, 1.f}, g1 = g0, g2 = g0, g3 = g0;
            if (!isv) { g0 = *(const f32x4*)(gain + hc0); g1 = *(const f32x4*)(gain + hc0 + 4); g2 = *(const f32x4*)(gain + 32 + hc0); g3 = *(const f32x4*)(gain + 36 + hc0); }
#pragma unroll
            for (int ai = 0; ai < 2; ++ai)
#pragma unroll
                for (int m = 0; m < 4; ++m) { const int row = row0 + ai * HALF + m * 16; const int t = row - rb;
                    f32x4 a0 = acc[ai][0][m][0], a1 = acc[ai][0][m][1], b0 = acc[ai][1][m][0], b1 = acc[ai][1][m][1];
                    if (!isv) { float ss = (dot4(a0) + dot4(a1)) + (dot4(b0) + dot4(b1)); ss += __shfl_xor(ss, 16); ss += __shfl_xor(ss, 32);
                        const float r = __builtin_amdgcn_rsqf(ss * (1.0f / 64.0f) + RMS_EPS) * scale;
                        a0 = a0 * r * g0; a1 = a1 * r * g1; b0 = b0 * r * g2; b1 = b1 * r * g3; }
                    bf16_t* d = base + ((size_t)rb * nh + (size_t)h * L + t) * 64 + hc0;
                    *(u32x4*)d = pack8(a0, a1); *(u32x4*)(d + 32) = pack8(b0, b1); }
        } else {
            const int col = (G - 40) * 64 + hc0;
#pragma unroll
            for (int ai = 0; ai < 2; ++ai)
#pragma unroll
                for (int m = 0; m < 4; ++m) { const int row = row0 + ai * HALF + m * 16; bf16_t* d = (bf16_t*)(ws + WS_MIX) + (size_t)row * DM + col;
                    *(u32x4*)d = pack8(silu4(acc[ai][0][m][0]), silu4(acc[ai][0][m][1])); *(u32x4*)(d + 32) = pack8(silu4(acc[ai][1][m][0]), silu4(acc[ai][1][m][1])); }
        }
    }
};
struct EpiMKV {
    static constexpr bool PERM = true, AFTER_DRAIN = false;
    bf16_t* km; const float* gmk;
    __device__ __forceinline__ void operator()(const f32x4 (&acc)[2][2][4][2], const Unit& u, int wr, int wc, int fr, int fq) const {
        const int G = u.pn * 4 + wc, hc0 = 8 * fq, h = G & 3; const bool isk = G < 4;
        const int row0 = u.pm * BM + wr * 64 + fr;
        f32x4 g0 = {1.f, 1.f, 1.f, 1.f}, g1 = g0, g2 = g0, g3 = g0;
        if (isk) { g0 = *(const f32x4*)(gmk + hc0); g1 = *(const f32x4*)(gmk + hc0 + 4); g2 = *(const f32x4*)(gmk + 32 + hc0); g3 = *(const f32x4*)(gmk + 36 + hc0); }
#pragma unroll
        for (int ai = 0; ai < 2; ++ai)
#pragma unroll
            for (int m = 0; m < 4; ++m) { const int row = row0 + ai * HALF + m * 16; const int bbm = row >> 8, j = row & 255;
                f32x4 a0 = acc[ai][0][m][0], a1 = acc[ai][0][m][1], b0 = acc[ai][1][m][0], b1 = acc[ai][1][m][1];
                if (isk) { float ss = (dot4(a0) + dot4(a1)) + (dot4(b0) + dot4(b1)); ss += __shfl_xor(ss, 16); ss += __shfl_xor(ss, 32);
                    const float r = __builtin_amdgcn_rsqf(ss * (1.0f / 64.0f) + RMS_EPS);
                    a0 = a0 * r * g0; a1 = a1 * r * g1; b0 = b0 * r * g2; b1 = b1 * r * g3; }
                bf16_t* d = km + (isk ? (size_t)0 : (size_t)(WS_VM - WS_KM) / 2) + ((size_t)(bbm * NHM + h) * NMEM + j) * 64 + hc0;
                *(u32x4*)d = pack8(a0, a1); *(u32x4*)(d + 32) = pack8(b0, b1); }
    }
};
struct EpiOut {
    static constexpr bool PERM = false, AFTER_DRAIN = false;
    const float *xp, *xs; float* out;
    __device__ __forceinline__ void operator()(const f32x4 (&acc)[2][2][4][2], const Unit& u, int wr, int wc, int fr, int fq) const {
        const int row0 = u.pm * BM + wr * 64 + fr, col0 = u.pn * BM + wc * 32 + 4 * fq;
        const float* xin = (u.pm * BM < MP) ? xp + (size_t)row0 * DM : xs + (size_t)(row0 - MP) * DM;
        float* o = out + (size_t)row0 * DM;
#pragma unroll
        for (int ai = 0; ai < 2; ++ai)
#pragma unroll
            for (int m = 0; m < 4; ++m) { const size_t ro = (size_t)(ai * HALF + m * 16) * DM + col0;
#pragma unroll
                for (int bj = 0; bj < 2; ++bj)
#pragma unroll
                    for (int n = 0; n < 2; ++n) { const size_t off = ro + bj * HALF + n * 16; *(f32x4*)(o + off) = *(const f32x4*)(xin + off) + acc[ai][bj][m][n]; } }
    }
};
}

__device__ __forceinline__ float wave_sum(float v) {
#pragma unroll
    for (int o = 1; o < 64; o <<= 1) v += __shfl_xor(v, o);
    return v;
}
__device__ __forceinline__ int head_perm(int n) { const int o = n & 255; return (n & ~255) + 128 * ((o >> 5) & 1) + 32 * (o >> 6) + (o & 31); }
template <bool HP>
__device__ __forceinline__ void p0_transpose_item(const float* W, const float* gain, int K, int N, bf16* WT, LAS float* scr, int item, int lane) {
    const int nblk = N / 32, kb = item / nblk, nb = item % nblk, k0 = 64 * kb, n0 = 32 * nb;
#pragma unroll 8
    for (int i = 0; i < 32; ++i) { const int kk = 2 * i + (lane >> 5); float w = W[(size_t)(k0 + kk) * N + n0 + (lane & 31)]; if (gain) w *= gain[k0 + kk]; scr[kk * 33 + (lane & 31)] = w; }
    LDS_WAIT(); asm volatile("" ::: "memory");
    const int c = lane & 7;
#pragma unroll
    for (int j = 0; j < 4; ++j) { const int n = (lane >> 3) + 8 * j; const LAS float* s = scr + (8 * c) * 33 + n;
        v4u o; o.x = pk2(s[0 * 33], s[1 * 33]); o.y = pk2(s[2 * 33], s[3 * 33]); o.z = pk2(s[4 * 33], s[5 * 33]); o.w = pk2(s[6 * 33], s[7 * 33]);
        const int rowo = HP ? head_perm(n0 + n) : (n0 + n);
        *(GAS v4u*)(WT + (size_t)rowo * K + k0 + 8 * c) = o; }
    LDS_WAIT(); asm volatile("" ::: "memory");
}
__device__ __forceinline__ void rms_row_to_bf16(int lane, const float* xrow, bf16* orow) {
    const GAS f32x4* xr = (const GAS f32x4*)xrow + lane;
    f32x4 v[4]; float s = 0.f;
#pragma unroll
    for (int j = 0; j < 4; ++j) { v[j] = xr[64 * j]; s += (v[j].x * v[j].x + v[j].y * v[j].y) + (v[j].z * v[j].z + v[j].w * v[j].w); }
    const float rstd = 1.0f / sqrtf(wave_sum(s) * (1.f / DM) + RMS_EPS);
    GAS unsigned long long* o8 = (GAS unsigned long long*)orow + lane;
#pragma unroll
    for (int j = 0; j < 4; ++j) o8[64 * j] = (unsigned long long)pk2(v[j].x * rstd, v[j].y * rstd) | ((unsigned long long)pk2(v[j].z * rstd, v[j].w * rstd) << 32);
}
__device__ __forceinline__ void h2_row(const Frame& F, int t, int L, float* h2) {
    const int j = F.lane;
    const int bi = j & 15;
    const float band = 1e-4f + (float)bi * ((15.0f - 1e-4f) / 15.0f);
    const float xarg = 2.0f * ((float)t * band) / (float)L;
    float sn, cs; sincospif(xarg, &sn, &cs);
    const float tt = (float)t / (float)(L - 1);
    float a = tt * F.fw1[j] + F.fb1[j];
#pragma unroll
    for (int i = 0; i < 16; ++i) { const float c = __shfl(cs, i), s = -__shfl(sn, i); a += c * F.fw1[(1 + i) * 64 + j] + s * F.fw1[(17 + i) * 64 + j]; }
    const float fr = F.ffreq[j];
    const float h1 = sinf(fr * a);
    float b = F.fb2[j];
#pragma unroll 8
    for (int i = 0; i < 64; ++i) b += __shfl(h1, i) * F.fw2[i * 64 + j];
    h2[(size_t)t * 64 + j] = sinf(fr * b);
}
__device__ __forceinline__ int t5_bucket_dev(int rel) {
    const int n = rel < 0 ? -rel : rel;
    int b = n < 8 ? n : n < 15 ? 8 : n < 27 ? 9 : n < 50 ? 10 : n < 91 ? 11 : n < 166 ? 12 : n < 305 ? 13 : n < 559 ? 14 : 15;
    return b + (rel > 0 ? 16 : 0);
}
__device__ __forceinline__ void p0_prologue(Frame& F) {
    LAS float* scr = (LAS float*)(F.lds + RING_OFF + F.wave * 16384);
    const int gw = F.vcu * NWAVES + F.wave, NGW = F.G * NWAVES;
    constexpr int I_IN = (DM / 64) * (DIN / 32), I_OUT = (DM / 64) * (DM / 32), I_MKV = (DM / 64) * (DMKV / 32);
    constexpr int NITEMS = I_IN + I_OUT + I_MKV;
    for (int it = gw; it < NITEMS; it += NGW) {
        int r = it;
        if (r < I_IN) { p0_transpose_item<true>(F.w_in, F.norm_in, DM, DIN, F.WTin, scr, r, F.lane); continue; } r -= I_IN;
        if (r < I_OUT) { p0_transpose_item<false>(F.w_out, nullptr, DM, DM, F.WTout, scr, r, F.lane); continue; } r -= I_OUT;
        p0_transpose_item<true>(F.w_mkv, F.mem_norm, DM, DMKV, F.WTmkv, scr, r, F.lane);
    }
    for (int m = gw; m < MT; m += NGW) rms_row_to_bf16(F.lane, m < MP ? F.xp + (size_t)m * DM : F.xs + (size_t)(m - MP) * DM, F.XB + (size_t)m * DM);
    for (int m = gw; m < MMEM; m += NGW) rms_row_to_bf16(F.lane, m < MMEM / 2 ? F.memp + (size_t)m * DM : F.mems + (size_t)(m - MMEM / 2) * DM, F.MEMB + (size_t)m * DM);
    for (int t = gw; t < LP + LS; t += NGW) { if (t < LP) h2_row(F, t, LP, F.H2P); else h2_row(F, t - LP, LS, F.H2S); }
    if (gw == 1) { F.GAINS[F.lane] = F.gq[F.lane]; F.GAINS[64 + F.lane] = F.gk[F.lane]; F.GAINS[128 + F.lane] = F.gmq[F.lane]; F.GAINS[192 + F.lane] = F.gmk[F.lane]; }
    if (gw == 0) { for (int e = F.lane; e < 3 * NH * 129; e += 64) { const int c = e / (NH * 129), h = (e / 129) % NH, jj = e % 129; const int d = c == 0 ? 1 : c == 1 ? 4 : 16;
            F.BIAS[e] = F.rel_bias[t5_bucket_dev((jj - 64) * d) * NH + h]; } }
}

constexpr int NTW = 8192;
__device__ __forceinline__ cf2 root16(int k) {
    static constexpr float c[8] = {1.0f, 0.92387953251128674f, 0.70710678118654752f, 0.38268343236508977f, 0.0f, -0.38268343236508977f, -0.70710678118654752f, -0.92387953251128674f};
    static constexpr float s[8] = {0.0f, 0.38268343236508977f, 0.70710678118654752f, 0.92387953251128674f, 1.0f, 0.92387953251128674f, 0.70710678118654752f, 0.38268343236508977f};
    return (cf2){c[k], -s[k]};
}
template <int S, bool INV, bool T1ONE>
__device__ __forceinline__ void bfly(cf2 (&v)[1 << S], cf2 t1) {
    constexpr int R = 1 << S;
    cf2 tp[S]; tp[0] = t1;
#pragma unroll
    for (int s = 1; s < S; ++s) tp[s] = cmul(tp[s - 1], tp[s - 1]);
    if (!INV) {
#pragma unroll
        for (int s = 0; s < S; ++s) { const int half = R >> (s + 1);
#pragma unroll
            for (int r = 0; r < R; ++r) if ((r % (2 * half)) < half) { const int k16 = (r % half) * (8 / half);
                const cf2 u = v[r], x = v[r + half]; v[r] = u + x; cf2 d = u - x;
                if (T1ONE) { if (k16 != 0) d = cmul(d, root16(k16)); }
                else { const cf2 w = (k16 == 0) ? tp[s] : cmul(tp[s], root16(k16)); d = cmul(d, w); }
                v[r + half] = d; } }
    } else {
#pragma unroll
        for (int s = S - 1; s >= 0; --s) { const int half = R >> (s + 1);
#pragma unroll
            for (int r = 0; r < R; ++r) if ((r % (2 * half)) < half) { const int k16 = (r % half) * (8 / half);
                cf2 x = v[r + half];
                if (T1ONE) { if (k16 != 0) x = cmulc(x, root16(k16)); }
                else { const cf2 w = (k16 == 0) ? tp[s] : cmul(tp[s], root16(k16)); x = cmulc(x, w); }
                const cf2 u = v[r]; v[r] = u + x; v[r + half] = u - x; } }
    }
}
template <int S, int LSTR, bool INV>
__device__ __forceinline__ void fft_pass(LAS cf2* x, const LAS cf2* tw, int N, int tl, int NT) {
    constexpr int R = 1 << S, stride = 1 << LSTR;
    for (int g = tl; g < (N >> S); g += NT) {
        const int j0 = g & (stride - 1), base = ((g >> LSTR) << (LSTR + S)) + j0;
        cf2 v[R];
#pragma unroll
        for (int r = 0; r < R; ++r) v[r] = x[base + r * stride];
        if (LSTR == 0) bfly<S, INV, true>(v, (cf2){1.f, 0.f});
        else bfly<S, INV, false>(v, tw[j0 << (13 - S - LSTR)]);
#pragma unroll
        for (int r = 0; r < R; ++r) x[base + r * stride] = v[r];
    }
}
template <int S>
__device__ __forceinline__ void fft_mid(LAS cf2* x, const cf2* Kg, int N, int tl, int NT) {
    constexpr int R = 1 << S;
    for (int g = tl; g < (N >> S); g += NT) {
        cf2 v[R];
#pragma unroll
        for (int r = 0; r < R; ++r) v[r] = x[g * R + r];
        bfly<S, false, true>(v, (cf2){1.f, 0.f});
#pragma unroll
        for (int r = 0; r < R; ++r) v[r] = cmul(v[r], Kg[g * R + r]);
        bfly<S, true, true>(v, (cf2){1.f, 0.f});
#pragma unroll
        for (int r = 0; r < R; ++r) x[g * R + r] = v[r];
    }
}
template <int LOGN>
__device__ __forceinline__ void fft_conv(cf2 (&v)[16], LAS cf2* x, const LAS cf2* tw, const cf2* Kg, int tl) {
    constexpr int N = 1 << LOGN, NT = N >> 4;
    const cf2 t1 = tw[tl << (13 - LOGN)];
    bfly<4, false, false>(v, t1);
    __syncthreads();
#pragma unroll
    for (int r = 0; r < 16; ++r) x[tl + r * NT] = v[r];
    __syncthreads();
    fft_pass<4, LOGN - 8, false>(x, tw, N, tl, NT);
    __syncthreads();
    if (LOGN == 13) { fft_pass<4, 1, false>(x, tw, N, tl, NT); __syncthreads(); fft_mid<1>(x, Kg, N, tl, NT); __syncthreads(); fft_pass<4, 1, true>(x, tw, N, tl, NT); }
    else { fft_mid<3>(x, Kg, N, tl, NT); }
    __syncthreads();
    fft_pass<4, LOGN - 8, true>(x, tw, N, tl, NT);
    __syncthreads();
#pragma unroll
    for (int r = 0; r < 16; ++r) v[r] = x[tl + r * NT];
    bfly<4, true, false>(v, t1);
}
template <int LOGN>
__device__ __forceinline__ void fft_fwd_store(cf2 (&v)[16], LAS cf2* x, const LAS cf2* tw, cf2* Kout, int tl) {
    constexpr int N = 1 << LOGN, NT = N >> 4;
    const cf2 t1 = tw[tl << (13 - LOGN)];
    bfly<4, false, false>(v, t1);
    __syncthreads();
#pragma unroll
    for (int r = 0; r < 16; ++r) x[tl + r * NT] = v[r];
    __syncthreads();
    fft_pass<4, LOGN - 8, false>(x, tw, N, tl, NT);
    __syncthreads();
    if (LOGN == 13) { fft_pass<4, 1, false>(x, tw, N, tl, NT); __syncthreads(); fft_pass<1, 0, false>(x, tw, N, tl, NT); }
    else { fft_pass<3, 0, false>(x, tw, N, tl, NT); }
    __syncthreads();
    for (int i = tl; i < N; i += NT) Kout[i] = x[i];
}
constexpr int FFT_X = 0, FFT_TW = 65536, FFT_SCR = 98304, FFT_AUX = 133120;
__device__ __forceinline__ void fft_init_tw(Frame& F) {
    LAS cf2* tw = (LAS cf2*)(F.lds + FFT_TW);
    for (int k = F.tid; k < NTW / 2; k += NWAVES * 64) { float s, c; sincospif((float)k * (2.0f / NTW), &s, &c); tw[k] = (cf2){c, -s}; }
    __syncthreads();
}
__device__ __forceinline__ cf2 root32(int r) {
    static constexpr float c[16] = {1.0f, 0.98078528040323043f, 0.92387953251128674f, 0.83146961230254524f, 0.70710678118654752f, 0.55557023301960218f, 0.38268343236508977f, 0.19509032201612825f,
                         0.0f, -0.19509032201612825f, -0.38268343236508977f, -0.55557023301960218f, -0.70710678118654752f, -0.83146961230254524f, -0.92387953251128674f, -0.98078528040323043f};
    static constexpr float s[16] = {0.0f, 0.19509032201612825f, 0.38268343236508977f, 0.55557023301960218f, 0.70710678118654752f, 0.83146961230254524f, 0.92387953251128674f, 0.98078528040323043f,
                         1.0f, 0.98078528040323043f, 0.92387953251128674f, 0.83146961230254524f, 0.70710678118654752f, 0.55557023301960218f, 0.38268343236508977f, 0.19509032201612825f};
    return (cf2){c[r], -s[r]};
}

template <int LOGN>
__device__ __forceinline__ void filter_item(Frame& F, int c, int gi, int tl, const float* H2, cf2* Kout) {
    constexpr int N = 1 << LOGN, NT = N >> 4;
    LAS cf2* x = (LAS cf2*)(F.lds + FFT_X) + gi * N;
    const LAS cf2* tw = (const LAS cf2*)(F.lds + FFT_TW);
    LAS float* sf = (LAS float*)x;
    LAS float* sb = sf + N;
    LAS float* w3s = (LAS float*)(F.lds + FFT_AUX) + gi * 128;
    LAS float* red = (LAS float*)(F.lds + FFT_AUX + 2048) + gi * 16;
    __syncthreads();
    if (tl < 128) w3s[tl] = F.fw3[(size_t)(tl & 63) * 768 + (tl >> 6) * DHY + c];
    __syncthreads();
    const float delta = 3.0701134573253944f + (float)c * ((15.350567286626972f - 3.0701134573253944f) / 383.0f);
    float ss = 0.f;
#pragma unroll 1
    for (int r = 0; r < 16; ++r) { const int t = tl + r * NT; const f32x4* hr = (const f32x4*)(H2 + (size_t)t * 64);
        float f = 0.f, b = 0.f;
#pragma unroll
        for (int j4 = 0; j4 < 16; ++j4) { const f32x4 h = hr[j4];
            f += h.x * w3s[4 * j4] + h.y * w3s[4 * j4 + 1] + h.z * w3s[4 * j4 + 2] + h.w * w3s[4 * j4 + 3];
            b += h.x * w3s[64 + 4 * j4] + h.y * w3s[64 + 4 * j4 + 1] + h.z * w3s[64 + 4 * j4 + 2] + h.w * w3s[64 + 4 * j4 + 3]; }
        const float dec = expf(-((float)t / (float)(N - 1)) * delta);
        f *= dec; b *= dec; sf[t] = f; sb[t] = b;
        ss += (t == 0) ? (f + b) * (f + b) : (f * f + b * b); }
    ss = wave_sum(ss);
    if ((tl & 63) == 0) red[tl >> 6] = ss;
    __syncthreads();
    float tot = 0.f;
    for (int w = 0; w < NT / 64; ++w) tot += red[w];
    const float sc = (1.0f / sqrtf(tot + 1e-12f)) * (0.5f / (float)N);
    float sn, cs; sincospif((float)tl / (float)N, &sn, &cs); const cf2 wt = (cf2){cs, -sn};
    float ka[16], kb[16];
#pragma unroll
    for (int r = 0; r < 16; ++r) { const int t = tl + r * NT;
        ka[r] = ((t == 0) ? sf[0] + sb[0] : sf[t]) * sc;
        kb[r] = ((t == 0) ? 0.f : sb[(N - t) & (N - 1)]) * sc; }
    cf2 v[16];
#pragma unroll
    for (int r = 0; r < 16; ++r) v[r] = (cf2){ka[r] + kb[r], 0.f};
    fft_fwd_store<LOGN>(v, x, tw, Kout, tl);
#pragma unroll
    for (int r = 0; r < 16; ++r) v[r] = cmul(wt, root32(r)) * (ka[r] - kb[r]);
    fft_fwd_store<LOGN>(v, x, tw, Kout + N, tl);
}
__device__ __forceinline__ void filter_phase(Frame& F) {
    fft_init_tw(F);
    const int NI = DHY + DHY / 4;
    for (int it = F.vcu; it < NI; it += F.G) {
        int tid = F.tid; asm volatile("" : "+v"(tid));
        if (it < DHY) filter_item<13>(F, it, 0, tid, F.H2P, F.KSP + (size_t)it * 2 * LP);
        else { const int gi = tid >> 7, c = (it - DHY) * 4 + gi; filter_item<11>(F, c, gi, tid & 127, F.H2S, F.KSS + (size_t)c * 2 * LS); }
    }
    __syncthreads();
}

template <int LOGN>
__device__ __forceinline__ void hyena_item(Frame& F, int c, int bb1, int bb2, int gi, int tl, const cf2* Kc) {
    constexpr int N = 1 << LOGN, NT = N >> 4;
    LAS cf2* x = (LAS cf2*)(F.lds + FFT_X) + gi * N;
    const LAS cf2* tw = (const LAS cf2*)(F.lds + FFT_TW);
    const bf16* s1p = F.ST + (size_t)bb_rowbase(bb1) * DHY + (size_t)c * N + tl;
    const bf16* s2p = F.ST + (size_t)bb_rowbase(bb2) * DHY + (size_t)c * N + tl;
    float sn, cs; sincospif((float)tl / (float)N, &sn, &cs); const cf2 wt = (cf2){cs, -sn};
    LAS unsigned* ysc = (LAS unsigned*)(F.lds + FFT_SCR) + gi * N + tl;
    cf2 v[16];
#pragma unroll
    for (int r = 0; r < 16; ++r) v[r] = (cf2){bf2f(s1p[r * NT]), bf2f(s2p[r * NT])};
    fft_conv<LOGN>(v, x, tw, Kc, tl);
#pragma unroll
    for (int r = 0; r < 16; ++r) ysc[r * NT] = pk2(v[r].x, v[r].y);
#pragma unroll
    for (int r = 0; r < 16; ++r) v[r] = cmul((cf2){bf2f(s1p[r * NT]), bf2f(s2p[r * NT])}, cmul(wt, root32(r)));
    fft_conv<LOGN>(v, x, tw, Kc + N, tl);
    cf2 wt2 = wt; asm volatile("" : "+v"(wt2));
    const float sk = F.skip[c];
    bf16* o1 = F.CT + (size_t)bb_rowbase(bb1) * DHY + (size_t)c * N + tl;
    bf16* o2 = F.CT + (size_t)bb_rowbase(bb2) * DHY + (size_t)c * N + tl;
#pragma unroll
    for (int r = 0; r < 16; ++r) { const unsigned yw = ysc[r * NT]; const cf2 z = (cf2){bflo(yw), bfhi(yw)} + cmulc(v[r], cmul(wt2, root32(r)));
        o1[r * NT] = (bf16)f2bf(z.x + bf2f(s1p[r * NT]) * sk); o2[r * NT] = (bf16)f2bf(z.y + bf2f(s2p[r * NT]) * sk); }
}
__device__ __forceinline__ void hyena_phase(Frame& F) {
    fft_init_tw(F);
    const int NI = DHY * 4 + DHY;
    for (int it = F.vcu; it < NI; it += F.G) {
        int tid = F.tid; asm volatile("" : "+v"(tid));
        if (it < DHY * 4) { const int c = it >> 2, bp = it & 3; hyena_item<13>(F, c, 2 * bp, 2 * bp + 1, 0, tid, F.KSP + (size_t)c * 2 * LP); }
        else { const int c = it - DHY * 4, gi = tid >> 7; hyena_item<11>(F, c, 8 + 2 * gi, 9 + 2 * gi, gi, tid & 127, F.KSS + (size_t)c * 2 * LS); }
    }
    __syncthreads();
}

constexpr int TP = 65;
__device__ __forceinline__ void load_tile_rows(Frame& F, LAS float* T, int rb, int L, int t0, int colbase) {
    for (int id = F.tid; id < 130 * 8; id += NWAVES * 64) { const int i = id >> 3, ch = id & 7; const int t = t0 - 1 + i;
        v4u w = {0u, 0u, 0u, 0u};
        if (t >= 0 && t < L) w = *(const GAS v4u*)(F.ZHY + (size_t)(rb + t) * 1152 + colbase + ch * 8);
        LAS float* d = T + i * TP + ch * 8;
        d[0] = bflo(w.x); d[1] = bfhi(w.x); d[2] = bflo(w.y); d[3] = bfhi(w.y); d[4] = bflo(w.z); d[5] = bfhi(w.z); d[6] = bflo(w.w); d[7] = bfhi(w.w); }
}
__device__ __forceinline__ void prep_phase(Frame& F) {
    LAS float* T1 = (LAS float*)(F.lds), *T2 = T1 + 130 * TP;
    const int NI = (MT / 128) * 6;
    for (int it = F.vcu; it < NI; it += F.G) {
        const int cg = it % 6, tile = it / 6; int bb, t0; row_to_bt(tile * 128, bb, t0); const int rb = bb_rowbase(bb), L = bb_len(bb);
        __syncthreads();
        load_tile_rows(F, T1, rb, L, t0, DHY + cg * 64);
        load_tile_rows(F, T2, rb, L, t0, 2 * DHY + cg * 64);
        __syncthreads();
        const int tt = F.tid & 127, cq = F.tid >> 7;
#pragma unroll 4
        for (int k = 0; k < 16; ++k) { const int cl = cq * 16 + k, ch1 = DHY + cg * 64 + cl, ch2 = 2 * DHY + cg * 64 + cl;
            const float u1 = F.conv_w[ch1] * T1[tt * TP + cl] + F.conv_w[1152 + ch1] * T1[(tt + 1) * TP + cl] + F.conv_w[2304 + ch1] * T1[(tt + 2) * TP + cl] + F.conv_b[ch1];
            const float u2 = F.conv_w[ch2] * T2[tt * TP + cl] + F.conv_w[1152 + ch2] * T2[(tt + 1) * TP + cl] + F.conv_w[2304 + ch2] * T2[(tt + 2) * TP + cl] + F.conv_b[ch2];
            F.ST[(size_t)rb * DHY + (size_t)(cg * 64 + cl) * L + t0 + tt] = (bf16)f2bf(u1 * u2); }
    }
    __syncthreads();
}
__device__ __forceinline__ void combine_phase(Frame& F) {
    LAS float* T1 = (LAS float*)(F.lds), *Y = T1 + 130 * TP;
    const int NI = (MT / 128) * 6;
    for (int it = F.vcu; it < NI; it += F.G) {
        const int cg = it % 6, tile = it / 6; int bb, t0; row_to_bt(tile * 128, bb, t0); const int rb = bb_rowbase(bb), L = bb_len(bb);
        __syncthreads();
        load_tile_rows(F, T1, rb, L, t0, cg * 64);
        __syncthreads();
        const int tt = F.tid & 127, cq = F.tid >> 7;
#pragma unroll 4
        for (int k = 0; k < 16; ++k) { const int cl = cq * 16 + k, ch = cg * 64 + cl;
            const float u0 = F.conv_w[ch] * T1[tt * TP + cl] + F.conv_w[1152 + ch] * T1[(tt + 1) * TP + cl] + F.conv_w[2304 + ch] * T1[(tt + 2) * TP + cl] + F.conv_b[ch];
            const float ct = bf2f(F.CT[(size_t)rb * DHY + (size_t)ch * L + t0 + tt]);
            Y[tt * TP + cl] = u0 * ct; }
        __syncthreads();
        for (int id = F.tid; id < 128 * 8; id += NWAVES * 64) { const int i = id >> 3, ch8 = id & 7;
            GAS v4u* p = (GAS v4u*)(F.MIX + (size_t)(rb + t0 + i) * DM + cg * 64 + ch8 * 8); const v4u g = *p; const LAS float* y = Y + i * TP + ch8 * 8;
            v4u o; o.x = pk2(bflo(g.x) * y[0], bfhi(g.x) * y[1]); o.y = pk2(bflo(g.y) * y[2], bfhi(g.y) * y[3]); o.z = pk2(bflo(g.z) * y[4], bfhi(g.z) * y[5]); o.w = pk2(bflo(g.w) * y[6], bfhi(g.w) * y[7]);
            *p = o; }
    }
    __syncthreads();
}

__device__ __forceinline__ void load_row64(const bf16* p, float (&x)[64]) {
#pragma unroll
    for (int i = 0; i < 8; ++i) { const v4u w = *(const GAS v4u*)(p + 8 * i);
        x[8 * i] = bflo(w.x); x[8 * i + 1] = bfhi(w.x); x[8 * i + 2] = bflo(w.y); x[8 * i + 3] = bfhi(w.y); x[8 * i + 4] = bflo(w.z); x[8 * i + 5] = bfhi(w.z); x[8 * i + 6] = bflo(w.w); x[8 * i + 7] = bfhi(w.w); }
}
__device__ __forceinline__ float dot_row64(const bf16* p, const float (&q)[64]) {
    float a0 = 0.f, a1 = 0.f, a2 = 0.f, a3 = 0.f;
#pragma unroll
    for (int i = 0; i < 8; ++i) { const v4u w = *(const GAS v4u*)(p + 8 * i);
        a0 += bflo(w.x) * q[8 * i] + bfhi(w.x) * q[8 * i + 1]; a1 += bflo(w.y) * q[8 * i + 2] + bfhi(w.y) * q[8 * i + 3];
        a2 += bflo(w.z) * q[8 * i + 4] + bfhi(w.z) * q[8 * i + 5]; a3 += bflo(w.w) * q[8 * i + 6] + bfhi(w.w) * q[8 * i + 7]; }
    return (a0 + a1) + (a2 + a3);
}
__device__ __forceinline__ void axpy_row64(const bf16* p, float pw, float corr, float (&o)[64]) {
#pragma unroll
    for (int i = 0; i < 8; ++i) { const v4u w = *(const GAS v4u*)(p + 8 * i);
        o[8 * i] = o[8 * i] * corr + pw * bflo(w.x); o[8 * i + 1] = o[8 * i + 1] * corr + pw * bfhi(w.x); o[8 * i + 2] = o[8 * i + 2] * corr + pw * bflo(w.y); o[8 * i + 3] = o[8 * i + 3] * corr + pw * bfhi(w.y);
        o[8 * i + 4] = o[8 * i + 4] * corr + pw * bflo(w.z); o[8 * i + 5] = o[8 * i + 5] * corr + pw * bfhi(w.z); o[8 * i + 6] = o[8 * i + 6] * corr + pw * bflo(w.w); o[8 * i + 7] = o[8 * i + 7] * corr + pw * bfhi(w.w); }
}
__device__ __forceinline__ void mix_store_row64(bf16* p, const float (&o)[64], float inv) {
#pragma unroll
    for (int i = 0; i < 8; ++i) { GAS v4u* pp = (GAS v4u*)(p + 8 * i); const v4u g = *pp; v4u w;
        w.x = pk2(bflo(g.x) * o[8 * i] * inv, bfhi(g.x) * o[8 * i + 1] * inv); w.y = pk2(bflo(g.y) * o[8 * i + 2] * inv, bfhi(g.y) * o[8 * i + 3] * inv);
        w.z = pk2(bflo(g.z) * o[8 * i + 4] * inv, bfhi(g.z) * o[8 * i + 5] * inv); w.w = pk2(bflo(g.w) * o[8 * i + 6] * inv, bfhi(g.w) * o[8 * i + 7] * inv); *pp = w; }
}
__device__ __forceinline__ void attn_naive_phase(Frame& F) {
    const int NI1 = 8 * NH * (LP / 512) + 8 * NH * (LS / 512);
    for (int it = F.vcu; it < NI1; it += F.G) {
        int bb, h, ch;
        if (it < 8 * NH * (LP / 512)) { bb = it / (NH * 16); h = (it / 16) % NH; ch = it % 16; } else { const int r = it - 8 * NH * (LP / 512); bb = 8 + r / (NH * 4); h = (r / 4) % NH; ch = r % 4; }
        const int rb = bb_rowbase(bb), L = bb_len(bb), t = ch * 512 + F.tid;
        const size_t hb = ((size_t)rb * NH + (size_t)h * L) * 64;
        float q[64], o[64];
        load_row64(F.Q + hb + (size_t)t * 64, q);
#pragma unroll
        for (int e = 0; e < 64; ++e) o[e] = 0.f;
        float m = -1e30f, l = 0.f;
        for (int c = 0; c < 3; ++c) { const int d = c == 0 ? 1 : c == 1 ? 4 : 16; const float* bias = F.BIAS + (c * NH + h) * 129;
            for (int jj = 0; jj < 129; ++jj) { const int tk = t + (jj - 64) * d;
                if (tk >= 0 && tk < L) { const float lg = dot_row64(F.K + hb + (size_t)tk * 64, q) + bias[jj];
                    const float mn = fmaxf(m, lg), corr = __expf(m - mn), pw = __expf(lg - mn); m = mn; l = l * corr + pw;
                    axpy_row64(F.V + hb + (size_t)tk * 64, pw, corr, o); } } }
        mix_store_row64(F.MIX + (size_t)(rb + t) * DM + DHY + h * 64, o, 1.0f / l);
    }
    const int NI2 = 8 * NHM * (LP / 512) + 8 * NHM * (LS / 512);
    for (int it = F.vcu; it < NI2; it += F.G) {
        int bb, h, ch;
        if (it < 8 * NHM * (LP / 512)) { bb = it / (NHM * 16); h = (it / 16) % NHM; ch = it % 16; } else { const int r = it - 8 * NHM * (LP / 512); bb = 8 + r / (NHM * 4); h = (r / 4) % NHM; ch = r % 4; }
        const int rb = bb_rowbase(bb), L = bb_len(bb), t = ch * 512 + F.tid;
        float q[64], o[64];
        load_row64(F.MQ + ((size_t)rb * NHM + (size_t)h * L + t) * 64, q);
#pragma unroll
        for (int e = 0; e < 64; ++e) o[e] = 0.f;
        float m = -1e30f, l = 0.f;
        const bf16* kb = F.KM + (size_t)(bb * NHM + h) * NMEM * 64; const bf16* vb = F.VM + (size_t)(bb * NHM + h) * NMEM * 64;
        for (int j = 0; j < NMEM; ++j) { const float lg = dot_row64(kb + j * 64, q);
            const float mn = fmaxf(m, lg), corr = __expf(m - mn), pw = __expf(lg - mn); m = mn; l = l * corr + pw;
            axpy_row64(vb + j * 64, pw, corr, o); }
        mix_store_row64(F.MIX + (size_t)(rb + t) * DM + 2 * DHY + h * 64, o, 1.0f / l);
    }
}

struct Args { const float* in[23]; float* out; unsigned char* ws; int ph_lo, ph_hi, li, pad; };
__global__ void __launch_bounds__(NWAVES * 64, 2) hymba_fwd(Args args) {
    extern __shared__ __attribute__((aligned(16))) unsigned char lds[];
    Frame F;
    F.lds = (LAS unsigned char*)lds;
    F.MISC = (volatile LAS unsigned*)(F.lds + MISC_OFF);
    F.tid = threadIdx.x; F.lane = F.tid & 63; F.wave = __builtin_amdgcn_readfirstlane(F.tid >> 6);
    F.G = gridDim.x; { const int bx = blockIdx.x; F.vcu = (F.G % 8 == 0) ? (bx % 8) * (F.G / 8) + bx / 8 : bx; }
    unsigned char* ws = args.ws;
    F.ctl = (gu32*)(ws + WS_CTL);
    F.xp = args.in[0]; F.xs = args.in[1]; F.memp = args.in[2]; F.mems = args.in[3]; F.norm_in = args.in[4]; F.w_in = args.in[5]; F.conv_w = args.in[6]; F.conv_b = args.in[7];
    F.fw1 = args.in[8]; F.fb1 = args.in[9]; F.ffreq = args.in[10]; F.fw2 = args.in[11]; F.fb2 = args.in[12]; F.fw3 = args.in[13]; F.skip = args.in[14]; F.gq = args.in[15]; F.gk = args.in[16];
    F.mem_norm = args.in[17]; F.w_mkv = args.in[18]; F.gmq = args.in[19]; F.gmk = args.in[20]; F.w_out = args.in[21]; F.rel_bias = args.in[22]; F.out = args.out;
    F.WTin = (bf16*)(ws + WS_WTIN); F.WTout = (bf16*)(ws + WS_WTOUT); F.WTmkv = (bf16*)(ws + WS_WTMKV); F.MEMB = (bf16*)(ws + WS_MEMB); F.KM = (bf16*)(ws + WS_KM); F.VM = (bf16*)(ws + WS_VM);
    F.XB = (bf16*)(ws + WS_XB); F.ST = (bf16*)(ws + WS_ST); F.CT = (bf16*)(ws + WS_CT); F.ZHY = (bf16*)(ws + WS_ZHY); F.Q = (bf16*)(ws + WS_Q); F.K = (bf16*)(ws + WS_K); F.V = (bf16*)(ws + WS_V);
    F.MQ = (bf16*)(ws + WS_MQ); F.MIX = (bf16*)(ws + WS_MIX); F.H2P = (float*)(ws + WS_H2P); F.H2S = (float*)(ws + WS_H2S); F.BIAS = (float*)(ws + WS_BIAS); F.GAINS = (float*)(ws + WS_GAINS);
    F.KSP = (cf2*)(ws + WS_KSP); F.KSS = (cf2*)(ws + WS_KSS);
    for (int u = F.tid; u < (LDS_BYTES - LDSCTL_OFF) / 4; u += NWAVES * 64) ((LAS unsigned*)(F.lds + LDSCTL_OFF))[u] = 0u;
    __syncthreads();
    XcdBarrier bar; bar.bar = (unsigned*)(F.ctl + CW_BAR); bar.x = 0; bar.st = nullptr;
    if (N_LAUNCHES != PER_PHASE) bar = xcd_barrier_post((unsigned*)(F.ctl + CW_BAR), F.MISC + 8);
#define GRID_BAR(seam) do { if (N_LAUNCHES == PER_PHASE) { if (F.tid == 0) __hip_atomic_store(F.ctl + CW_TMO, 0xBADBA0u | (unsigned)(seam), RLX_AGENT); } else { xcd_barrier(bar); } } while (0)
    const int lo = args.ph_lo, hi = args.ph_hi;
#ifndef PH_MASK
#define PH_MASK 63
#endif
#define IN(k) (((PH_MASK >> (k)) & 1) && lo <= (k) && (k) < hi)
#define BOTH(k) (IN(k) && IN((k) + 1))

    if (IN(0)) { p0_prologue(F); if (BOTH(0)) GRID_BAR(0); }
    if (IN(1)) {
#ifndef NO_G1
        { pg8::Gemm g{F.XB, F.WTin, MT, DIN, DM}; pg8::StaticOrder S; S.init(MT, DIN, F.G, (int)blockIdx.x);
          pg8::EpiZ E{args.ws, F.GAINS};
          static_assert(WS_V - WS_K == WS_K - WS_Q, "Q | K | V equally spaced");
          pg8::gemm_phase<pg8::EpiZ, pg8::StaticOrder, true, true>(F.lds + RING_OFF, g, S, E); }
#endif
#ifndef NO_MKV
        { pg8::Gemm g{F.MEMB, F.WTmkv, MMEM, DMKV, DM}; pg8::StaticOrder S; S.init(MMEM, DMKV, F.G, (int)((blockIdx.x + F.G / 2) % F.G));
          pg8::EpiMKV E{F.KM, F.GAINS + 192};
          pg8::gemm_phase<pg8::EpiMKV, pg8::StaticOrder, true, true>(F.lds + RING_OFF, g, S, E); }
#endif
#ifndef NO_FILT
        filter_phase(F);
#endif
        if (BOTH(1)) GRID_BAR(1);
    }
    if (IN(2)) { prep_phase(F); if (BOTH(2)) GRID_BAR(2); }
    if (IN(3)) {
#ifndef NO_HY
 hyena_phase(F);
#endif
#ifndef NO_ATT
 attn_naive_phase(F);
#endif
 if (BOTH(3)) GRID_BAR(3); }
    if (IN(4)) { combine_phase(F); if (BOTH(4)) GRID_BAR(4); }
    if (IN(5)) {
        pg8::Gemm g{F.MIX, F.WTout, MT, DM, DM}; pg8::StaticOrder S; S.init(MT, DM, F.G, (int)blockIdx.x);
        pg8::EpiOut E{F.xp, F.xs, F.out};
        pg8::gemm_phase<pg8::EpiOut, pg8::StaticOrder, true, true>(F.lds + RING_OFF, g, S, E);
    }
#undef IN
#undef BOTH
}

extern "C" void kernel_launch(void* const* d_in, const int* in_sizes, int n_in, void* d_out, int out_size, void* d_ws, size_t ws_size, hipStream_t stream) {
    static int grid = 0;
    if (grid == 0) {
        if (n_in != 23 || in_sizes[0] != MP * DM || out_size != MT * DM || ws_size < WS_END) { fprintf(stderr, "kernel_launch: unexpected shapes (n_in %d, in0 %d, out %d, ws %zu)\n", n_in, n_in > 0 ? in_sizes[0] : -1, out_size, ws_size); grid = -1; return; }
        int dev = 0, cus = 0;
        if (hipGetDevice(&dev) != hipSuccess || hipDeviceGetAttribute(&cus, hipDeviceAttributeMultiprocessorCount, dev) != hipSuccess) { grid = -1; return; }
        if (hipFuncSetAttribute((const void*)hymba_fwd, hipFuncAttributeMaxDynamicSharedMemorySize, LDS_BYTES) != hipSuccess) { fprintf(stderr, "kernel_launch: hipFuncSetAttribute failed\n"); grid = -1; return; }
        (void)hipGetLastError();
        grid = cus;
    }
    if (grid < 0) return;
    if (hipMemsetAsync((char*)d_ws + WS_CTL, 0, CTL_ZERO_BYTES, stream) != hipSuccess) return;
    Args a{};
    for (int i = 0; i < 23; ++i) a.in[i] = (const float*)d_in[i];
    a.out = (float*)d_out; a.ws = (unsigned char*)d_ws;
    for (int li = 0; li < N_LAUNCHES; ++li) {
        a.ph_lo = (N_LAUNCHES == PER_PHASE) ? li : 0; a.ph_hi = (N_LAUNCHES == PER_PHASE) ? li + 1 : PER_PHASE; a.li = li;
        hipLaunchKernelGGL(hymba_fwd, dim3(grid), dim3(NWAVES * 64), LDS_BYTES, stream, a);
        const hipError_t le = hipPeekAtLastError();
        if (le != hipSuccess) { fprintf(stderr, "kernel_launch: launch %d failed: %s\n", li, hipGetErrorName(le)); break; }
    }
}
```

```cpp
#include <hip/hip_runtime.h>
#include <cstdio>
#include <cstdint>
namespace pg8 {
#define PG8_LAS __attribute__((address_space(3)))
typedef unsigned short bf16_t;
typedef short bf16x8 __attribute__((ext_vector_type(8)));
typedef float f32x4 __attribute__((ext_vector_type(4)));
typedef unsigned u32x4 __attribute__((ext_vector_type(4)));
constexpr int BM = 256, BK = 64, HALF = 128, HTB = HALF * BK * 2  , STAGE_BYTES = 8 * HTB, NXCD = 8, WGM = 8;

__host__ __device__ __forceinline__ int lds_byte(int r, int c) { const int st = (r >> 4) * 2 + (c >> 5), rr = r & 15, cc = c & 31, ob = rr * 64 + cc * 2; return st * 1024 + (ob ^ (((ob >> 9) & 1) << 5)); }
__host__ __device__ __forceinline__ void stage_rc(int b, int& R, int& C) { const int st = b / 1024, sb = b % 1024, swz = sb ^ (((sb >> 9) & 1) << 5); R = (st >> 1) * 16 + swz / 64; C = (st & 1) * 32 + (swz % 64) / 2; }
__host__ __device__ __forceinline__ int perm32(int rho) { const int n = rho >> 4, i = rho & 15; return 8 * (i >> 2) + 4 * n + (i & 3); }

struct Unit { int pm, pn; };
struct Gemm { const bf16_t* A; const bf16_t* Bt; int M, N, K; };

struct StaticOrder {
    int nM, nN, nwg, G, c;
    __host__ __device__ void init(int M, int N, int G_, int c_) { nM = M / BM; nN = N / BM; nwg = nM * nN; G = G_; c = c_; }
    __host__ __device__ bool next(int i, Unit& u) const {
        const long L = (long)i * G + c; if (L >= nwg) return false;
        int wgid = (int)L; { const int q = nwg / NXCD, r = nwg % NXCD, xcd = wgid % NXCD, off = wgid / NXCD; wgid = (xcd < r ? xcd * (q + 1) : r * (q + 1) + (xcd - r) * q) + off; }
        const int nig = WGM * nN, gid = wgid / nig, fm = gid * WGM, gsz = (nM - fm) < WGM ? (nM - fm) : WGM;
        u.pm = fm + ((wgid % nig) % gsz); u.pn = (wgid % nig) / gsz; return true;
    }
    __device__ __forceinline__ void a_ready(const Unit&) const {}
    __device__ __forceinline__ void done(const Unit&) const {}
};

__device__ __forceinline__ unsigned cvt_pk_bf16(float lo, float hi) { unsigned r; asm volatile("v_cvt_pk_bf16_f32 %0, %1, %2" : "=v"(r) : "v"(lo), "v"(hi)); return r; }
typedef float f32x2 __attribute__((ext_vector_type(2)));
template <class Epi, class Sched, bool ALIGN_EPI = false, bool SP2 = false>
__device__ __forceinline__ void gemm_phase(PG8_LAS unsigned char* lds, const Gemm g, const Sched& S, const Epi& E) {
    const int tid = threadIdx.x, wid = __builtin_amdgcn_readfirstlane(tid >> 6), lane = tid & 63, wr = wid >> 2, wc = wid & 3, fr = lane & 15, fq = lane >> 4;
    const int K = g.K, nt = K / BK;
    unsigned voffA[2], voffB[2];
#pragma unroll
    for (int i = 0; i < 2; ++i) { int R, C; stage_rc(tid * 16 + i * 8192, R, C); const int Rb = Epi::PERM ? ((R & ~31) + perm32(R & 31)) : R;
        voffA[i] = (unsigned)(R * K + C) * 2u; voffB[i] = (unsigned)(Rb * K + C) * 2u; }
    const size_t kstep = (size_t)(BK * 2);
    const size_t hstep = (size_t)HALF * K * 2;
    const size_t tstep = 2 * hstep;
    const unsigned ldsw = (unsigned)wid * 1024u;
    const int aoff = lds_byte(wr * 64 + fr, fq * 8), boff = lds_byte(wc * 32 + fr, fq * 8);
#define PG8_SA(b, h) (((b) * 2 + (h)) * HTB)
#define PG8_SB(b, h) ((4 + (b) * 2 + (h)) * HTB)
#define PG8_STAGE(bufoff, gbase, voff) do { _Pragma("unroll") for (int _i = 0; _i < 2; ++_i) \
        __builtin_amdgcn_global_load_lds((const unsigned*)((const char*)(gbase) + (voff)[_i]), (PG8_LAS unsigned*)(lds + (bufoff) + ldsw + _i * 8192), 16, 0, 0); } while (0)
#define PG8_LDA(dst, b, h) do { _Pragma("unroll") for (int m = 0; m < 4; ++m) _Pragma("unroll") for (int k = 0; k < 2; ++k) dst[m][k] = *(const PG8_LAS bf16x8*)(lds + PG8_SA(b, h) + aoff + m * 2048 + k * 1024); } while (0)
#define PG8_LDB(dst, b, h) do { _Pragma("unroll") for (int n = 0; n < 2; ++n) _Pragma("unroll") for (int k = 0; k < 2; ++k) dst[n][k] = *(const PG8_LAS bf16x8*)(lds + PG8_SB(b, h) + boff + n * 2048 + k * 1024); } while (0)
#define PG8_MMA(ai, bj, At, Bt) do { __builtin_amdgcn_s_setprio(1); _Pragma("unroll") for (int m = 0; m < 4; ++m) _Pragma("unroll") for (int n = 0; n < 2; ++n) _Pragma("unroll") for (int k = 0; k < 2; ++k) \
        acc[ai][bj][m][n] = __builtin_amdgcn_mfma_f32_16x16x32_bf16(Bt[n][k], At[m][k], acc[ai][bj][m][n], 0, 0, 0); __builtin_amdgcn_s_setprio(0); } while (0)
#define PG8_WAIT_V(n) asm volatile("s_waitcnt vmcnt(" #n ")" ::: "memory")
#define PG8_WAIT_L(n) asm volatile("s_waitcnt lgkmcnt(" #n ")" ::: "memory")
#define PG8_BAR __builtin_amdgcn_s_barrier()
#define PG8_SCHED __builtin_amdgcn_sched_barrier(0)
    Unit cur, nxt; int ui = 0;
    if (!S.next(0, cur)) return;
    f32x4 acc[2][2][4][2];
#pragma unroll
    for (int a = 0; a < 2; ++a)
#pragma unroll
        for (int b = 0; b < 2; ++b)
#pragma unroll
            for (int m = 0; m < 4; ++m)
#pragma unroll
                for (int n = 0; n < 2; ++n) acc[a][b][m][n] = (f32x4){0.f, 0.f, 0.f, 0.f};
    bf16x8 At[4][2], B0[2][2], B1[2][2];
    const char* cA = (const char*)g.A + (size_t)cur.pm * tstep; const char* cB = (const char*)g.Bt + (size_t)cur.pn * tstep;
    S.a_ready(cur);
    if constexpr (SP2) {
        PG8_STAGE(PG8_SB(0, 0), cB, voffB); PG8_STAGE(PG8_SB(0, 1), cB + hstep, voffB); PG8_STAGE(PG8_SA(0, 0), cA, voffA); PG8_STAGE(PG8_SA(0, 1), cA + hstep, voffA);
        if (wr == 1) PG8_BAR;
        PG8_WAIT_V(2); PG8_BAR;
        PG8_STAGE(PG8_SB(1, 0), cB + kstep, voffB); PG8_STAGE(PG8_SA(1, 0), cA + kstep, voffA); PG8_STAGE(PG8_SB(1, 1), cB + hstep + kstep, voffB);
        PG8_WAIT_V(6); PG8_BAR;
    } else {
        PG8_STAGE(PG8_SB(0, 0), cB, voffB); PG8_STAGE(PG8_SA(0, 0), cA, voffA); PG8_STAGE(PG8_SB(0, 1), cB + hstep, voffB); PG8_STAGE(PG8_SA(0, 1), cA + hstep, voffA);
        if (wr == 1) PG8_BAR;
        PG8_WAIT_V(4); PG8_BAR;
        PG8_STAGE(PG8_SB(1, 0), cB + kstep, voffB); PG8_STAGE(PG8_SA(1, 0), cA + kstep, voffA); PG8_STAGE(PG8_SB(1, 1), cB + hstep + kstep, voffB);
        PG8_WAIT_V(6); PG8_BAR;
    }
    for (;;) {
        const bool has_next = S.next(ui + 1, nxt);
        const char* nA = has_next ? (const char*)g.A + (size_t)nxt.pm * tstep : cA; const char* nB = has_next ? (const char*)g.Bt + (size_t)nxt.pn * tstep : cB;
        for (int t = 0; t < nt; t += 2) {
            const bool last = (t == nt - 2);
            const char* a1 = cA + (size_t)(t + 1) * kstep;
            const char* a2 = last ? nA : cA + (size_t)(t + 2) * kstep; const char* b2 = last ? nB : cB + (size_t)(t + 2) * kstep;
            const char* a3 = a2 + kstep; const char* b3 = b2 + kstep;
            if (last && has_next) S.a_ready(nxt);
            if constexpr (SP2) {
            PG8_LDB(B0, 0, 0); PG8_LDB(B1, 0, 1); PG8_SCHED; PG8_LDA(At, 0, 0); PG8_STAGE(PG8_SA(1, 1), a1 + hstep, voffA);
            PG8_WAIT_V(8); PG8_WAIT_L(0); PG8_BAR; PG8_MMA(0, 0, At, B0); PG8_MMA(0, 1, At, B1); PG8_BAR; PG8_SCHED;
            PG8_LDA(At, 0, 1); PG8_STAGE(PG8_SB(0, 0), b2, voffB); PG8_STAGE(PG8_SB(0, 1), b2 + hstep, voffB); PG8_STAGE(PG8_SA(0, 0), a2, voffA);
            PG8_WAIT_V(8); PG8_WAIT_L(0); PG8_BAR; PG8_MMA(1, 0, At, B0); PG8_MMA(1, 1, At, B1); PG8_BAR; PG8_SCHED;
            PG8_LDB(B0, 1, 0); PG8_LDB(B1, 1, 1); PG8_SCHED; PG8_LDA(At, 1, 0); PG8_STAGE(PG8_SA(0, 1), a2 + hstep, voffA);
            PG8_WAIT_V(8); PG8_WAIT_L(0); PG8_BAR; PG8_MMA(0, 0, At, B0); PG8_MMA(0, 1, At, B1); PG8_BAR; PG8_SCHED;
            PG8_LDA(At, 1, 1); PG8_STAGE(PG8_SB(1, 0), b3, voffB); PG8_STAGE(PG8_SB(1, 1), b3 + hstep, voffB); PG8_STAGE(PG8_SA(1, 0), a3, voffA);
            PG8_WAIT_V(8); PG8_WAIT_L(0); PG8_BAR; PG8_MMA(1, 0, At, B0); PG8_MMA(1, 1, At, B1); PG8_BAR; PG8_SCHED;
            } else {
            PG8_LDB(B0, 0, 0); PG8_SCHED; PG8_LDA(At, 0, 0); PG8_STAGE(PG8_SA(1, 1), a1 + hstep, voffA);
            PG8_WAIT_L(8); PG8_BAR; PG8_WAIT_L(0); PG8_MMA(0, 0, At, B0); PG8_BAR; PG8_SCHED;
            PG8_LDB(B1, 0, 1); PG8_STAGE(PG8_SB(0, 0), b2, voffB);
            PG8_BAR; PG8_WAIT_L(0); PG8_MMA(0, 1, At, B1); PG8_BAR;
            PG8_LDA(At, 0, 1); PG8_STAGE(PG8_SA(0, 0), a2, voffA);
            PG8_BAR; PG8_WAIT_L(0); PG8_MMA(1, 0, At, B0); PG8_BAR; PG8_SCHED;
            PG8_STAGE(PG8_SB(0, 1), b2 + hstep, voffB);
            PG8_WAIT_V(6); PG8_BAR; PG8_MMA(1, 1, At, B1); PG8_BAR;
            PG8_LDB(B0, 1, 0); PG8_SCHED; PG8_LDA(At, 1, 0); PG8_STAGE(PG8_SA(0, 1), a2 + hstep, voffA);
            PG8_WAIT_L(8); PG8_BAR; PG8_WAIT_L(0); PG8_MMA(0, 0, At, B0); PG8_BAR; PG8_SCHED;
            PG8_LDB(B1, 1, 1); PG8_STAGE(PG8_SB(1, 0), b3, voffB);
            PG8_BAR; PG8_WAIT_L(0); PG8_MMA(0, 1, At, B1); PG8_BAR;
            PG8_LDA(At, 1, 1); PG8_STAGE(PG8_SA(1, 0), a3, voffA);
            PG8_BAR; PG8_WAIT_L(0); PG8_MMA(1, 0, At, B0); PG8_BAR; PG8_SCHED;
            PG8_STAGE(PG8_SB(1, 1), b3 + hstep, voffB);
            PG8_WAIT_V(6); PG8_BAR; PG8_MMA(1, 1, At, B1); PG8_BAR;
            }
        }
        if constexpr (ALIGN_EPI) { if (wr == 0) PG8_BAR; }
        if constexpr (!Epi::AFTER_DRAIN) { E(acc, cur, wr, wc, fr, fq); S.done(cur); }
        if (!has_next) break;
#pragma unroll
        for (int a = 0; a < 2; ++a)
#pragma unroll
            for (int b = 0; b < 2; ++b)
#pragma unroll
                for (int m = 0; m < 4; ++m)
#pragma unroll
                    for (int n = 0; n < 2; ++n) acc[a][b][m][n] = (f32x4){0.f, 0.f, 0.f, 0.f};
        cur = nxt; cA = nA; cB = nB; ++ui;
        if constexpr (ALIGN_EPI) { if (wr == 1) PG8_BAR; }
    }
    PG8_WAIT_V(0);
    if constexpr (!ALIGN_EPI) { if (wr == 0) PG8_BAR; }
    PG8_BAR;
    if constexpr (Epi::AFTER_DRAIN) { E.fused(acc, cur, wr, wc, fr, fq, lds, wid, lane); S.done(cur); }
#undef PG8_SA
#undef PG8_SB
#undef PG8_STAGE
#undef PG8_LDA
#undef PG8_LDB
#undef PG8_MMA
#undef PG8_WAIT_V
#undef PG8_WAIT_L
#undef PG8_BAR
#undef PG8_SCHED
}
}

#define GAS __attribute__((address_space(1)))
#define LAS __attribute__((address_space(3)))
typedef unsigned short bf16;
typedef unsigned v4u __attribute__((ext_vector_type(4)));
typedef float f32x4 __attribute__((ext_vector_type(4)));
typedef short bf16x8 __attribute__((ext_vector_type(8)));
typedef GAS unsigned gu32;
typedef GAS unsigned long long gu64;
#define RLX_AGENT __ATOMIC_RELAXED, __HIP_MEMORY_SCOPE_AGENT
#define LDS_WAIT() asm volatile("s_waitcnt lgkmcnt(0)" ::: "memory")
#define VM_WAIT() asm volatile("s_waitcnt vmcnt(0)" ::: "memory")
__device__ __forceinline__ unsigned long long rt() { return __builtin_amdgcn_s_memrealtime(); }
__device__ __forceinline__ unsigned f2bf(float f) { unsigned u = __builtin_bit_cast(unsigned, f); return (u + 0x7fffu + ((u >> 16) & 1u)) >> 16; }
__device__ __forceinline__ unsigned pk2(float lo, float hi) { return f2bf(lo) | (f2bf(hi) << 16); }

#define XB_TMO      128
#define XB_XCNT(j)  (256  + 64 * (j))
#define XB_XSUB(j)  (1280 + 64 * (j))
#define XB_XGEN(j)  (2304 + 64 * (j))
#define XB_TOP      3328
#define XB_TOPGEN   3392
#define XCD_BAR_WORDS 3456
#define XB_SPIN_CAP (1u << 18)

__device__ __forceinline__ unsigned xb_ld(unsigned* p)              { return __hip_atomic_load(p, __ATOMIC_RELAXED, __HIP_MEMORY_SCOPE_AGENT); }
__device__ __forceinline__ unsigned xb_add(unsigned* p, unsigned v) { return __hip_atomic_fetch_add(p, v, __ATOMIC_RELAXED, __HIP_MEMORY_SCOPE_AGENT); }
__device__ __forceinline__ unsigned xb_xcc_id() { return (unsigned)__builtin_amdgcn_s_getreg((3 << 11) | 20) & 0xFu; }
#define XB_SPIN(cond, bar) do { unsigned _sp = 0; while (cond) { __builtin_amdgcn_s_sleep(1); \
    if ((++_sp & 255u) == 0u) { if (xb_ld(&(bar)[XB_TMO])) break; if (_sp > XB_SPIN_CAP) { atomicAdd(&(bar)[XB_TMO], 1u); break; } } } } while (0)

struct XcdBarrier {
    unsigned* bar; unsigned x;
    volatile LAS unsigned* st;
};

__device__ __forceinline__ XcdBarrier xcd_barrier_post(unsigned* bar, volatile LAS unsigned* st) {
    XcdBarrier b; b.bar = bar; b.x = xb_xcc_id(); b.st = st;
    if (threadIdx.x == 0) (void)xb_add(&bar[XB_XCNT(b.x)], 1u);
    return b;
}
__device__ __forceinline__ void xcd_barrier_complete(unsigned* bar, unsigned x, unsigned& nloc, unsigned& nx) {
    const unsigned G = gridDim.x * gridDim.y * gridDim.z;
    unsigned sum, cnt, mine, sp = 0u;
    for (;;) {
        sum = 0u; cnt = 0u; mine = 0u;
#pragma unroll
        for (unsigned j = 0; j < 16; ++j) { const unsigned c = xb_ld(&bar[XB_XCNT(j)]); sum += c; cnt += (c > 0u) ? 1u : 0u; mine = (j == x) ? c : mine; }
        if (sum == G) break;
        __builtin_amdgcn_s_sleep(1);
        if ((++sp & 255u) == 0u) { if (xb_ld(&bar[XB_TMO])) break; if (sp > XB_SPIN_CAP) { atomicAdd(&bar[XB_TMO], 1u); break; } }
    }
    nloc = mine > 0u ? mine : 1u; nx = cnt > 0u ? cnt : 1u;
}

__device__ __forceinline__ void xcd_barrier(const XcdBarrier& b) {
    asm volatile("s_waitcnt vmcnt(0)" ::: "memory");
    __syncthreads();
    if (threadIdx.x == 0) {
        unsigned* bar = b.bar;
        __builtin_amdgcn_s_waitcnt(0);
        unsigned nloc = b.st[0], nx = b.st[1];
        if (nloc == 0u) { xcd_barrier_complete(bar, b.x, nloc, nx); b.st[0] = nloc; b.st[1] = nx; }
        const unsigned old = xb_add(&bar[XB_XSUB(b.x)], 1u);
        const unsigned gen = old / nloc;
        if (old + 1u == (gen + 1u) * nloc) {
            __builtin_amdgcn_fence(__ATOMIC_RELEASE, "agent");
            asm volatile("s_waitcnt vmcnt(0)" ::: "memory");
            const unsigned og = xb_add(&bar[XB_TOP], 1u);
            const unsigned tg = og / nx;
            if (og + 1u == (tg + 1u) * nx) xb_add(&bar[XB_TOPGEN], 1u);
            else XB_SPIN(xb_ld(&bar[XB_TOPGEN]) == tg, bar);
            __builtin_amdgcn_fence(__ATOMIC_ACQUIRE, "agent");
            xb_add(&bar[XB_XGEN(b.x)], 1u);
            asm volatile("s_waitcnt vmcnt(0)" ::: "memory");
        } else {
            XB_SPIN(xb_ld(&bar[XB_XGEN(b.x)]) == gen, bar);
            __builtin_amdgcn_fence(__ATOMIC_ACQUIRE, "agent");
            asm volatile("s_waitcnt vmcnt(0)" ::: "memory");
        }
    }
    __syncthreads();
}


constexpr int NWAVES = 8;
#define DUP_SEL 0
#ifndef MK_N_LAUNCHES
#define MK_N_LAUNCHES 1
#endif
constexpr int PER_PHASE = 6;
constexpr int N_LAUNCHES = MK_N_LAUNCHES;

constexpr int DM = 1024, DIN = 3584, LP = 8192, LS = 2048, NBATCH = 8;
constexpr int MP = NBATCH * LP, MS = NBATCH * LS, MT = MP + MS;
constexpr int DHY = 384, NH = 6, NHM = 4, HD = 64, NMEM = 256, DMKV = 512;
constexpr int MMEM = 2 * NBATCH * NMEM;
constexpr float RMS_EPS = 1e-6f;

constexpr size_t MiB = 1u << 20;
constexpr size_t WS_CTL = 0, CTL_ZERO_BYTES = 1 * MiB;
constexpr size_t WS_WTIN = 2 * MiB;
constexpr size_t WS_WTOUT = 10 * MiB;
constexpr size_t WS_WTMKV = 12 * MiB;
constexpr size_t WS_MEMB = 13 * MiB;
constexpr size_t WS_KM = 21 * MiB;
constexpr size_t WS_VM = 23 * MiB;
constexpr size_t WS_H2P = 25 * MiB;
constexpr size_t WS_H2S = 27 * MiB;
constexpr size_t WS_BIAS = 28 * MiB;
constexpr size_t WS_GAINS = 28 * MiB + 65536;
constexpr size_t WS_RSTD = 28 * MiB + 262144;
constexpr size_t WS_CONSTS = 28 * MiB + 131072;
constexpr size_t WS_KSP = 29 * MiB;
constexpr size_t WS_KSS = 77 * MiB;
constexpr size_t WS_XB = 90 * MiB;
constexpr size_t WS_ST = 90 * MiB;
constexpr size_t WS_CT = 150 * MiB;
constexpr size_t WS_ZHY = 250 * MiB;
constexpr size_t WS_Q = 430 * MiB, WS_K = 490 * MiB, WS_V = 550 * MiB;
constexpr size_t WS_MQ = 610 * MiB;
constexpr size_t WS_MIX = 650 * MiB;
constexpr size_t WS_OC = 810 * MiB;
constexpr size_t WS_LC = 990 * MiB;
constexpr size_t WS_END = 996 * MiB;
static_assert(WS_VM - WS_KM >= (size_t)16 * 4 * 256 * 64 * 2 && WS_H2P - WS_VM >= (size_t)16 * 4 * 256 * 64 * 2 && WS_KSS - WS_KSP >= (size_t)384 * 2 * 8192 * 8 && WS_XB - WS_KSS >= (size_t)384 * 2 * 2048 * 8, "ws map");
static_assert(WS_ZHY - WS_XB >= (size_t)81920 * 1024 * 2 && WS_CT - WS_ST >= (size_t)81920 * 384 * 2 && WS_ZHY - WS_CT >= (size_t)81920 * 384 * 2 && WS_Q - WS_ZHY >= (size_t)81920 * 1152 * 2, "ws map");
static_assert(WS_K - WS_Q >= (size_t)81920 * 384 * 2 && WS_MQ - WS_V >= (size_t)81920 * 384 * 2 && WS_MIX - WS_MQ >= (size_t)81920 * 256 * 2 && WS_END - WS_MIX >= (size_t)81920 * 1024 * 2, "ws map");
constexpr int CW_TMO = 0, CW_CODE = 1, CW_BAR = 4096;

constexpr int RING_OFF = 0, RING_BYTES = 131072;
constexpr int LDS_BYTES = 147456;
constexpr int LDSCTL_OFF = LDS_BYTES - 512, MISC_OFF = LDSCTL_OFF + 320;

typedef float cf2 __attribute__((ext_vector_type(2)));
typedef unsigned u32x2 __attribute__((ext_vector_type(2)));
typedef unsigned u32x4 __attribute__((ext_vector_type(4)));

__device__ __forceinline__ float bf2f(unsigned short h) { return __builtin_bit_cast(float, (unsigned)h << 16); }
__device__ __forceinline__ float bflo(unsigned w) { return __builtin_bit_cast(float, w << 16); }
__device__ __forceinline__ float bfhi(unsigned w) { return __builtin_bit_cast(float, w & 0xffff0000u); }
__device__ __forceinline__ cf2 cmul(cf2 a, cf2 b) { return (cf2){a.x * b.x - a.y * b.y, a.x * b.y + a.y * b.x}; }
__device__ __forceinline__ cf2 cmulc(cf2 a, cf2 b) { return (cf2){a.x * b.x + a.y * b.y, a.y * b.x - a.x * b.y}; }

__device__ __forceinline__ int bb_rowbase(int bb) { return bb < 8 ? bb * LP : MP + (bb - 8) * LS; }
__device__ __forceinline__ int bb_len(int bb) { return bb < 8 ? LP : LS; }
__device__ __forceinline__ void row_to_bt(int row, int& bb, int& t) { if (row < MP) { bb = row >> 13; t = row & (LP - 1); } else { const int r = row - MP; bb = 8 + (r >> 11); t = r & (LS - 1); } }

struct Frame {
    LAS unsigned char* lds;
    volatile LAS unsigned* MISC;
    gu32* ctl;
    int tid, lane, wave, vcu, G;
    long woff;
    const float *xp, *xs, *memp, *mems, *norm_in, *w_in, *conv_w, *conv_b, *fw1, *fb1, *ffreq, *fw2, *fb2, *fw3, *skip, *gq, *gk, *mem_norm, *w_mkv, *gmq, *gmk, *w_out, *rel_bias;
    float* out;
    bf16 *WTin, *WTout, *WTmkv, *MEMB, *KM, *VM, *XB, *ST, *CT, *ZHY, *Q, *K, *V, *MQ, *MIX;
    float *H2P, *H2S, *BIAS, *GAINS, *CONSTS, *LC, *FBP, *FBS, *RSTD; bf16* OC;
    cf2 *KSP, *KSS;
};

namespace pg8 {
__device__ __forceinline__ u32x4 pack8(f32x4 a, f32x4 b) { u32x4 w; w.x = cvt_pk_bf16(a[0], a[1]); w.y = cvt_pk_bf16(a[2], a[3]); w.z = cvt_pk_bf16(b[0], b[1]); w.w = cvt_pk_bf16(b[2], b[3]); return w; }
__device__ __forceinline__ float dot4(f32x4 a) { return (a[0] * a[0] + a[1] * a[1]) + (a[2] * a[2] + a[3] * a[3]); }
__device__ __forceinline__ float lane_xor1(float x) { return __builtin_bit_cast(float, __builtin_amdgcn_mov_dpp(__builtin_bit_cast(int, x), 0xB1, 0xF, 0xF, true)); }
__device__ __forceinline__ float asm_add(unsigned a, unsigned b) { float r; asm("v_add_f32_e32 %0, %1, %2" : "=v"(r) : "v"(a), "v"(b)); return r; }
__device__ __forceinline__ float sum_rows4(float x) {
    const unsigned x0 = __builtin_bit_cast(unsigned, x);
    const auto a = __builtin_amdgcn_permlane16_swap(x0, x0, false, false);
    const float y = asm_add(a[0], a[1]);
    const unsigned y0 = __builtin_bit_cast(unsigned, y);
    const auto b = __builtin_amdgcn_permlane32_swap(y0, y0, false, false);
    return asm_add(b[0], b[1]);
}
__device__ __forceinline__ float silu_f(float x) { return x * __builtin_amdgcn_rcpf(1.0f + __builtin_amdgcn_exp2f(-1.4426950408889634f * x)); }
__device__ __forceinline__ f32x4 silu4(f32x4 a) { return (f32x4){silu_f(a[0]), silu_f(a[1]), silu_f(a[2]), silu_f(a[3])}; }

template <int TM = 7> struct EpiZT {
    static constexpr bool PERM = true, AFTER_DRAIN = false;
    unsigned char* ws; const float* gains;
    __device__ __forceinline__ void operator()(const f32x4 (&acc)[2][2][4][2], const Unit& u, int wr, int wc, int fr, int fq) const {
        const int G = u.pn * 4 + wc, hc0 = 8 * fq;
        const int row0 = u.pm * BM + wr * 64 + fr;
        int bb, t0; row_to_bt(u.pm * BM, bb, t0);
        const int rb = bb_rowbase(bb), L = bb_len(bb);
        const bool live = (G < 18) ? (TM & 1) : (G < 40) ? (TM & 2) : (TM & 4);
        if (!live) {
#pragma unroll
            for (int ai = 0; ai < 2; ++ai)
#pragma unroll
                for (int m = 0; m < 4; ++m)
#pragma unroll
                    for (int bj = 0; bj < 2; ++bj)
#pragma unroll
                        for (int n = 0; n < 2; ++n) asm volatile("" :: "v"(acc[ai][bj][m][n]));
        } else if (G < 18) {
            const bool odd = fr & 1;
            bf16_t* zt = (bf16_t*)(ws + WS_ZHY) + (size_t)rb * 1152 + (size_t)(G * 64 + hc0 + (odd ? 32 : 0)) * L;
#pragma unroll
            for (int ai = 0; ai < 2; ++ai)
#pragma unroll
                for (int m = 0; m < 4; ++m) { const int te = (row0 + ai * HALF + m * 16 - rb) & ~1;
#pragma unroll
                    for (int k = 0; k < 8; ++k) { const float lo = acc[ai][0][m][k >> 2][k & 3], hi = acc[ai][1][m][k >> 2][k & 3];
                        const float send = odd ? lo : hi, recv = lane_xor1(send);
                        *(unsigned*)(zt + (size_t)k * L + te) = cvt_pk_bf16(odd ? recv : lo, odd ? hi : recv); } }
        } else if (G < 40) {
            const bool ismq = G >= 36;
            const int part = ismq ? 0 : (G - 18) / 6;
            const int h = ismq ? G - 36 : (G - 18) - 6 * part;
            const bool isv = (part == 2);
            const int nh = ismq ? NHM : NH;
            bf16_t* base = (bf16_t*)(ws + (ismq ? WS_MQ : WS_Q + (size_t)part * (WS_K - WS_Q)));
            const float* gain = gains + (ismq ? 128 : (part == 0 ? 0 : 64));
            const float scale = (ismq || part == 0) ? 0.125f * 1.4426950408889634f : 1.0f;
            if (isv) {
#pragma unroll
                for (int ai = 0; ai < 2; ++ai)
#pragma unroll
                    for (int m = 0; m < 4; ++m) { const int row = row0 + ai * HALF + m * 16; const int t = row - rb;
                        bf16_t* d = base + ((size_t)rb * nh + (size_t)h * L + t) * 64 + hc0;
                        *(u32x4*)d = pack8(acc[ai][0][m][0], acc[ai][0][m][1]); *(u32x4*)(d + 32) = pack8(acc[ai][1][m][0], acc[ai][1][m][1]); }
            } else {
                const f32x4 g0 = *(const f32x4*)(gain + hc0), g1 = *(const f32x4*)(gain + hc0 + 4), g2 = *(const f32x4*)(gain + 32 + hc0), g3 = *(const f32x4*)(gain + 36 + hc0);
#pragma unroll
                for (int ai = 0; ai < 2; ++ai)
#pragma unroll
                    for (int m = 0; m < 4; ++m) { const int row = row0 + ai * HALF + m * 16; const int t = row - rb;
                        f32x4 a0 = acc[ai][0][m][0], a1 = acc[ai][0][m][1], b0 = acc[ai][1][m][0], b1 = acc[ai][1][m][1];
                        const float ss = sum_rows4((dot4(a0) + dot4(a1)) + (dot4(b0) + dot4(b1)));
                        const float r = __builtin_amdgcn_rsqf(ss * (1.0f / 64.0f) + RMS_EPS) * scale;
                        a0 = a0 * r * g0; a1 = a1 * r * g1; b0 = b0 * r * g2; b1 = b1 * r * g3;
                        bf16_t* d = base + ((size_t)rb * nh + (size_t)h * L + t) * 64 + hc0;
                        *(u32x4*)d = pack8(a0, a1); *(u32x4*)(d + 32) = pack8(b0, b1); }
            }
        } else {
            const int col = (G - 40) * 64 + hc0;
#pragma unroll
            for (int ai = 0; ai < 2; ++ai)
#pragma unroll
                for (int m = 0; m < 4; ++m) { const int row = row0 + ai * HALF + m * 16; bf16_t* d = (bf16_t*)(ws + WS_MIX) + (size_t)row * DM + col;
                    *(u32x4*)d = pack8(silu4(acc[ai][0][m][0]), silu4(acc[ai][0][m][1])); *(u32x4*)(d + 32) = pack8(silu4(acc[ai][1][m][0]), silu4(acc[ai][1][m][1])); }
        }
    }
};
typedef EpiZT<7> EpiZ;
struct EpiMKV {
    static constexpr bool PERM = true, AFTER_DRAIN = false;
    bf16_t* km; const float* gmk;
    __device__ __forceinline__ void operator()(const f32x4 (&acc)[2][2][4][2], const Unit& u, int wr, int wc, int fr, int fq) const {
        const int G = u.pn * 4 + wc, hc0 = 8 * fq, h = G & 3; const bool isk = G < 4;
        const int row0 = u.pm * BM + wr * 64 + fr;
        bf16_t* basep = km + (isk ? (size_t)0 : (size_t)(WS_VM - WS_KM) / 2) + hc0;
        if (!isk) {
#pragma unroll
            for (int ai = 0; ai < 2; ++ai)
#pragma unroll
                for (int m = 0; m < 4; ++m) { const int row = row0 + ai * HALF + m * 16; const int bbm = row >> 8, j = row & 255;
                    bf16_t* d = basep + ((size_t)(bbm * NHM + h) * NMEM + j) * 64;
                    *(u32x4*)d = pack8(acc[ai][0][m][0], acc[ai][0][m][1]); *(u32x4*)(d + 32) = pack8(acc[ai][1][m][0], acc[ai][1][m][1]); }
        } else {
            const f32x4 g0 = *(const f32x4*)(gmk + hc0), g1 = *(const f32x4*)(gmk + hc0 + 4), g2 = *(const f32x4*)(gmk + 32 + hc0), g3 = *(const f32x4*)(gmk + 36 + hc0);
#pragma unroll
            for (int ai = 0; ai < 2; ++ai)
#pragma unroll
                for (int m = 0; m < 4; ++m) { const int row = row0 + ai * HALF + m * 16; const int bbm = row >> 8, j = row & 255;
                    f32x4 a0 = acc[ai][0][m][0], a1 = acc[ai][0][m][1], b0 = acc[ai][1][m][0], b1 = acc[ai][1][m][1];
                    const float ss = sum_rows4((dot4(a0) + dot4(a1)) + (dot4(b0) + dot4(b1)));
                    const float r = __builtin_amdgcn_rsqf(ss * (1.0f / 64.0f) + RMS_EPS);
                    a0 = a0 * r * g0; a1 = a1 * r * g1; b0 = b0 * r * g2; b1 = b1 * r * g3;
                    bf16_t* d = basep + ((size_t)(bbm * NHM + h) * NMEM + j) * 64;
                    *(u32x4*)d = pack8(a0, a1); *(u32x4*)(d + 32) = pack8(b0, b1); }
        }
    }
};
struct EpiOut {
    static constexpr bool PERM = false, AFTER_DRAIN = false;
    const bf16_t* xb; const float* rstd; float* out; float osc;
    __device__ __forceinline__ void operator()(const f32x4 (&acc)[2][2][4][2], const Unit& u, int wr, int wc, int fr, int fq) const {
        const int row0 = u.pm * BM + wr * 64 + fr, col0 = u.pn * BM + wc * 32 + 4 * fq;
        u32x2 w[2][4][2][2]; float rms[2][4];
#pragma unroll
        for (int ai = 0; ai < 2; ++ai)
#pragma unroll
            for (int m = 0; m < 4; ++m) { const int row = row0 + ai * HALF + m * 16; rms[ai][m] = rstd[row];
#pragma unroll
                for (int bj = 0; bj < 2; ++bj)
#pragma unroll
                    for (int n = 0; n < 2; ++n) w[ai][m][bj][n] = *(const u32x2*)(xb + (size_t)row * DM + col0 + bj * HALF + n * 16); }
#pragma unroll
        for (int ai = 0; ai < 2; ++ai)
#pragma unroll
            for (int m = 0; m < 4; ++m) { const int row = row0 + ai * HALF + m * 16; const float r = 1.0f / rms[ai][m]; const size_t ro = (size_t)row * DM + col0;
#pragma unroll
                for (int bj = 0; bj < 2; ++bj)
#pragma unroll
                    for (int n = 0; n < 2; ++n) { const u32x2 ww = w[ai][m][bj][n];
                        const f32x4 x0 = {__builtin_bit_cast(float, ww.x << 16), __builtin_bit_cast(float, ww.x & 0xffff0000u), __builtin_bit_cast(float, ww.y << 16), __builtin_bit_cast(float, ww.y & 0xffff0000u)};
                        *(f32x4*)(out + ro + bj * HALF + n * 16) = (x0 * r + acc[ai][bj][m][n]) * osc; } }
    }
};
struct EpiNull { static constexpr bool PERM = false, AFTER_DRAIN = false;
    __device__ __forceinline__ void operator()(const f32x4 (&acc)[2][2][4][2], const Unit& u, int wr, int wc, int fr, int fq) const {
#pragma unroll
        for (int ai = 0; ai < 2; ++ai)
#pragma unroll
            for (int m = 0; m < 4; ++m)
#pragma unroll
                for (int bj = 0; bj < 2; ++bj)
#pragma unroll
                    for (int n = 0; n < 2; ++n) asm volatile("" :: "v"(acc[ai][bj][m][n])); } };
struct EpiStoreOnly { static constexpr bool PERM = false, AFTER_DRAIN = false; float* out;
    __device__ __forceinline__ void operator()(const f32x4 (&acc)[2][2][4][2], const Unit& u, int wr, int wc, int fr, int fq) const {
        const int row0 = u.pm * BM + wr * 64 + fr, col0 = u.pn * BM + wc * 32 + 4 * fq; float* o = out + (size_t)row0 * DM;
#pragma unroll
        for (int ai = 0; ai < 2; ++ai)
#pragma unroll
            for (int m = 0; m < 4; ++m) { const size_t ro = (size_t)(ai * HALF + m * 16) * DM + col0;
#pragma unroll
                for (int bj = 0; bj < 2; ++bj)
#pragma unroll
                    for (int n = 0; n < 2; ++n) *(f32x4*)(o + ro + bj * HALF + n * 16) = acc[ai][bj][m][n]; } } };
}

__device__ __forceinline__ float wave_sum(float v) {
#pragma unroll
    for (int o = 1; o < 64; o <<= 1) v += __shfl_xor(v, o);
    return v;
}
__device__ __forceinline__ int head_perm(int n) { const int o = n & 255; return (n & ~255) + 128 * ((o >> 5) & 1) + 32 * (o >> 6) + (o & 31); }
template <bool HP, bool GAIN>
__device__ __forceinline__ void p0_transpose_item(const float* W, const float* gain, int K, int N, bf16* WT, LAS float* scr, int item, int lane) {
    const int nblk = N / 32, kb = item / nblk, nb = item % nblk, k0 = 64 * kb, n0 = 32 * nb;
    float wv[32], gv[32];
#pragma unroll
    for (int i = 0; i < 32; ++i) { const int kk = 2 * i + (lane >> 5); wv[i] = W[(size_t)(k0 + kk) * N + n0 + (lane & 31)]; gv[i] = GAIN ? gain[k0 + kk] : 1.0f; }
#pragma unroll
    for (int i = 0; i < 32; ++i) { const int kk = 2 * i + (lane >> 5); scr[kk * 33 + (lane & 31)] = GAIN ? wv[i] * gv[i] : wv[i]; }
    LDS_WAIT(); asm volatile("" ::: "memory");
    const int c = lane & 7;
#pragma unroll
    for (int j = 0; j < 4; ++j) { const int n = (lane >> 3) + 8 * j; const LAS float* s = scr + (8 * c) * 33 + n;
        v4u o; o.x = pk2(s[0 * 33], s[1 * 33]); o.y = pk2(s[2 * 33], s[3 * 33]); o.z = pk2(s[4 * 33], s[5 * 33]); o.w = pk2(s[6 * 33], s[7 * 33]);
        const int rowo = HP ? head_perm(n0 + n) : (n0 + n);
        *(GAS v4u*)(WT + (size_t)rowo * K + k0 + 8 * c) = o; }
    LDS_WAIT(); asm volatile("" ::: "memory");
}
template <int NR>
__device__ __forceinline__ void rms_rows_pipe(int lane, const float* src, bf16* dst, float* rstd_out, int g0, int gstep, int ng) {
    if (g0 >= ng) return;
    f32x4 v[NR][4], w[NR][4];
    { const GAS f32x4* xr = (const GAS f32x4*)(src + (size_t)g0 * NR * DM) + lane;
#pragma unroll
      for (int i = 0; i < NR; ++i)
#pragma unroll
          for (int j = 0; j < 4; ++j) v[i][j] = __builtin_nontemporal_load(xr + i * (DM / 4) + 64 * j); }
    for (int g = g0; g < ng; g += gstep) {
        const int gn = g + gstep < ng ? g + gstep : g;
        { const GAS f32x4* xr = (const GAS f32x4*)(src + (size_t)gn * NR * DM) + lane;
#pragma unroll
          for (int i = 0; i < NR; ++i)
#pragma unroll
              for (int j = 0; j < 4; ++j) w[i][j] = __builtin_nontemporal_load(xr + i * (DM / 4) + 64 * j); }
#pragma unroll
        for (int i = 0; i < NR; ++i) { float s = 0.f;
#pragma unroll
            for (int j = 0; j < 4; ++j) s += (v[i][j].x * v[i][j].x + v[i][j].y * v[i][j].y) + (v[i][j].z * v[i][j].z + v[i][j].w * v[i][j].w);
            const float rstd = 1.0f / sqrtf(wave_sum(s) * (1.f / DM) + RMS_EPS);
            if (rstd_out && lane == 0) rstd_out[(size_t)g * NR + i] = rstd;
            GAS unsigned long long* o8 = (GAS unsigned long long*)(dst + ((size_t)g * NR + i) * DM) + lane;
#pragma unroll
            for (int j = 0; j < 4; ++j) o8[64 * j] = (unsigned long long)pk2(v[i][j].x * rstd, v[i][j].y * rstd) | ((unsigned long long)pk2(v[i][j].z * rstd, v[i][j].w * rstd) << 32); }
#pragma unroll
        for (int i = 0; i < NR; ++i)
#pragma unroll
            for (int j = 0; j < 4; ++j) v[i][j] = w[i][j];
    }
}
__device__ __forceinline__ void h2_row(const Frame& F, int t, int L, float* h2) {
    const int j = F.lane;
    const int bi = j & 15;
    const float band = 1e-4f + (float)bi * ((15.0f - 1e-4f) / 15.0f);
    const float xarg = 2.0f * ((float)t * band) / (float)L;
    float sn, cs; sincospif(xarg, &sn, &cs);
    const float tt = (float)t / (float)(L - 1);
    float a = tt * F.fw1[j] + F.fb1[j];
#pragma unroll
    for (int i = 0; i < 16; ++i) { const float c = __shfl(cs, i), s = -__shfl(sn, i); a += c * F.fw1[(1 + i) * 64 + j] + s * F.fw1[(17 + i) * 64 + j]; }
    const float fr = F.ffreq[j];
    const float h1 = sinf(fr * a);
    float b = F.fb2[j];
#pragma unroll 8
    for (int i = 0; i < 64; ++i) b += __shfl(h1, i) * F.fw2[i * 64 + j];
    h2[(size_t)t * 64 + j] = sinf(fr * b);
}
__device__ __forceinline__ int t5_bucket_dev(int rel) {
    const int n = rel < 0 ? -rel : rel;
    int b = n < 8 ? n : n < 15 ? 8 : n < 27 ? 9 : n < 50 ? 10 : n < 91 ? 11 : n < 166 ? 12 : n < 305 ? 13 : n < 559 ? 14 : 15;
    return b + (rel > 0 ? 16 : 0);
}
__device__ __forceinline__ void p0_prologue(Frame& F) {
    LAS float* scr = (LAS float*)(F.lds + RING_OFF + F.wave * 16384);
    const int gw = F.vcu * NWAVES + F.wave, NGW = F.G * NWAVES;
    constexpr int I_IN = (DM / 64) * (DIN / 32), I_OUT = (DM / 64) * (DM / 32), I_MKV = (DM / 64) * (DMKV / 32);
    constexpr int NITEMS = I_IN + I_OUT + I_MKV;
    for (int it = gw; it < NITEMS; it += NGW) {
        int r = it;
        if (r < I_IN) { p0_transpose_item<true, true>(F.w_in, F.norm_in, DM, DIN, F.WTin, scr, r, F.lane); continue; } r -= I_IN;
        if (r < I_OUT) { p0_transpose_item<false, false>(F.w_out, nullptr, DM, DM, F.WTout, scr, r, F.lane); continue; } r -= I_OUT;
        p0_transpose_item<true, true>(F.w_mkv, F.mem_norm, DM, DMKV, F.WTmkv, scr, r, F.lane);
    }
    rms_rows_pipe<4>(F.lane, F.xp, F.XB, F.RSTD, gw, NGW, MP / 4);
    rms_rows_pipe<4>(F.lane, F.xs, F.XB + (size_t)MP * DM, F.RSTD + MP, gw, NGW, MS / 4);
    rms_rows_pipe<2>(F.lane, F.memp, F.MEMB, nullptr, gw, NGW, MMEM / 4);
    rms_rows_pipe<2>(F.lane, F.mems, F.MEMB + (size_t)(MMEM / 2) * DM, nullptr, gw, NGW, MMEM / 4);
    for (int t = gw; t < LP + LS; t += NGW) { if (t < LP) h2_row(F, t, LP, F.H2P); else h2_row(F, t - LP, LS, F.H2S); }
    if (gw == 1) { F.GAINS[F.lane] = F.gq[F.lane]; F.GAINS[64 + F.lane] = F.gk[F.lane]; F.GAINS[128 + F.lane] = F.gmq[F.lane]; F.GAINS[192 + F.lane] = F.gmk[F.lane]; }
    if (gw == 2) { float a = fabsf(F.gq[F.lane]), b = fabsf(F.gk[F.lane]), c = fabsf(F.gmq[F.lane]), d = fabsf(F.gmk[F.lane]);
        float e = fmaxf(fmaxf(fabsf(F.rel_bias[F.lane]), fabsf(F.rel_bias[64 + F.lane])), fabsf(F.rel_bias[128 + F.lane]));
#pragma unroll
        for (int o = 1; o < 64; o <<= 1) { a = fmaxf(a, __shfl_xor(a, o)); b = fmaxf(b, __shfl_xor(b, o)); c = fmaxf(c, __shfl_xor(c, o)); d = fmaxf(d, __shfl_xor(d, o)); e = fmaxf(e, __shfl_xor(e, o)); }
        if (F.lane == 0) { F.CONSTS[0] = (8.0f * a * b * 1.01f + e) * 1.4426950408889634f; F.CONSTS[1] = (8.0f * c * d * 1.01f) * 1.4426950408889634f; } }
    if (gw == 0) { for (int e = F.lane; e < 3 * NH * 129; e += 64) { const int c = e / (NH * 129), h = (e / 129) % NH, jj = e % 129; const int d = c == 0 ? 1 : c == 1 ? 4 : 16;
            F.BIAS[e] = F.rel_bias[t5_bucket_dev((jj - 64) * d) * NH + h]; } }
}

__device__ __forceinline__ int XI(int i) { return i + ((i >> 5) << 1); }
constexpr int NTW = 8192, NTWE = 512;
__device__ __forceinline__ cf2 root16(int k) {
    static constexpr float c[8] = {1.0f, 0.92387953251128674f, 0.70710678118654752f, 0.38268343236508977f, 0.0f, -0.38268343236508977f, -0.70710678118654752f, -0.92387953251128674f};
    static constexpr float s[8] = {0.0f, 0.38268343236508977f, 0.70710678118654752f, 0.92387953251128674f, 1.0f, 0.92387953251128674f, 0.70710678118654752f, 0.38268343236508977f};
    return (cf2){c[k], -s[k]};
}
__device__ __forceinline__ void root16_ri(int k, float& c, float& s) {
    const float cc[8] = {1.0f, 0.92387953251128674f, 0.70710678118654752f, 0.38268343236508977f, 0.0f, -0.38268343236508977f, -0.70710678118654752f, -0.92387953251128674f};
    const float ss[8] = {0.0f, 0.38268343236508977f, 0.70710678118654752f, 0.92387953251128674f, 1.0f, 0.92387953251128674f, 0.70710678118654752f, 0.38268343236508977f};
    c = cc[k]; s = -ss[k];
}
__device__ __forceinline__ cf2 c_add(cf2 a, cf2 b) { cf2 r; asm("v_pk_add_f32 %0, %1, %2" : "=v"(r) : "v"(a), "v"(b)); return r; }
__device__ __forceinline__ cf2 c_sub(cf2 a, cf2 b) { cf2 r; asm("v_pk_add_f32 %0, %1, %2 neg_lo:[0,1] neg_hi:[0,1]" : "=v"(r) : "v"(a), "v"(b)); return r; }
__device__ __forceinline__ cf2 c_sub_mi(cf2 a, cf2 b) { cf2 r; asm("v_pk_add_f32 %0, %1, %2 op_sel:[1,1] op_sel_hi:[0,0] neg_lo:[0,1] neg_hi:[1,0]" : "=v"(r) : "v"(a), "v"(b)); return r; }
__device__ __forceinline__ cf2 c_add_pi(cf2 a, cf2 b) { cf2 r; asm("v_pk_add_f32 %0, %1, %2 op_sel:[0,1] op_sel_hi:[1,0] neg_lo:[0,1]" : "=v"(r) : "v"(a), "v"(b)); return r; }
__device__ __forceinline__ cf2 c_sub_pi(cf2 a, cf2 b) { cf2 r; asm("v_pk_add_f32 %0, %1, %2 op_sel:[0,1] op_sel_hi:[1,0] neg_hi:[0,1]" : "=v"(r) : "v"(a), "v"(b)); return r; }
__device__ __forceinline__ cf2 c_mul(cf2 d, cf2 w) { cf2 r;
    asm("v_pk_mul_f32 %0, %1, %2 op_sel_hi:[0,1]\n\tv_pk_fma_f32 %0, %1, %2, %0 op_sel:[1,1,0] op_sel_hi:[1,0,1] neg_lo:[1,0,0]" : "=&v"(r) : "v"(d), "v"(w)); return r; }
__device__ __forceinline__ cf2 c_mulc(cf2 x, cf2 w) { cf2 r;
    asm("v_pk_mul_f32 %0, %1, %2 op_sel_hi:[0,1]\n\tv_pk_fma_f32 %0, %1, %2, %0 op_sel:[1,1,0] op_sel_hi:[1,0,1] neg_hi:[0,0,1]" : "=&v"(r) : "v"(x), "v"(w)); return r; }
template <int S, bool INV, bool T1ONE>
__device__ __forceinline__ void bfly(cf2 (&v)[1 << S], cf2 t1) {
    constexpr int R = 1 << S;
    cf2 tp[S]; tp[0] = t1;
    if (!T1ONE) {
#pragma unroll
        for (int s = 1; s < S; ++s) tp[s] = c_mul(tp[s - 1], tp[s - 1]); }
#pragma unroll
    for (int ss = 0; ss < S; ++ss) { const int s = INV ? S - 1 - ss : ss; const int half = R >> (s + 1);
        cf2 w[R / 2];
#pragma unroll
        for (int q = 0; q < half; ++q) { const int k16 = q * (8 / half);
            if (k16 == 0) w[q] = T1ONE ? (cf2){1.f, 0.f} : tp[s];
            else if (k16 == 4) w[q] = T1ONE ? (cf2){0.f, -1.f} : (cf2){tp[s].y, -tp[s].x};
            else w[q] = T1ONE ? root16(k16) : c_mul(tp[s], root16(k16)); }
#pragma unroll
        for (int r = 0; r < R; ++r) if ((r % (2 * half)) < half) { const int q = r % half, k16 = q * (8 / half);
            const cf2 u = v[r], x = v[r + half];
            if (!INV) {
                v[r] = c_add(u, x);
                if (T1ONE && k16 == 0) v[r + half] = c_sub(u, x);
                else if (T1ONE && k16 == 4) v[r + half] = c_sub_mi(u, x);
                else v[r + half] = c_mul(c_sub(u, x), w[q]);
            } else {
                if (T1ONE && k16 == 0) { v[r] = c_add(u, x); v[r + half] = c_sub(u, x); }
                else if (T1ONE && k16 == 4) { v[r] = c_add_pi(u, x); v[r + half] = c_sub_pi(u, x); }
                else { const cf2 y = c_mulc(x, w[q]); v[r] = c_add(u, y); v[r + half] = c_sub(u, y); }
            } } }
}
template <int S, int LSTR, bool INV, bool NOV = false>
__device__ __forceinline__ void fft_pass(LAS cf2* x, const LAS cf2* tw, int N, int tl, int NT) {
    constexpr int R = 1 << S, stride = 1 << LSTR;
    for (int g = tl; g < (N >> S); g += NT) {
        const int j0 = g & (stride - 1), base = ((g >> LSTR) << (LSTR + S)) + j0;
        cf2 v[R];
#pragma unroll
        for (int r = 0; r < R; ++r) v[r] = x[XI(base + r * stride)];
        if (!NOV) { if (LSTR == 0) bfly<S, INV, true>(v, (cf2){1.f, 0.f});
        else bfly<S, INV, false>(v, tw[j0 << (13 - S - LSTR)]); }
#pragma unroll
        for (int r = 0; r < R; ++r) x[XI(base + r * stride)] = v[r];
    }
}
#define WAVE_LDS_FENCE() asm volatile("s_waitcnt lgkmcnt(0)" ::: "memory")
template <int S, bool NOV = false>
__device__ __forceinline__ void fft_mid(LAS cf2* x, const cf2 (&kreg)[16], int N, int tl, int NT) {
    constexpr int R = 1 << S;
#pragma unroll
    for (int i = 0; i < 16 / R; ++i) { const int g = tl * (16 / R) + i;
        cf2 v[R];
#pragma unroll
        for (int r = 0; r < R; ++r) v[r] = x[XI(g * R) + r];
        if (!NOV) bfly<S, false, true>(v, (cf2){1.f, 0.f});
#pragma unroll
        for (int r = 0; r < R; ++r) v[r] = c_mul(v[r], kreg[i * R + r]);
        if (!NOV) bfly<S, true, true>(v, (cf2){1.f, 0.f});
#pragma unroll
        for (int r = 0; r < R; ++r) x[XI(g * R) + r] = v[r];
    }
}
template <int LOGN, bool NOV = false>
__device__ __forceinline__ void fft_conv(cf2 (&v)[16], LAS cf2* x, const LAS cf2* tw, const cf2* Kg, int tl) {
    constexpr int N = 1 << LOGN, NT = N >> 4;
    const cf2 t1 = tw[tl << (13 - LOGN)];
    if (!NOV) bfly<4, false, false>(v, t1);
    __syncthreads();
#pragma unroll
    for (int r = 0; r < 16; ++r) x[XI(tl + r * NT)] = v[r];
    cf2 kreg[16];
#pragma unroll
    for (int i = 0; i < 16; ++i) kreg[i] = Kg[tl * 16 + i];
    __syncthreads();
    fft_pass<4, LOGN - 8, false, NOV>(x, tw, N, tl, NT);
    WAVE_LDS_FENCE();
    if (LOGN == 13) { fft_pass<4, 1, false, NOV>(x, tw, N, tl, NT); WAVE_LDS_FENCE(); fft_mid<1, NOV>(x, kreg, N, tl, NT); WAVE_LDS_FENCE(); fft_pass<4, 1, true, NOV>(x, tw, N, tl, NT); }
    else { fft_mid<3, NOV>(x, kreg, N, tl, NT); }
    WAVE_LDS_FENCE();
    fft_pass<4, LOGN - 8, true, NOV>(x, tw, N, tl, NT);
    __syncthreads();
#pragma unroll
    for (int r = 0; r < 16; ++r) v[r] = x[XI(tl + r * NT)];
    if (!NOV) bfly<4, true, false>(v, t1);
}
template <int LOGN>
__device__ __forceinline__ void fft_fwd_store(cf2 (&v)[16], LAS cf2* x, const LAS cf2* tw, cf2* Kout, int tl) {
    constexpr int N = 1 << LOGN, NT = N >> 4;
    const cf2 t1 = tw[tl << (13 - LOGN)];
    bfly<4, false, false>(v, t1);
    __syncthreads();
#pragma unroll
    for (int r = 0; r < 16; ++r) x[XI(tl + r * NT)] = v[r];
    __syncthreads();
    fft_pass<4, LOGN - 8, false>(x, tw, N, tl, NT);
    if (LOGN == 13) { WAVE_LDS_FENCE(); fft_pass<4, 1, false>(x, tw, N, tl, NT); __syncthreads(); fft_pass<1, 0, false>(x, tw, N, tl, NT); }
    else { __syncthreads(); fft_pass<3, 0, false>(x, tw, N, tl, NT); }
    __syncthreads();
    for (int i = tl; i < N; i += NT) Kout[i] = x[XI(i)];
}
constexpr int FFT_XG = 8192 + 512;
constexpr int FFT_X = 0, FFT_TW = FFT_XG * 8, FFT_SCR = FFT_TW + NTWE * 8, FFT_SPK = FFT_SCR + 32768, FFT_AUX = FFT_SPK + 32768;
static_assert(FFT_AUX + 4096 <= LDSCTL_OFF, "FFT LDS map");
__device__ __forceinline__ void fft_init_tw(Frame& F) {
    LAS cf2* tw = (LAS cf2*)(F.lds + FFT_TW);
    for (int k = F.tid; k < NTWE; k += NWAVES * 64) { float s, c; sincospif((float)k * (2.0f / NTW), &s, &c); tw[k] = (cf2){c, -s}; }
    __syncthreads();
}
__device__ __forceinline__ cf2 root32(int r) {
    static constexpr float c[16] = {1.0f, 0.98078528040323043f, 0.92387953251128674f, 0.83146961230254524f, 0.70710678118654752f, 0.55557023301960218f, 0.38268343236508977f, 0.19509032201612825f,
                         0.0f, -0.19509032201612825f, -0.38268343236508977f, -0.55557023301960218f, -0.70710678118654752f, -0.83146961230254524f, -0.92387953251128674f, -0.98078528040323043f};
    static constexpr float s[16] = {0.0f, 0.19509032201612825f, 0.38268343236508977f, 0.55557023301960218f, 0.70710678118654752f, 0.83146961230254524f, 0.92387953251128674f, 0.98078528040323043f,
                         1.0f, 0.98078528040323043f, 0.92387953251128674f, 0.83146961230254524f, 0.70710678118654752f, 0.55557023301960218f, 0.38268343236508977f, 0.19509032201612825f};
    return (cf2){c[r], -s[r]};
}

__device__ __forceinline__ void split_bf16x8(const f32x4 x0, const f32x4 x1, bf16x8& hi, bf16x8& lo) {
    const float x[8] = {x0.x, x0.y, x0.z, x0.w, x1.x, x1.y, x1.z, x1.w};
    unsigned h[4], l[4];
#pragma unroll
    for (int i = 0; i < 4; ++i) { h[i] = pk2(x[2 * i], x[2 * i + 1]); l[i] = pk2(x[2 * i] - bflo(h[i]), x[2 * i + 1] - bfhi(h[i])); }
    hi = __builtin_bit_cast(bf16x8, (v4u){h[0], h[1], h[2], h[3]}); lo = __builtin_bit_cast(bf16x8, (v4u){l[0], l[1], l[2], l[3]});
}
__device__ __forceinline__ void filterA_phase(Frame& F) {
    constexpr int WP = 72;
    LAS bf16* wh = (LAS bf16*)(F.lds); LAS bf16* wl = wh + 64 * WP;
    const int NI = 80 * 12;
    for (int it = F.vcu; it < NI; it += F.G) {
        int tid = F.tid; asm volatile("" : "+v"(tid));
        const int lane = tid & 63, w = F.wave, n16 = lane & 15, g4 = lane >> 4;
        const int tt_ = it / 12, cc = it % 12; const bool prm = tt_ < 64; const int N = prm ? LP : LS, t0 = (prm ? tt_ : tt_ - 64) * 128 + 16 * w;
        const float* H2 = prm ? F.H2P : F.H2S; float* FB = prm ? F.FBP : F.FBS;
        const float* hr = H2 + (size_t)(t0 + n16) * 64 + 8 * g4;
        const f32x4 x00 = *(const f32x4*)(hr), x01 = *(const f32x4*)(hr + 4), x10 = *(const f32x4*)(hr + 32), x11 = *(const f32x4*)(hr + 36);
        float wv[8];
#pragma unroll
        for (int i = 0; i < 8; ++i) { const int e = tid + 512 * i; wv[i] = F.fw3[(size_t)(e >> 6) * 768 + cc * 64 + (e & 63)]; }
        __syncthreads();
#pragma unroll
        for (int i = 0; i < 8; ++i) { const int e = tid + 512 * i, k = e >> 6, c = e & 63; const unsigned h = f2bf(wv[i]); wh[c * WP + k] = (bf16)h; wl[c * WP + k] = (bf16)f2bf(wv[i] - __builtin_bit_cast(float, h << 16)); }
        __syncthreads();
        bf16x8 ah[2], al[2];
        split_bf16x8(x00, x01, ah[0], al[0]); split_bf16x8(x10, x11, ah[1], al[1]);
        const float tb = (float)(t0 + 4 * g4), rn = 1.0f / (float)(N - 1);
#pragma unroll
        for (int nt = 0; nt < 4; ++nt) {
            f32x4 acc = {0.f, 0.f, 0.f, 0.f};
#pragma unroll
            for (int s2 = 0; s2 < 2; ++s2) {
                const bf16x8 bh = *(const LAS bf16x8*)(wh + (nt * 16 + n16) * WP + 32 * s2 + 8 * g4), bl = *(const LAS bf16x8*)(wl + (nt * 16 + n16) * WP + 32 * s2 + 8 * g4);
                acc = __builtin_amdgcn_mfma_f32_16x16x32_bf16(ah[s2], bh, acc, 0, 0, 0);
                acc = __builtin_amdgcn_mfma_f32_16x16x32_bf16(ah[s2], bl, acc, 0, 0, 0);
                acc = __builtin_amdgcn_mfma_f32_16x16x32_bf16(al[s2], bh, acc, 0, 0, 0); }
            const int col = cc * 64 + nt * 16 + n16, c = col >= DHY ? col - DHY : col;
            const float delta = 3.0701134573253944f + (float)c * ((15.350567286626972f - 3.0701134573253944f) / 383.0f);
            f32x4 o;
#pragma unroll
            for (int j = 0; j < 4; ++j) { const float tt = (tb + (float)j) * rn; o[j] = acc[j] * expf(-tt * delta); }
            *(f32x4*)(FB + (size_t)col * N + t0 + 4 * g4) = o; }
    }
    __syncthreads();
}
template <int LOGN>
__device__ __forceinline__ void filter_item(Frame& F, int c, int gi, int tl, const float* FB, cf2* Kout) {
    constexpr int N = 1 << LOGN, NT = N >> 4;
    LAS cf2* x = (LAS cf2*)(F.lds + FFT_X) + gi * (N + N / 16);
    const LAS cf2* tw = (const LAS cf2*)(F.lds + FFT_TW);
    LAS float* red = (LAS float*)(F.lds + FFT_AUX + 2048) + gi * 16;
    const float* fwd = FB + (size_t)c * N; const float* bwd = FB + (size_t)(DHY + c) * N;
    float ka[16], kb[16]; float ss = 0.f;
#pragma unroll
    for (int r = 0; r < 16; ++r) { const int t = tl + r * NT; const float f = fwd[t], b = bwd[(N - t) & (N - 1)];
        ka[r] = (t == 0) ? f + b : f; kb[r] = (t == 0) ? 0.f : b; ss += ka[r] * ka[r] + kb[r] * kb[r]; }
    ss = wave_sum(ss);
    __syncthreads();
    if ((tl & 63) == 0) red[tl >> 6] = ss;
    __syncthreads();
    float tot = 0.f;
    for (int w = 0; w < NT / 64; ++w) tot += red[w];
    const float sc = (1.0f / sqrtf(tot + 1e-12f)) * (0.5f / (float)N);
    float sn, cs; sincospif((float)tl / (float)N, &sn, &cs); const cf2 wt = (cf2){cs, -sn};
    cf2 v[16];
#pragma unroll
    for (int r = 0; r < 16; ++r) v[r] = (cf2){(ka[r] + kb[r]) * sc, 0.f};
    fft_fwd_store<LOGN>(v, x, tw, Kout, tl);
#pragma unroll
    for (int r = 0; r < 16; ++r) v[r] = cmul(wt, root32(r)) * ((ka[r] - kb[r]) * sc);
    fft_fwd_store<LOGN>(v, x, tw, Kout + N, tl);
}
__device__ __forceinline__ void filter_phase(Frame& F) {
    fft_init_tw(F);
    const int NI = DHY + DHY / 4;
    for (int it = F.vcu; it < NI; it += F.G) {
        int tid = F.tid; asm volatile("" : "+v"(tid));
        if (it < DHY) filter_item<13>(F, it, 0, tid, F.FBP, F.KSP + (size_t)it * 2 * LP);
        else { const int gi = tid >> 7, c = (it - DHY) * 4 + gi; filter_item<11>(F, c, gi, tid & 127, F.FBS, F.KSS + (size_t)c * 2 * LS); }
    }
    __syncthreads();
}

__device__ __forceinline__ void conv3_16(const LAS bf16* row, int t0, int N, float w0, float w1, float w2, float b, float (&u)[16]) {
    const v4u a = *(const LAS v4u*)(row + t0), c = *(const LAS v4u*)(row + t0 + 8);
    float e[18];
    e[0] = bf2f(row[t0 > 0 ? t0 - 1 : 0]); e[17] = bf2f(row[t0 + 16 < N ? t0 + 16 : t0]);
    e[0] = t0 > 0 ? e[0] : 0.f; e[17] = t0 + 16 < N ? e[17] : 0.f;
    e[1] = bflo(a.x); e[2] = bfhi(a.x); e[3] = bflo(a.y); e[4] = bfhi(a.y); e[5] = bflo(a.z); e[6] = bfhi(a.z); e[7] = bflo(a.w); e[8] = bfhi(a.w);
    e[9] = bflo(c.x); e[10] = bfhi(c.x); e[11] = bflo(c.y); e[12] = bfhi(c.y); e[13] = bflo(c.z); e[14] = bfhi(c.z); e[15] = bflo(c.w); e[16] = bfhi(c.w);
#pragma unroll
    for (int k = 0; k < 16; ++k) u[k] = w0 * e[k] + w1 * e[k + 1] + w2 * e[k + 2] + b;
}
template <int LOGN, int MODE>
__device__ __forceinline__ void hyena_item(Frame& F, int c, int bb1, int bb2, int gi, int tl, const cf2* Kc) {
    constexpr int N = 1 << LOGN, NT = N >> 4;
    LAS cf2* x = (LAS cf2*)(F.lds + FFT_X) + gi * (N + N / 16);
    const LAS cf2* tw = (const LAS cf2*)(F.lds + FFT_TW);
    LAS bf16* R = (LAS bf16*)(F.lds + FFT_SCR) + gi * (4 * N);
    LAS unsigned* ysc = (LAS unsigned*)(F.lds + FFT_SCR) + gi * N + tl;
    LAS unsigned* spk = (LAS unsigned*)(F.lds + FFT_SPK) + gi * N + tl;
    const bf16* z1 = F.ZHY + (size_t)bb_rowbase(bb1) * 1152 + (size_t)c * N;
    const bf16* z2 = F.ZHY + (size_t)bb_rowbase(bb2) * 1152 + (size_t)c * N;
    const float* cw = F.conv_w; const float* cb = F.conv_b;
    float sn, cs; sincospif((float)tl / (float)N, &sn, &cs); const cf2 wt = (cf2){cs, -sn};
    const int t0 = 16 * tl;
    cf2 v[16];
    if (MODE & 1) {
    { v4u stg[8];
#pragma unroll
      for (int i = 0; i < 8; ++i) { const int id = tl + i * NT, row = id / (N / 8), ch = id % (N / 8);
          stg[i] = *(const GAS v4u*)(((row & 2) ? z2 : z1) + (size_t)((row & 1) ? 2 * DHY : DHY) * N + ch * 8); }
      __syncthreads();
#pragma unroll
      for (int i = 0; i < 8; ++i) { const int id = tl + i * NT, row = id / (N / 8), ch = id % (N / 8); *(LAS v4u*)(R + row * N + ch * 8) = stg[i]; } }
    __syncthreads();
    { const float a0 = cw[DHY + c], a1 = cw[1152 + DHY + c], a2 = cw[2304 + DHY + c], ab = cb[DHY + c];
      const float v0 = cw[2 * DHY + c], v1 = cw[1152 + 2 * DHY + c], v2 = cw[2304 + 2 * DHY + c], vb = cb[2 * DHY + c];
      float ua[16], ub[16]; LAS f32x4* xw = (LAS f32x4*)(x + XI(t0));
      conv3_16(R, t0, N, a0, a1, a2, ab, ua); conv3_16(R + N, t0, N, v0, v1, v2, vb, ub);
#pragma unroll
      for (int k = 0; k < 16; ++k) ua[k] *= ub[k];
      float uc[16];
      conv3_16(R + 2 * N, t0, N, a0, a1, a2, ab, uc); conv3_16(R + 3 * N, t0, N, v0, v1, v2, vb, ub);
#pragma unroll
      for (int k = 0; k < 16; ++k) uc[k] *= ub[k];
#pragma unroll
      for (int k = 0; k < 8; ++k) xw[k] = (f32x4){ua[2 * k], uc[2 * k], ua[2 * k + 1], uc[2 * k + 1]}; }
    __syncthreads();
#pragma unroll
    for (int r = 0; r < 16; ++r) { v[r] = x[XI(tl + r * NT)]; spk[r * NT] = pk2(v[r].x, v[r].y); }
    } else {
#pragma unroll
    for (int r = 0; r < 16; ++r) v[r] = (cf2){(float)(tl + r), 1.0f};
    }
    if (MODE & 2) {
    fft_conv<LOGN, (MODE & 8) != 0>(v, x, tw, Kc, tl);
#pragma unroll
    for (int r = 0; r < 16; ++r) ysc[r * NT] = pk2(v[r].x, v[r].y);
#pragma unroll
    for (int r = 0; r < 16; ++r) { const unsigned sw = spk[r * NT]; v[r] = c_mul((cf2){bflo(sw), bfhi(sw)}, c_mul(wt, root32(r))); }
    fft_conv<LOGN, (MODE & 8) != 0>(v, x, tw, Kc + N, tl);
    }
    if (MODE & 4) {
    cf2 wt2 = wt; asm volatile("" : "+v"(wt2));
    const float sk = F.skip[c];
    v4u stg0[4];
#pragma unroll
    for (int i = 0; i < 4; ++i) { const int id = tl + i * NT, row = id / (N / 8), ch = id % (N / 8); stg0[i] = *(const GAS v4u*)((row ? z2 : z1) + ch * 8); }
#pragma unroll
    for (int r = 0; r < 16; ++r) { const unsigned yw = ysc[r * NT], sw = spk[r * NT]; const cf2 z = (cf2){bflo(yw), bfhi(yw)} + c_mulc(v[r], c_mul(wt2, root32(r))); v[r] = (cf2){z.x + bflo(sw) * sk, z.y + bfhi(sw) * sk}; }
    __syncthreads();
#pragma unroll
    for (int r = 0; r < 16; ++r) x[XI(tl + r * NT)] = v[r];
#pragma unroll
    for (int i = 0; i < 4; ++i) { const int id = tl + i * NT, row = id / (N / 8), ch = id % (N / 8); *(LAS v4u*)(R + row * N + ch * 8) = stg0[i]; }
    __syncthreads();
    { const float x0w0 = cw[c], x0w1 = cw[1152 + c], x0w2 = cw[2304 + c], x0b = cb[c];
      float ua[16], uc[16]; const LAS f32x4* xr = (const LAS f32x4*)(x + XI(t0));
      conv3_16(R, t0, N, x0w0, x0w1, x0w2, x0b, ua); conv3_16(R + N, t0, N, x0w0, x0w1, x0w2, x0b, uc);
      v4u q1[2], q2[2];
#pragma unroll
      for (int k = 0; k < 8; ++k) { const f32x4 zz = xr[k]; const unsigned w1 = pk2(ua[2 * k] * zz.x, ua[2 * k + 1] * zz.z), w2 = pk2(uc[2 * k] * zz.y, uc[2 * k + 1] * zz.w);
          q1[k >> 2][k & 3] = w1; q2[k >> 2][k & 3] = w2; }
      GAS v4u* o1 = (GAS v4u*)(F.ZHY + (size_t)bb_rowbase(bb1) * 1152 + (size_t)c * N + t0);
      GAS v4u* o2 = (GAS v4u*)(F.ZHY + (size_t)bb_rowbase(bb2) * 1152 + (size_t)c * N + t0);
      if (MODE == 7) { o1[0] = q1[0]; o1[1] = q1[1]; o2[0] = q2[0]; o2[1] = q2[1]; } else asm volatile("" :: "v"(q1[0]), "v"(q1[1]), "v"(q2[0]), "v"(q2[1])); }
    } else {
#pragma unroll
    for (int r = 0; r < 16; ++r) asm volatile("" :: "v"(v[r].x), "v"(v[r].y));
    }
}
template <int MODE>
__device__ __forceinline__ void hyena_phase(Frame& F) {
    fft_init_tw(F);
    const int NI = DHY * 4 + DHY;
    for (int it = F.vcu; it < NI; it += F.G) {
        int tid = F.tid; asm volatile("" : "+v"(tid));
        if (it < DHY * 4) { const int c = it >> 2, bp = it & 3; hyena_item<13, MODE>(F, c, 2 * bp, 2 * bp + 1, 0, tid, F.KSP + (size_t)c * 2 * LP); }
        else { const int c = it - DHY * 4, gi = tid >> 7; hyena_item<11, MODE>(F, c, 8 + 2 * gi, 9 + 2 * gi, gi, tid & 127, F.KSS + (size_t)c * 2 * LS); }
    }
    __syncthreads();
}

constexpr int TP = 65;
__device__ __forceinline__ void combine_phase(Frame& F) {
    LAS float* Y = (LAS float*)(F.lds);
    const int NI = (MT / 128) * 6;
    for (int it = F.vcu; it < NI; it += F.G) {
        const int cg = it % 6, tile = it / 6; int bb, t0; row_to_bt(tile * 128, bb, t0); const int rb = bb_rowbase(bb), L = bb_len(bb);
        __syncthreads();
        const int tt = F.tid & 127, cq = F.tid >> 7;
        unsigned short cv[16]; v4u gv[2];
#pragma unroll
        for (int k = 0; k < 16; ++k) cv[k] = F.ZHY[(size_t)rb * 1152 + (size_t)(cg * 64 + cq * 16 + k) * L + t0 + tt];
#pragma unroll
        for (int j = 0; j < 2; ++j) { const int id = F.tid + j * NWAVES * 64; gv[j] = *(const GAS v4u*)(F.MIX + (size_t)(rb + t0 + (id >> 3)) * DM + cg * 64 + (id & 7) * 8); }
#pragma unroll
        for (int k = 0; k < 16; ++k) Y[tt * TP + cq * 16 + k] = bf2f(cv[k]);
        __syncthreads();
#pragma unroll
        for (int j = 0; j < 2; ++j) { const int id = F.tid + j * NWAVES * 64, i = id >> 3, ch8 = id & 7;
            GAS v4u* p = (GAS v4u*)(F.MIX + F.woff + (size_t)(rb + t0 + i) * DM + cg * 64 + ch8 * 8); const v4u g = gv[j]; const LAS float* y = Y + i * TP + ch8 * 8;
            v4u o; o.x = pk2(bflo(g.x) * y[0], bfhi(g.x) * y[1]); o.y = pk2(bflo(g.y) * y[2], bfhi(g.y) * y[3]); o.z = pk2(bflo(g.z) * y[4], bfhi(g.z) * y[5]); o.w = pk2(bflo(g.w) * y[6], bfhi(g.w) * y[7]);
            *p = o; }
    }
    __syncthreads();
}

typedef float f32x16 __attribute__((ext_vector_type(16)));
typedef short s16x4 __attribute__((ext_vector_type(4)));
constexpr int AT_K = 0;
constexpr int AT_V = 49152;
constexpr int AT_VH = 384 * 64 + 64;
constexpr int AT_B = AT_V + 2 * AT_VH;
constexpr int AT_L = AT_B + 20480;
constexpr int AT_O = AT_L + 1024;
static_assert(AT_O + 8192 <= LDSCTL_OFF && (AT_B % 16) == 0 && (AT_O % 16) == 0, "attention LDS map");
__device__ __forceinline__ int crow(int r, int hi) { return (r & 3) + 8 * (r >> 2) + 4 * hi; }
__device__ __forceinline__ s16x4 vtr(const LAS unsigned char* p) { typedef short v4i16_t __attribute__((ext_vector_type(4))); return __builtin_bit_cast(s16x4, __builtin_amdgcn_ds_read_tr16_b64_v4i16((LAS v4i16_t*)p)); }

template <int NK>
__device__ __forceinline__ void attn_stage_load(int tid, v4u (&kd)[NK / 64], v4u (&vd)[NK / 64], const bf16* Kg, const bf16* Vg, int idx0, int n, long tok0, int tstride) {
#pragma unroll
    for (int i = 0; i < NK / 64; ++i) { const int id = tid + i * NWAVES * 64, kk = id >> 3, c8 = id & 7; const int idx = idx0 + kk;
        const bool ok = idx >= 0 && idx < n; const size_t off = ok ? (size_t)(tok0 + (long)kk * tstride) * 64 + c8 * 8 : 0;
        kd[i] = *(const GAS v4u*)(Kg + off); vd[i] = *(const GAS v4u*)(Vg + off); }
}
template <int NK>
__device__ __forceinline__ void attn_stage_write(Frame& F, int tid, const v4u (&kd)[NK / 64], const v4u (&vd)[NK / 64], int idx0, int n) {
#pragma unroll
    for (int i = 0; i < NK / 64; ++i) { const int id = tid + i * NWAVES * 64, kk = id >> 3, c8 = id & 7; const int idx = idx0 + kk;
        const bool ok = idx >= 0 && idx < n; const v4u z = {0u, 0u, 0u, 0u};
        *(LAS v4u*)(F.lds + AT_K + kk * 128 + ((c8 ^ ((kk >> 1) & 7)) << 4)) = ok ? kd[i] : z;
        *(LAS v4u*)(F.lds + AT_V + (c8 >> 2) * AT_VH + kk * 64 + ((c8 & 3) << 4)) = ok ? vd[i] : z; }
}
__device__ __forceinline__ void attn_kread(const LAS unsigned char* lds, int T, int lane, bf16x8 (&kf)[4]) {
    const int ql = lane & 31, hi = lane >> 5; const LAS unsigned char* kp = lds + AT_K + (32 * T + ql) * 128; const int sw = (ql >> 1) & 7;
#pragma unroll
    for (int d0 = 0; d0 < 4; ++d0) kf[d0] = *(const LAS bf16x8*)(kp + (((2 * d0 + hi) ^ sw) << 4));
}
__device__ __forceinline__ void attn_vread(const LAS unsigned char* lds, int T, int lane, s16x4 (&vf)[8]) {
    const int hi = lane >> 5; const LAS unsigned char* vp = lds + AT_V + (32 * T + 4 * hi + ((lane & 15) >> 2)) * 64 + ((lane >> 4) & 1) * 32 + (lane & 3) * 8;
#pragma unroll
    for (int db = 0; db < 2; ++db)
#pragma unroll
        for (int q = 0; q < 4; ++q) vf[db * 4 + q] = vtr(vp + db * AT_VH + q * 512);
}
__device__ __forceinline__ void attn_tile(const LAS unsigned char* lds, int T, int Tn, const LAS unsigned char* bnext, bf16x8 (&kf)[4], f32x16& p, const bf16x8 (&qr)[4], bool bnd, int idxbase, int n, float& lsum, f32x16& o0, f32x16& o1, int lane) {
    const int hi = lane >> 5;
    __builtin_amdgcn_sched_barrier(0);
    s16x4 vf[8];
    attn_vread(lds, T, lane, vf);
#pragma unroll
    for (int d0 = 0; d0 < 4; ++d0) p = __builtin_amdgcn_mfma_f32_32x32x16_bf16(kf[d0], qr[d0], p, 0, 0, 0);
    if (Tn >= 0) attn_kread(lds, Tn, lane, kf);
    if (bnd) {
#pragma unroll
        for (int r = 0; r < 16; ++r) { const int idx = idxbase + crow(r, hi); if (idx < 0 || idx >= n) p[r] = -1e30f; } }
    float s = 0.f;
#pragma unroll
    for (int r = 0; r < 16; ++r) { p[r] = __builtin_amdgcn_exp2f(p[r]); s += p[r]; }
    lsum += s;
    u32x4 w0, w1;
    w0.x = pg8::cvt_pk_bf16(p[0], p[1]); w0.y = pg8::cvt_pk_bf16(p[2], p[3]); w0.z = pg8::cvt_pk_bf16(p[4], p[5]); w0.w = pg8::cvt_pk_bf16(p[6], p[7]);
    w1.x = pg8::cvt_pk_bf16(p[8], p[9]); w1.y = pg8::cvt_pk_bf16(p[10], p[11]); w1.z = pg8::cvt_pk_bf16(p[12], p[13]); w1.w = pg8::cvt_pk_bf16(p[14], p[15]);
    if (bnext) {
#pragma unroll
        for (int r4 = 0; r4 < 4; ++r4) { const f32x4 b = *(const LAS f32x4*)(bnext + (r4 * 64 + lane) * 16); p[4 * r4] = b.x; p[4 * r4 + 1] = b.y; p[4 * r4 + 2] = b.z; p[4 * r4 + 3] = b.w; } }
    const bf16x8 pa0 = __builtin_bit_cast(bf16x8, w0), pa1 = __builtin_bit_cast(bf16x8, w1);
    const bf16x8 v00 = (bf16x8){vf[0][0], vf[0][1], vf[0][2], vf[0][3], vf[1][0], vf[1][1], vf[1][2], vf[1][3]}, v01 = (bf16x8){vf[2][0], vf[2][1], vf[2][2], vf[2][3], vf[3][0], vf[3][1], vf[3][2], vf[3][3]};
    const bf16x8 v10 = (bf16x8){vf[4][0], vf[4][1], vf[4][2], vf[4][3], vf[5][0], vf[5][1], vf[5][2], vf[5][3]}, v11 = (bf16x8){vf[6][0], vf[6][1], vf[6][2], vf[6][3], vf[7][0], vf[7][1], vf[7][2], vf[7][3]};
    o0 = __builtin_amdgcn_mfma_f32_32x32x16_bf16(pa0, v00, o0, 0, 0, 0); o1 = __builtin_amdgcn_mfma_f32_32x32x16_bf16(pa0, v10, o1, 0, 0, 0);
    o0 = __builtin_amdgcn_mfma_f32_32x32x16_bf16(pa1, v01, o0, 0, 0, 0); o1 = __builtin_amdgcn_mfma_f32_32x32x16_bf16(pa1, v11, o1, 0, 0, 0);
}
template <int NTILES, bool BIAS>
__device__ __forceinline__ void attn_tiles(const LAS unsigned char* lds, int T0, const bf16x8 (&qr)[4], float cinit, bool bnd, int idxbase0, int n, float& lsum, f32x16& o0, f32x16& o1, int lane) {
    const int hi = lane >> 5;
    bf16x8 kf[4]; f32x16 p[2];
#define AT_PINIT(P, TAU) do { if (BIAS) { _Pragma("unroll") for (int r4 = 0; r4 < 4; ++r4) { const f32x4 b_ = *(const LAS f32x4*)(lds + AT_B + (TAU) * 4096 + (r4 * 64 + lane) * 16); \
        P[4 * r4] = b_.x; P[4 * r4 + 1] = b_.y; P[4 * r4 + 2] = b_.z; P[4 * r4 + 3] = b_.w; } } else { _Pragma("unroll") for (int r = 0; r < 16; ++r) P[r] = cinit; } } while (0)
    attn_kread(lds, T0, lane, kf);
    AT_PINIT(p[0], 0);
#pragma unroll
    for (int d0 = 0; d0 < 4; ++d0) p[0] = __builtin_amdgcn_mfma_f32_32x32x16_bf16(kf[d0], qr[d0], p[0], 0, 0, 0);
    if (NTILES > 1) { attn_kread(lds, T0 + 1, lane, kf); AT_PINIT(p[1], 1); }
#pragma unroll
    for (int tau = 0; tau < NTILES; ++tau) {
        f32x16& pc = p[tau & 1]; f32x16& pn = p[(tau + 1) & 1];
        __builtin_amdgcn_sched_barrier(0);
        s16x4 vf[8];
        attn_vread(lds, T0 + tau, lane, vf);
        if (tau + 1 < NTILES) {
#pragma unroll
            for (int d0 = 0; d0 < 4; ++d0) pn = __builtin_amdgcn_mfma_f32_32x32x16_bf16(kf[d0], qr[d0], pn, 0, 0, 0);
            if (tau + 2 < NTILES) attn_kread(lds, T0 + tau + 2, lane, kf);
        }
        __builtin_amdgcn_sched_barrier(0);
        if (bnd) { const int idxbase = idxbase0 + 32 * tau;
#pragma unroll
            for (int r = 0; r < 16; ++r) { const int idx = idxbase + crow(r, hi); if (idx < 0 || idx >= n) pc[r] = -1e30f; } }
        float s = 0.f;
#pragma unroll
        for (int r = 0; r < 16; ++r) { pc[r] = __builtin_amdgcn_exp2f(pc[r]); s += pc[r]; }
        lsum += s;
        u32x4 w0, w1;
        w0.x = pg8::cvt_pk_bf16(pc[0], pc[1]); w0.y = pg8::cvt_pk_bf16(pc[2], pc[3]); w0.z = pg8::cvt_pk_bf16(pc[4], pc[5]); w0.w = pg8::cvt_pk_bf16(pc[6], pc[7]);
        w1.x = pg8::cvt_pk_bf16(pc[8], pc[9]); w1.y = pg8::cvt_pk_bf16(pc[10], pc[11]); w1.z = pg8::cvt_pk_bf16(pc[12], pc[13]); w1.w = pg8::cvt_pk_bf16(pc[14], pc[15]);
        if (tau + 2 < NTILES) AT_PINIT(pc, tau + 2);
        const bf16x8 pa0 = __builtin_bit_cast(bf16x8, w0), pa1 = __builtin_bit_cast(bf16x8, w1);
        const bf16x8 v00 = (bf16x8){vf[0][0], vf[0][1], vf[0][2], vf[0][3], vf[1][0], vf[1][1], vf[1][2], vf[1][3]}, v01 = (bf16x8){vf[2][0], vf[2][1], vf[2][2], vf[2][3], vf[3][0], vf[3][1], vf[3][2], vf[3][3]};
        const bf16x8 v10 = (bf16x8){vf[4][0], vf[4][1], vf[4][2], vf[4][3], vf[5][0], vf[5][1], vf[5][2], vf[5][3]}, v11 = (bf16x8){vf[6][0], vf[6][1], vf[6][2], vf[6][3], vf[7][0], vf[7][1], vf[7][2], vf[7][3]};
        o0 = __builtin_amdgcn_mfma_f32_32x32x16_bf16(pa0, v00, o0, 0, 0, 0); o1 = __builtin_amdgcn_mfma_f32_32x32x16_bf16(pa0, v10, o1, 0, 0, 0);
        o0 = __builtin_amdgcn_mfma_f32_32x32x16_bf16(pa1, v01, o0, 0, 0, 0); o1 = __builtin_amdgcn_mfma_f32_32x32x16_bf16(pa1, v11, o1, 0, 0, 0);
    }
#undef AT_PINIT
}
struct DilUnit { int bb, h, c, rho, i0, n, d, rb, L; size_t hb; };
__device__ __forceinline__ DilUnit dil_decode(int it) {
    DilUnit u;
    if (it < 4608) { const int g = it >> 5, q = it & 31; u.bb = g / 18; u.h = (g / 3) % 6; u.c = g % 3; u.n = LP >> (2 * u.c); const int nb = u.n >> 8; u.rho = q / nb; u.i0 = (q % nb) << 8; }
    else { const int r = it - 4608, g = r >> 5, q = r & 31; u.bb = 8 + g / 6; u.h = g % 6;
        if (q < 8) { u.c = 0; u.n = LS; u.rho = 0; u.i0 = q << 8; } else if (q < 16) { u.c = 1; u.n = LS / 4; u.rho = (q - 8) >> 1; u.i0 = ((q - 8) & 1) << 8; } else { u.c = 2; u.n = LS / 16; u.rho = q - 16; u.i0 = 0; } }
    u.d = 1 << (2 * u.c); u.rb = bb_rowbase(u.bb); u.L = bb_len(u.bb); u.hb = ((size_t)u.rb * NH + (size_t)u.h * u.L) * 64;
    return u;
}
__device__ __forceinline__ void dil_prefetch(Frame& F, int tid, const DilUnit& u, v4u (&kd)[6], v4u (&vd)[6], bf16x8 (&qr)[4]) {
    attn_stage_load<384>(tid, kd, vd, F.K + u.hb, F.V + u.hb, u.i0 - 64, u.n, (long)u.rho + (long)u.d * (u.i0 - 64), u.d);
    const int ql = tid & 31, hi = (tid >> 5) & 1; const bool wact = u.i0 + 32 * F.wave < u.n;
    const bf16* qp = F.Q + u.hb + (size_t)(u.rho + u.d * (wact ? u.i0 + 32 * F.wave + ql : 0)) * 64 + 8 * hi;
#pragma unroll
    for (int d0 = 0; d0 < 4; ++d0) qr[d0] = *(const GAS bf16x8*)(qp + 16 * d0);
}
template <int MODE>
__device__ __forceinline__ void attn_dilated_phase(Frame& F) {
#ifndef DIL_WGS
#define DIL_WGS 0
#endif
    const int GA = DIL_WGS ? DIL_WGS : F.G;
    const int NU = 6144, ub = F.vcu < GA ? (int)(((long)F.vcu * NU) / GA) : 0, ue = F.vcu < GA ? (int)(((long)(F.vcu + 1) * NU) / GA) : 0;
    const int w = F.wave;
    const float cshift = F.CONSTS[0];
    int prev_ch = -1;
    v4u kd[6], vd[6]; bf16x8 qn[4];
    if (!(MODE & 1)) {
#pragma unroll
        for (int i = 0; i < 6; ++i) { kd[i] = (v4u){0u, 0u, 0u, 0u}; vd[i] = kd[i]; }
#pragma unroll
        for (int i = 0; i < 4; ++i) qn[i] = (bf16x8){0, 0, 0, 0, 0, 0, 0, 0}; }
    if ((MODE & 1) && ub < ue) { const DilUnit u0 = dil_decode(ub); dil_prefetch(F, F.tid, u0, kd, vd, qn); }
    for (int it = ub; it < ue; ++it) {
        int tid = F.tid; asm volatile("" : "+v"(tid));
        const int lane = tid & 63, ql = lane & 31, hi = lane >> 5;
        const DilUnit u = dil_decode(it);
        const int c = u.c, h = u.h, rho = u.rho, i0 = u.i0, n = u.n, d = u.d, rb = u.rb;
        __syncthreads();
        if (c * 8 + h != prev_ch) { prev_ch = c * 8 + h; const float* bias = F.BIAS + (c * NH + h) * 129;
            for (int e = tid; e < 5 * 16 * 64; e += NWAVES * 64) { const int tau = e >> 10, r = (e >> 6) & 15, ln = e & 63; const int rel = 32 * tau + crow(r, ln >> 5) - 64 - (ln & 31);
                const float v = (rel >= -64 && rel <= 64) ? bias[rel + 64] * 1.4426950408889634f - cshift : -1e30f;
                ((LAS float*)(F.lds + AT_B))[((tau * 4 + (r >> 2)) * 64 + ln) * 4 + (r & 3)] = v; } }
        if (MODE & 1) attn_stage_write<384>(F, tid, kd, vd, i0 - 64, n);
        bf16x8 qr[4];
#pragma unroll
        for (int d0 = 0; d0 < 4; ++d0) qr[d0] = qn[d0];
        __syncthreads();
        if ((MODE & 1) && it + 1 < ue) { const DilUnit un = dil_decode(it + 1); dil_prefetch(F, tid, un, kd, vd, qn); }
        const bool wact = i0 + 32 * w < n;
        const int qi = i0 + 32 * w + ql;
        if (wact) {
            f32x16 o0, o1;
#pragma unroll
            for (int r = 0; r < 16; ++r) { o0[r] = 0.f; o1[r] = 0.f; }
            float lsum = 0.f;
            const bool bnd = (i0 == 0) || (i0 + 256 + 64 > n);
            if (MODE & 2) attn_tiles<5, true>(F.lds, w, qr, 0.f, bnd, i0 - 64 + 32 * w, n, lsum, o0, o1, lane);
            lsum += __shfl_xor(lsum, 32);
            LAS bf16* ost = (LAS bf16*)(F.lds + AT_O) + w * 512;
            bf16* ocp = F.OC + ((size_t)c * MT + rb) * DHY + h * 64 + (lane & 7) * 8;
            if (!(MODE & 4)) { asm volatile("" :: "v"(o0), "v"(o1), "v"(lsum)); }
            if (MODE & 4)
#pragma unroll
            for (int g = 0; g < 4; ++g) {
#pragma unroll
                for (int j = 0; j < 4; ++j) { ost[(4 * hi + j) * 64 + ql] = (bf16)f2bf(o0[4 * g + j]); ost[(4 * hi + j) * 64 + 32 + ql] = (bf16)f2bf(o1[4 * g + j]); }
                asm volatile("s_waitcnt lgkmcnt(0)" ::: "memory");
                const v4u ov = *(const LAS v4u*)(ost + (lane >> 3) * 64 + (lane & 7) * 8);
                asm volatile("s_waitcnt lgkmcnt(0)" ::: "memory");
                const size_t tok = (size_t)(rho + d * (i0 + 32 * w + 8 * g + (lane >> 3)));
                if (MODE == 7) *(GAS v4u*)(ocp + tok * DHY) = ov; else asm volatile("" :: "v"(ov)); }
            if (MODE == 7 && hi == 0) F.LC[((size_t)c * MT + rb + rho + d * qi) * NH + h] = lsum;
        }
    }
    __syncthreads();
}
struct MemUnit { int bb, hm, rb, L, t0; };
__device__ __forceinline__ MemUnit mem_decode(int it, int w) {
    MemUnit u; int blk;
    if (it < 1024) { u.bb = it >> 7; u.hm = (it >> 5) & 3; blk = it & 31; } else { const int r = it - 1024; u.bb = 8 + (r >> 5); u.hm = (r >> 3) & 3; blk = r & 7; }
    u.rb = bb_rowbase(u.bb); u.L = bb_len(u.bb); u.t0 = blk * 256 + 32 * w; return u;
}
__device__ __forceinline__ void attn_memory_phase(Frame& F) {
    const int NU = 1280, ub = (int)(((long)F.vcu * NU) / F.G), ue = (int)(((long)(F.vcu + 1) * NU) / F.G);
    const int lane = F.lane, ql = lane & 31, hi = lane >> 5, w = F.wave;
    const float cshift = F.CONSTS[1];
    int prev = -1;
    bf16x8 qn[4];
    if (ub < ue) { const MemUnit u0 = mem_decode(ub, w); const bf16* qp = F.MQ + ((size_t)u0.rb * NHM + (size_t)u0.hm * u0.L + u0.t0 + ql) * 64 + 8 * hi;
#pragma unroll
        for (int d0 = 0; d0 < 4; ++d0) qn[d0] = *(const GAS bf16x8*)(qp + 16 * d0); }
    for (int it = ub; it < ue; ++it) {
        const MemUnit u = mem_decode(it, w); const int bb = u.bb, hm = u.hm, rb = u.rb, t0 = u.t0;
        if (bb * 4 + hm != prev) { prev = bb * 4 + hm;
            const size_t mb = (size_t)(bb * NHM + hm) * NMEM * 64;
            v4u kd[4], vd[4];
            attn_stage_load<256>(F.tid, kd, vd, F.KM + mb, F.VM + mb, 0, 256, 0, 1);
            __syncthreads();
            attn_stage_write<256>(F, F.tid, kd, vd, 0, 256);
            __syncthreads(); }
        bf16x8 qr[4];
#pragma unroll
        for (int d0 = 0; d0 < 4; ++d0) qr[d0] = qn[d0];
        bf16* mp = F.MIX + (size_t)(rb + t0 + (lane >> 3)) * DM + 2 * DHY + hm * 64 + (lane & 7) * 8;
        v4u gv[4];
#pragma unroll
        for (int g = 0; g < 4; ++g) gv[g] = *(const GAS v4u*)(mp + (size_t)(8 * g) * DM);
        if (it + 1 < ue) { const MemUnit un = mem_decode(it + 1, w); const bf16* qp = F.MQ + ((size_t)un.rb * NHM + (size_t)un.hm * un.L + un.t0 + ql) * 64 + 8 * hi;
#pragma unroll
            for (int d0 = 0; d0 < 4; ++d0) qn[d0] = *(const GAS bf16x8*)(qp + 16 * d0); }
        f32x16 o0, o1;
#pragma unroll
        for (int r = 0; r < 16; ++r) { o0[r] = 0.f; o1[r] = 0.f; }
        float lsum = 0.f;
        attn_tiles<8, false>(F.lds, 0, qr, -cshift, false, 0, 256, lsum, o0, o1, lane);
        lsum += __shfl_xor(lsum, 32);
        LAS float* lsc = (LAS float*)(F.lds + AT_L) + w * 32;
        if (hi == 0) lsc[ql] = lsum;
        asm volatile("s_waitcnt lgkmcnt(0)" ::: "memory");
        LAS bf16* ost = (LAS bf16*)(F.lds + AT_O) + w * 512;
#pragma unroll
        for (int g = 0; g < 4; ++g) {
#pragma unroll
            for (int j = 0; j < 4; ++j) { const float inv = 1.0f / lsc[8 * g + 4 * hi + j]; ost[(4 * hi + j) * 64 + ql] = (bf16)f2bf(o0[4 * g + j] * inv); ost[(4 * hi + j) * 64 + 32 + ql] = (bf16)f2bf(o1[4 * g + j] * inv); }
            asm volatile("s_waitcnt lgkmcnt(0)" ::: "memory");
            const v4u ov = *(const LAS v4u*)(ost + (lane >> 3) * 64 + (lane & 7) * 8);
            asm volatile("s_waitcnt lgkmcnt(0)" ::: "memory");
            const v4u gg = gv[g]; v4u q;
            q.x = pk2(bflo(gg.x) * bflo(ov.x), bfhi(gg.x) * bfhi(ov.x)); q.y = pk2(bflo(gg.y) * bflo(ov.y), bfhi(gg.y) * bfhi(ov.y));
            q.z = pk2(bflo(gg.z) * bflo(ov.z), bfhi(gg.z) * bfhi(ov.z)); q.w = pk2(bflo(gg.w) * bflo(ov.w), bfhi(gg.w) * bfhi(ov.w));
            *(GAS v4u*)(mp + F.woff + (size_t)(8 * g) * DM) = q; }
    }
    __syncthreads();
}
struct ACLoad { v4u x0, x1, x2, g; float l0, l1, l2; };
__device__ __forceinline__ ACLoad ac_load(const bf16* OC, const float* LC, const bf16* MIX, long id) {
    const int m = (int)(id / 48), ch = (int)(id % 48), h = ch >> 3; ACLoad r;
    r.x0 = *(const GAS v4u*)(OC + (size_t)m * DHY + ch * 8); r.x1 = *(const GAS v4u*)(OC + ((size_t)MT + m) * DHY + ch * 8); r.x2 = *(const GAS v4u*)(OC + ((size_t)2 * MT + m) * DHY + ch * 8);
    r.l0 = LC[(size_t)m * NH + h]; r.l1 = LC[((size_t)MT + m) * NH + h]; r.l2 = LC[((size_t)2 * MT + m) * NH + h];
    r.g = *(const GAS v4u*)(MIX + (size_t)m * DM + DHY + ch * 8); return r;
}
__device__ __forceinline__ void attn_combine_phase(Frame& F) {
    const long NT8 = (long)MT * 48, stride = (long)F.G * (NWAVES * 64);
    long id = (long)F.vcu * (NWAVES * 64) + F.tid;
    if (id >= NT8) return;
    ACLoad cur = ac_load(F.OC, F.LC, F.MIX, id);
    for (; id < NT8; id += stride) {
        const long nx = id + stride < NT8 ? id + stride : id;
        const ACLoad nxt = ac_load(F.OC, F.LC, F.MIX, nx);
        const int m = (int)(id / 48), ch = (int)(id % 48);
        const float inv = 1.0f / (cur.l0 + cur.l1 + cur.l2);
        float o[8];
        o[0] = bflo(cur.x0.x) + bflo(cur.x1.x) + bflo(cur.x2.x); o[1] = bfhi(cur.x0.x) + bfhi(cur.x1.x) + bfhi(cur.x2.x); o[2] = bflo(cur.x0.y) + bflo(cur.x1.y) + bflo(cur.x2.y); o[3] = bfhi(cur.x0.y) + bfhi(cur.x1.y) + bfhi(cur.x2.y);
        o[4] = bflo(cur.x0.z) + bflo(cur.x1.z) + bflo(cur.x2.z); o[5] = bfhi(cur.x0.z) + bfhi(cur.x1.z) + bfhi(cur.x2.z); o[6] = bflo(cur.x0.w) + bflo(cur.x1.w) + bflo(cur.x2.w); o[7] = bfhi(cur.x0.w) + bfhi(cur.x1.w) + bfhi(cur.x2.w);
        const v4u g = cur.g; v4u q;
        q.x = pk2(bflo(g.x) * o[0] * inv, bfhi(g.x) * o[1] * inv); q.y = pk2(bflo(g.y) * o[2] * inv, bfhi(g.y) * o[3] * inv);
        q.z = pk2(bflo(g.z) * o[4] * inv, bfhi(g.z) * o[5] * inv); q.w = pk2(bflo(g.w) * o[6] * inv, bfhi(g.w) * o[7] * inv);
        *(GAS v4u*)(F.MIX + F.woff + (size_t)m * DM + DHY + ch * 8) = q;
        cur = nxt;
    }
}

#define DUP_SEL_UNUSED 0
#ifndef TS_I
#define TS_I -1
#define TS_J -1
#endif
struct Args { const float* in[23]; float* out; unsigned char* ws; int ph_lo, ph_hi, li, pad; };
__global__ void __launch_bounds__(NWAVES * 64, 2) hymba_fwd(Args args) {
    extern __shared__ __attribute__((aligned(16))) unsigned char lds[];
    Frame F;
    F.lds = (LAS unsigned char*)lds;
    F.MISC = (volatile LAS unsigned*)(F.lds + MISC_OFF);
    F.tid = threadIdx.x; F.lane = F.tid & 63; F.wave = __builtin_amdgcn_readfirstlane(F.tid >> 6);
    F.G = gridDim.x; { const int bx = blockIdx.x; F.vcu = (F.G % 8 == 0) ? (bx % 8) * (F.G / 8) + bx / 8 : bx; }
    unsigned char* ws = args.ws;
    F.ctl = (gu32*)(ws + WS_CTL);
    F.xp = args.in[0]; F.xs = args.in[1]; F.memp = args.in[2]; F.mems = args.in[3]; F.norm_in = args.in[4]; F.w_in = args.in[5]; F.conv_w = args.in[6]; F.conv_b = args.in[7];
    F.fw1 = args.in[8]; F.fb1 = args.in[9]; F.ffreq = args.in[10]; F.fw2 = args.in[11]; F.fb2 = args.in[12]; F.fw3 = args.in[13]; F.skip = args.in[14]; F.gq = args.in[15]; F.gk = args.in[16];
    F.mem_norm = args.in[17]; F.w_mkv = args.in[18]; F.gmq = args.in[19]; F.gmk = args.in[20]; F.w_out = args.in[21]; F.rel_bias = args.in[22]; F.out = args.out;
    F.WTin = (bf16*)(ws + WS_WTIN); F.WTout = (bf16*)(ws + WS_WTOUT); F.WTmkv = (bf16*)(ws + WS_WTMKV); F.MEMB = (bf16*)(ws + WS_MEMB); F.KM = (bf16*)(ws + WS_KM); F.VM = (bf16*)(ws + WS_VM);
    F.XB = (bf16*)(ws + WS_XB); F.ST = (bf16*)(ws + WS_ST); F.CT = (bf16*)(ws + WS_CT); F.ZHY = (bf16*)(ws + WS_ZHY); F.Q = (bf16*)(ws + WS_Q); F.K = (bf16*)(ws + WS_K); F.V = (bf16*)(ws + WS_V);
    F.MQ = (bf16*)(ws + WS_MQ); F.MIX = (bf16*)(ws + WS_MIX); F.woff = 0; F.H2P = (float*)(ws + WS_H2P); F.H2S = (float*)(ws + WS_H2S); F.BIAS = (float*)(ws + WS_BIAS); F.GAINS = (float*)(ws + WS_GAINS); F.CONSTS = (float*)(ws + WS_CONSTS); F.RSTD = (float*)(ws + WS_RSTD); F.LC = (float*)(ws + WS_LC); F.OC = (bf16*)(ws + WS_OC); F.FBP = (float*)(ws + WS_OC); F.FBS = (float*)(ws + WS_OC + 24 * MiB);
    F.KSP = (cf2*)(ws + WS_KSP); F.KSS = (cf2*)(ws + WS_KSS);
    for (int u = F.tid; u < (LDS_BYTES - LDSCTL_OFF) / 4; u += NWAVES * 64) ((LAS unsigned*)(F.lds + LDSCTL_OFF))[u] = 0u;
    __syncthreads();
    XcdBarrier bar; bar.bar = (unsigned*)(F.ctl + CW_BAR); bar.x = 0; bar.st = nullptr;
    if (N_LAUNCHES != PER_PHASE) bar = xcd_barrier_post((unsigned*)(F.ctl + CW_BAR), F.MISC + 8);
#define GRID_BAR(seam) do { if (N_LAUNCHES == PER_PHASE) { if (F.tid == 0) __hip_atomic_store(F.ctl + CW_TMO, 0xBADBA0u | (unsigned)(seam), RLX_AGENT); } else { xcd_barrier(bar); } } while (0)
    const int lo = args.ph_lo, hi = args.ph_hi;
    unsigned long long* const tsb = (unsigned long long*)(ws + WS_CTL + 524288);
#define STAMP(k) do { if (TS_I >= 0 && blockIdx.x == 0 && F.tid == 0) __hip_atomic_store(tsb + (k), rt(), RLX_AGENT); } while (0)
    STAMP(0);
#ifndef PH_MASK
#define PH_MASK 63
#endif
#define IN(k) (((PH_MASK >> (k)) & 1) && lo <= (k) && (k) < hi)
#define BOTH(k) (IN(k) && IN((k) + 1))

    if (IN(0)) { p0_prologue(F); if (DUP_SEL == 30) p0_prologue(F); STAMP(1); if (BOTH(0)) GRID_BAR(0); STAMP(2); if (DUP_SEL == 20) { for (int k = 0; k < 10; ++k) GRID_BAR(0); } }
    if (IN(1)) {
#ifndef NO_G1
        { pg8::Gemm g{F.XB, F.WTin, MT, DIN, DM}; pg8::StaticOrder S; S.init(MT, DIN, F.G, (int)blockIdx.x);
          pg8::EpiZ E{args.ws, F.GAINS};
          static_assert(WS_V - WS_K == WS_K - WS_Q, "Q | K | V equally spaced");
          pg8::gemm_phase<pg8::EpiZ, pg8::StaticOrder, true, true>(F.lds + RING_OFF, g, S, E);
          if (DUP_SEL == 10) pg8::gemm_phase<pg8::EpiZ, pg8::StaticOrder, true, true>(F.lds + RING_OFF, g, S, E);
          if (DUP_SEL == 11) { pg8::EpiZT<0> E1{args.ws, F.GAINS}; pg8::gemm_phase<pg8::EpiZT<0>, pg8::StaticOrder, true, true>(F.lds + RING_OFF, g, S, E1); }
          if (DUP_SEL == 12) { pg8::EpiZT<1> E1{args.ws, F.GAINS}; pg8::gemm_phase<pg8::EpiZT<1>, pg8::StaticOrder, true, true>(F.lds + RING_OFF, g, S, E1); }
          if (DUP_SEL == 13) { pg8::EpiZT<2> E1{args.ws, F.GAINS}; pg8::gemm_phase<pg8::EpiZT<2>, pg8::StaticOrder, true, true>(F.lds + RING_OFF, g, S, E1); }
          if (DUP_SEL == 14) { pg8::EpiZT<4> E1{args.ws, F.GAINS}; pg8::gemm_phase<pg8::EpiZT<4>, pg8::StaticOrder, true, true>(F.lds + RING_OFF, g, S, E1); } }
#endif
        STAMP(3);
#ifndef NO_MKV
        { pg8::Gemm g{F.MEMB, F.WTmkv, MMEM, DMKV, DM}; pg8::StaticOrder S; S.init(MMEM, DMKV, F.G, (int)((blockIdx.x + F.G / 2) % F.G));
          pg8::EpiMKV E{F.KM, F.GAINS + 192};
          pg8::gemm_phase<pg8::EpiMKV, pg8::StaticOrder, true, true>(F.lds + RING_OFF, g, S, E); }
#endif
        STAMP(4);
#ifndef NO_FILT
        filterA_phase(F);
#endif
        STAMP(5); if (BOTH(1)) GRID_BAR(1); STAMP(6);
    }
    if (IN(2)) { filter_phase(F); if (DUP_SEL == 21) filter_phase(F); attn_memory_phase(F); if (DUP_SEL == 31) { F.woff = (long)(WS_OC - WS_MIX) / 2; attn_memory_phase(F); F.woff = 0; } STAMP(7); if (BOTH(2)) GRID_BAR(2); STAMP(8); }
    if (IN(3)) {
#ifndef NO_HY
 hyena_phase<7>(F); if (DUP_SEL == 1) hyena_phase<7>(F); if (DUP_SEL == 15) hyena_phase<1>(F); if (DUP_SEL == 16) hyena_phase<2>(F); if (DUP_SEL == 18) hyena_phase<10>(F); if (DUP_SEL == 17) hyena_phase<4>(F); if (DUP_SEL == 34) hyena_phase<3>(F); STAMP(9);
#endif
#ifndef NO_ATT
 attn_dilated_phase<7>(F); if (DUP_SEL == 2) attn_dilated_phase<7>(F); if (DUP_SEL == 8) attn_dilated_phase<1>(F); if (DUP_SEL == 9) attn_dilated_phase<2>(F); if (DUP_SEL == 4) attn_dilated_phase<4>(F); STAMP(10);
#endif
 if (BOTH(3)) GRID_BAR(3); STAMP(12); }
    if (IN(4)) { combine_phase(F); STAMP(13); attn_combine_phase(F); STAMP(14); if (DUP_SEL == 32) { F.woff = (long)(WS_Q - WS_MIX) / 2; combine_phase(F); F.woff = 0; } if (DUP_SEL == 33) { F.woff = (long)(WS_Q - WS_MIX) / 2; attn_combine_phase(F); F.woff = 0; } if (BOTH(4)) GRID_BAR(4); }
    if (IN(5)) {
        pg8::Gemm g{F.MIX, F.WTout, MT, DM, DM}; pg8::StaticOrder S; S.init(MT, DM, F.G, (int)blockIdx.x);
        float osc = 1.0f;
        if (TS_I >= 0) { const unsigned long long ta = __hip_atomic_load(tsb + (TS_I < 0 ? 0 : TS_I), RLX_AGENT), tb = __hip_atomic_load(tsb + (TS_J < 0 ? 0 : TS_J), RLX_AGENT); osc = 1.0f + (float)(((long long)(tb - ta) + 2500) / 5000) * 5e-3f; }
        pg8::EpiOut E{F.XB, F.RSTD, F.out, osc};
        pg8::gemm_phase<pg8::EpiOut, pg8::StaticOrder, true, true>(F.lds + RING_OFF, g, S, E);
        if (DUP_SEL == 3) pg8::gemm_phase<pg8::EpiOut, pg8::StaticOrder, true, true>(F.lds + RING_OFF, g, S, E);
        if (DUP_SEL == 5) { pg8::EpiNull E0; pg8::gemm_phase<pg8::EpiNull, pg8::StaticOrder, true, true>(F.lds + RING_OFF, g, S, E0); }
        if (DUP_SEL == 6) { pg8::EpiStoreOnly E1{(float*)(ws + WS_ZHY)}; pg8::gemm_phase<pg8::EpiStoreOnly, pg8::StaticOrder, true, true>(F.lds + RING_OFF, g, S, E1); }
    }
#undef IN
#undef BOTH
}

extern "C" void kernel_launch(void* const* d_in, const int* in_sizes, int n_in, void* d_out, int out_size, void* d_ws, size_t ws_size, hipStream_t stream) {
    static int grid = 0;
    if (grid == 0) {
        if (n_in != 23 || in_sizes[0] != MP * DM || out_size != MT * DM || ws_size < WS_END) { fprintf(stderr, "kernel_launch: unexpected shapes (n_in %d, in0 %d, out %d, ws %zu)\n", n_in, n_in > 0 ? in_sizes[0] : -1, out_size, ws_size); grid = -1; return; }
        int dev = 0, cus = 0;
        if (hipGetDevice(&dev) != hipSuccess || hipDeviceGetAttribute(&cus, hipDeviceAttributeMultiprocessorCount, dev) != hipSuccess) { grid = -1; return; }
        if (hipFuncSetAttribute((const void*)hymba_fwd, hipFuncAttributeMaxDynamicSharedMemorySize, LDS_BYTES) != hipSuccess) { fprintf(stderr, "kernel_launch: hipFuncSetAttribute failed\n"); grid = -1; return; }
        (void)hipGetLastError();
        grid = cus;
    }
    if (grid < 0) return;
    if (hipMemsetAsync((char*)d_ws + WS_CTL, 0, CTL_ZERO_BYTES, stream) != hipSuccess) return;
    Args a{};
    for (int i = 0; i < 23; ++i) a.in[i] = (const float*)d_in[i];
    a.out = (float*)d_out; a.ws = (unsigned char*)d_ws;
    for (int li = 0; li < N_LAUNCHES; ++li) {
        a.ph_lo = (N_LAUNCHES == PER_PHASE) ? li : 0; a.ph_hi = (N_LAUNCHES == PER_PHASE) ? li + 1 : PER_PHASE; a.li = li;
        hipLaunchKernelGGL(hymba_fwd, dim3(grid), dim3(NWAVES * 64), LDS_BYTES, stream, a);
        const hipError_t le = hipPeekAtLastError();
        if (le != hipSuccess) { fprintf(stderr, "kernel_launch: launch %d failed: %s\n", li, hipGetErrorName(le)); break; }
    }
}
```

```cpp
#include <hip/hip_runtime.h>
#include <cstdio>
#include <cstdint>
namespace pg8 {
#define PG8_LAS __attribute__((address_space(3)))
typedef unsigned short bf16_t;
typedef short bf16x8 __attribute__((ext_vector_type(8)));
typedef float f32x4 __attribute__((ext_vector_type(4)));
typedef unsigned u32x4 __attribute__((ext_vector_type(4)));
constexpr int BM = 256, BK = 64, HALF = 128, HTB = HALF * BK * 2  , STAGE_BYTES = 8 * HTB, NXCD = 8, WGM = 8;

__host__ __device__ __forceinline__ int lds_byte(int r, int c) { const int st = (r >> 4) * 2 + (c >> 5), rr = r & 15, cc = c & 31, ob = rr * 64 + cc * 2; return st * 1024 + (ob ^ (((ob >> 9) & 1) << 5)); }
__host__ __device__ __forceinline__ void stage_rc(int b, int& R, int& C) { const int st = b / 1024, sb = b % 1024, swz = sb ^ (((sb >> 9) & 1) << 5); R = (st >> 1) * 16 + swz / 64; C = (st & 1) * 32 + (swz % 64) / 2; }
__host__ __device__ __forceinline__ int perm32(int rho) { const int n = rho >> 4, i = rho & 15; return 8 * (i >> 2) + 4 * n + (i & 3); }

struct Unit { int pm, pn; };
struct Gemm { const bf16_t* A; const bf16_t* Bt; int M, N, K; };

struct StaticOrder {
    int nM, nN, nwg, G, c;
    __host__ __device__ void init(int M, int N, int G_, int c_) { nM = M / BM; nN = N / BM; nwg = nM * nN; G = G_; c = c_; }
    __host__ __device__ bool next(int i, Unit& u) const {
        const long L = (long)i * G + c; if (L >= nwg) return false;
        int wgid = (int)L; { const int q = nwg / NXCD, r = nwg % NXCD, xcd = wgid % NXCD, off = wgid / NXCD; wgid = (xcd < r ? xcd * (q + 1) : r * (q + 1) + (xcd - r) * q) + off; }
        const int nig = WGM * nN, gid = wgid / nig, fm = gid * WGM, gsz = (nM - fm) < WGM ? (nM - fm) : WGM;
        u.pm = fm + ((wgid % nig) % gsz); u.pn = (wgid % nig) / gsz; return true;
    }
    __device__ __forceinline__ void a_ready(const Unit&) const {}
    __device__ __forceinline__ void done(const Unit&) const {}
};

__device__ __forceinline__ unsigned cvt_pk_bf16(float lo, float hi) { unsigned r; asm volatile("v_cvt_pk_bf16_f32 %0, %1, %2" : "=v"(r) : "v"(lo), "v"(hi)); return r; }
typedef float f32x2 __attribute__((ext_vector_type(2)));
template <class Epi, class Sched, bool ALIGN_EPI = false, bool SP2 = false>
__device__ __forceinline__ void gemm_phase(PG8_LAS unsigned char* lds, const Gemm g, const Sched& S, const Epi& E) {
    const int tid = threadIdx.x, wid = __builtin_amdgcn_readfirstlane(tid >> 6), lane = tid & 63, wr = wid >> 2, wc = wid & 3, fr = lane & 15, fq = lane >> 4;
    const int K = g.K, nt = K / BK;
    unsigned voffA[2], voffB[2];
#pragma unroll
    for (int i = 0; i < 2; ++i) { int R, C; stage_rc(tid * 16 + i * 8192, R, C); const int Rb = Epi::PERM ? ((R & ~31) + perm32(R & 31)) : R;
        voffA[i] = (unsigned)(R * K + C) * 2u; voffB[i] = (unsigned)(Rb * K + C) * 2u; }
    const size_t kstep = (size_t)(BK * 2);
    const size_t hstep = (size_t)HALF * K * 2;
    const size_t tstep = 2 * hstep;
    const unsigned ldsw = (unsigned)wid * 1024u;
    const int aoff = lds_byte(wr * 64 + fr, fq * 8), boff = lds_byte(wc * 32 + fr, fq * 8);
#define PG8_SA(b, h) (((b) * 2 + (h)) * HTB)
#define PG8_SB(b, h) ((4 + (b) * 2 + (h)) * HTB)
#define PG8_STAGE(bufoff, gbase, voff) do { _Pragma("unroll") for (int _i = 0; _i < 2; ++_i) \
        __builtin_amdgcn_global_load_lds((const unsigned*)((const char*)(gbase) + (voff)[_i]), (PG8_LAS unsigned*)(lds + (bufoff) + ldsw + _i * 8192), 16, 0, 0); } while (0)
#define PG8_LDA(dst, b, h) do { _Pragma("unroll") for (int m = 0; m < 4; ++m) _Pragma("unroll") for (int k = 0; k < 2; ++k) dst[m][k] = *(const PG8_LAS bf16x8*)(lds + PG8_SA(b, h) + aoff + m * 2048 + k * 1024); } while (0)
#define PG8_LDB(dst, b, h) do { _Pragma("unroll") for (int n = 0; n < 2; ++n) _Pragma("unroll") for (int k = 0; k < 2; ++k) dst[n][k] = *(const PG8_LAS bf16x8*)(lds + PG8_SB(b, h) + boff + n * 2048 + k * 1024); } while (0)
#define PG8_MMA(ai, bj, At, Bt) do { __builtin_amdgcn_s_setprio(1); _Pragma("unroll") for (int m = 0; m < 4; ++m) _Pragma("unroll") for (int n = 0; n < 2; ++n) _Pragma("unroll") for (int k = 0; k < 2; ++k) \
        acc[ai][bj][m][n] = __builtin_amdgcn_mfma_f32_16x16x32_bf16(Bt[n][k], At[m][k], acc[ai][bj][m][n], 0, 0, 0); __builtin_amdgcn_s_setprio(0); } while (0)
#define PG8_WAIT_V(n) asm volatile("s_waitcnt vmcnt(" #n ")" ::: "memory")
#define PG8_WAIT_L(n) asm volatile("s_waitcnt lgkmcnt(" #n ")" ::: "memory")
#define PG8_BAR __builtin_amdgcn_s_barrier()
#define PG8_SCHED __builtin_amdgcn_sched_barrier(0)
    Unit cur, nxt; int ui = 0;
    if (!S.next(0, cur)) return;
    f32x4 acc[2][2][4][2];
#pragma unroll
    for (int a = 0; a < 2; ++a)
#pragma unroll
        for (int b = 0; b < 2; ++b)
#pragma unroll
            for (int m = 0; m < 4; ++m)
#pragma unroll
                for (int n = 0; n < 2; ++n) acc[a][b][m][n] = (f32x4){0.f, 0.f, 0.f, 0.f};
    bf16x8 At[4][2], B0[2][2], B1[2][2];
    const char* cA = (const char*)g.A + (size_t)cur.pm * tstep; const char* cB = (const char*)g.Bt + (size_t)cur.pn * tstep;
    S.a_ready(cur);
    if constexpr (SP2) {
        PG8_STAGE(PG8_SB(0, 0), cB, voffB); PG8_STAGE(PG8_SB(0, 1), cB + hstep, voffB); PG8_STAGE(PG8_SA(0, 0), cA, voffA); PG8_STAGE(PG8_SA(0, 1), cA + hstep, voffA);
        if (wr == 1) PG8_BAR;
        PG8_WAIT_V(2); PG8_BAR;
        PG8_STAGE(PG8_SB(1, 0), cB + kstep, voffB); PG8_STAGE(PG8_SA(1, 0), cA + kstep, voffA); PG8_STAGE(PG8_SB(1, 1), cB + hstep + kstep, voffB);
        PG8_WAIT_V(6); PG8_BAR;
    } else {
        PG8_STAGE(PG8_SB(0, 0), cB, voffB); PG8_STAGE(PG8_SA(0, 0), cA, voffA); PG8_STAGE(PG8_SB(0, 1), cB + hstep, voffB); PG8_STAGE(PG8_SA(0, 1), cA + hstep, voffA);
        if (wr == 1) PG8_BAR;
        PG8_WAIT_V(4); PG8_BAR;
        PG8_STAGE(PG8_SB(1, 0), cB + kstep, voffB); PG8_STAGE(PG8_SA(1, 0), cA + kstep, voffA); PG8_STAGE(PG8_SB(1, 1), cB + hstep + kstep, voffB);
        PG8_WAIT_V(6); PG8_BAR;
    }
    for (;;) {
        const bool has_next = S.next(ui + 1, nxt);
        const char* nA = has_next ? (const char*)g.A + (size_t)nxt.pm * tstep : cA; const char* nB = has_next ? (const char*)g.Bt + (size_t)nxt.pn * tstep : cB;
        for (int t = 0; t < nt; t += 2) {
            const bool last = (t == nt - 2);
            const char* a1 = cA + (size_t)(t + 1) * kstep;
            const char* a2 = last ? nA : cA + (size_t)(t + 2) * kstep; const char* b2 = last ? nB : cB + (size_t)(t + 2) * kstep;
            const char* a3 = a2 + kstep; const char* b3 = b2 + kstep;
            if (last && has_next) S.a_ready(nxt);
            if constexpr (SP2) {
            PG8_LDB(B0, 0, 0); PG8_LDB(B1, 0, 1); PG8_SCHED; PG8_LDA(At, 0, 0); PG8_STAGE(PG8_SA(1, 1), a1 + hstep, voffA);
            PG8_WAIT_V(8); PG8_WAIT_L(0); PG8_BAR; PG8_MMA(0, 0, At, B0); PG8_MMA(0, 1, At, B1); PG8_BAR; PG8_SCHED;
            PG8_LDA(At, 0, 1); PG8_STAGE(PG8_SB(0, 0), b2, voffB); PG8_STAGE(PG8_SB(0, 1), b2 + hstep, voffB); PG8_STAGE(PG8_SA(0, 0), a2, voffA);
            PG8_WAIT_V(8); PG8_WAIT_L(0); PG8_BAR; PG8_MMA(1, 0, At, B0); PG8_MMA(1, 1, At, B1); PG8_BAR; PG8_SCHED;
            PG8_LDB(B0, 1, 0); PG8_LDB(B1, 1, 1); PG8_SCHED; PG8_LDA(At, 1, 0); PG8_STAGE(PG8_SA(0, 1), a2 + hstep, voffA);
            PG8_WAIT_V(8); PG8_WAIT_L(0); PG8_BAR; PG8_MMA(0, 0, At, B0); PG8_MMA(0, 1, At, B1); PG8_BAR; PG8_SCHED;
            PG8_LDA(At, 1, 1); PG8_STAGE(PG8_SB(1, 0), b3, voffB); PG8_STAGE(PG8_SB(1, 1), b3 + hstep, voffB); PG8_STAGE(PG8_SA(1, 0), a3, voffA);
            PG8_WAIT_V(8); PG8_WAIT_L(0); PG8_BAR; PG8_MMA(1, 0, At, B0); PG8_MMA(1, 1, At, B1); PG8_BAR; PG8_SCHED;
            } else {
            PG8_LDB(B0, 0, 0); PG8_SCHED; PG8_LDA(At, 0, 0); PG8_STAGE(PG8_SA(1, 1), a1 + hstep, voffA);
            PG8_WAIT_L(8); PG8_BAR; PG8_WAIT_L(0); PG8_MMA(0, 0, At, B0); PG8_BAR; PG8_SCHED;
            PG8_LDB(B1, 0, 1); PG8_STAGE(PG8_SB(0, 0), b2, voffB);
            PG8_BAR; PG8_WAIT_L(0); PG8_MMA(0, 1, At, B1); PG8_BAR;
            PG8_LDA(At, 0, 1); PG8_STAGE(PG8_SA(0, 0), a2, voffA);
            PG8_BAR; PG8_WAIT_L(0); PG8_MMA(1, 0, At, B0); PG8_BAR; PG8_SCHED;
            PG8_STAGE(PG8_SB(0, 1), b2 + hstep, voffB);
            PG8_WAIT_V(6); PG8_BAR; PG8_MMA(1, 1, At, B1); PG8_BAR;
            PG8_LDB(B0, 1, 0); PG8_SCHED; PG8_LDA(At, 1, 0); PG8_STAGE(PG8_SA(0, 1), a2 + hstep, voffA);
            PG8_WAIT_L(8); PG8_BAR; PG8_WAIT_L(0); PG8_MMA(0, 0, At, B0); PG8_BAR; PG8_SCHED;
            PG8_LDB(B1, 1, 1); PG8_STAGE(PG8_SB(1, 0), b3, voffB);
            PG8_BAR; PG8_WAIT_L(0); PG8_MMA(0, 1, At, B1); PG8_BAR;
            PG8_LDA(At, 1, 1); PG8_STAGE(PG8_SA(1, 0), a3, voffA);
            PG8_BAR; PG8_WAIT_L(0); PG8_MMA(1, 0, At, B0); PG8_BAR; PG8_SCHED;
            PG8_STAGE(PG8_SB(1, 1), b3 + hstep, voffB);
            PG8_WAIT_V(6); PG8_BAR; PG8_MMA(1, 1, At, B1); PG8_BAR;
            }
        }
        if constexpr (ALIGN_EPI) { if (wr == 0) PG8_BAR; }
        if constexpr (!Epi::AFTER_DRAIN) { E(acc, cur, wr, wc, fr, fq); S.done(cur); }
        if (!has_next) break;
#pragma unroll
        for (int a = 0; a < 2; ++a)
#pragma unroll
            for (int b = 0; b < 2; ++b)
#pragma unroll
                for (int m = 0; m < 4; ++m)
#pragma unroll
                    for (int n = 0; n < 2; ++n) acc[a][b][m][n] = (f32x4){0.f, 0.f, 0.f, 0.f};
        cur = nxt; cA = nA; cB = nB; ++ui;
        if constexpr (ALIGN_EPI) { if (wr == 1) PG8_BAR; }
    }
    PG8_WAIT_V(0);
    if constexpr (!ALIGN_EPI) { if (wr == 0) PG8_BAR; }
    PG8_BAR;
    if constexpr (Epi::AFTER_DRAIN) { E.fused(acc, cur, wr, wc, fr, fq, lds, wid, lane); S.done(cur); }
#undef PG8_SA
#undef PG8_SB
#undef PG8_STAGE
#undef PG8_LDA
#undef PG8_LDB
#undef PG8_MMA
#undef PG8_WAIT_V
#undef PG8_WAIT_L
#undef PG8_BAR
#undef PG8_SCHED
}
}

#define GAS __attribute__((address_space(1)))
#define LAS __attribute__((address_space(3)))
typedef unsigned short bf16;
typedef unsigned v4u __attribute__((ext_vector_type(4)));
typedef float f32x4 __attribute__((ext_vector_type(4)));
typedef short bf16x8 __attribute__((ext_vector_type(8)));
typedef GAS unsigned gu32;
typedef GAS unsigned long long gu64;
#define RLX_AGENT __ATOMIC_RELAXED, __HIP_MEMORY_SCOPE_AGENT
#define LDS_WAIT() asm volatile("s_waitcnt lgkmcnt(0)" ::: "memory")
#define VM_WAIT() asm volatile("s_waitcnt vmcnt(0)" ::: "memory")
__device__ __forceinline__ unsigned long long rt() { return __builtin_amdgcn_s_memrealtime(); }
__device__ __forceinline__ unsigned f2bf(float f) { unsigned u = __builtin_bit_cast(unsigned, f); return (u + 0x7fffu + ((u >> 16) & 1u)) >> 16; }
__device__ __forceinline__ unsigned pk2(float lo, float hi) { return f2bf(lo) | (f2bf(hi) << 16); }

#define XB_TMO      128
#define XB_XCNT(j)  (256  + 64 * (j))
#define XB_XSUB(j)  (1280 + 64 * (j))
#define XB_XGEN(j)  (2304 + 64 * (j))
#define XB_TOP      3328
#define XB_TOPGEN   3392
#define XCD_BAR_WORDS 3456
#define XB_SPIN_CAP (1u << 18)

__device__ __forceinline__ unsigned xb_ld(unsigned* p)              { return __hip_atomic_load(p, __ATOMIC_RELAXED, __HIP_MEMORY_SCOPE_AGENT); }
__device__ __forceinline__ unsigned xb_add(unsigned* p, unsigned v) { return __hip_atomic_fetch_add(p, v, __ATOMIC_RELAXED, __HIP_MEMORY_SCOPE_AGENT); }
__device__ __forceinline__ unsigned xb_xcc_id() { return (unsigned)__builtin_amdgcn_s_getreg((3 << 11) | 20) & 0xFu; }
#define XB_SPIN(cond, bar) do { unsigned _sp = 0; while (cond) { __builtin_amdgcn_s_sleep(1); \
    if ((++_sp & 255u) == 0u) { if (xb_ld(&(bar)[XB_TMO])) break; if (_sp > XB_SPIN_CAP) { atomicAdd(&(bar)[XB_TMO], 1u); break; } } } } while (0)

struct XcdBarrier {
    unsigned* bar; unsigned x;
    volatile LAS unsigned* st;
};

__device__ __forceinline__ XcdBarrier xcd_barrier_post(unsigned* bar, volatile LAS unsigned* st) {
    XcdBarrier b; b.bar = bar; b.x = xb_xcc_id(); b.st = st;
    if (threadIdx.x == 0) (void)xb_add(&bar[XB_XCNT(b.x)], 1u);
    return b;
}
__device__ __forceinline__ void xcd_barrier_complete(unsigned* bar, unsigned x, unsigned& nloc, unsigned& nx) {
    const unsigned G = gridDim.x * gridDim.y * gridDim.z;
    unsigned sum, cnt, mine, sp = 0u;
    for (;;) {
        sum = 0u; cnt = 0u; mine = 0u;
#pragma unroll
        for (unsigned j = 0; j < 16; ++j) { const unsigned c = xb_ld(&bar[XB_XCNT(j)]); sum += c; cnt += (c > 0u) ? 1u : 0u; mine = (j == x) ? c : mine; }
        if (sum == G) break;
        __builtin_amdgcn_s_sleep(1);
        if ((++sp & 255u) == 0u) { if (xb_ld(&bar[XB_TMO])) break; if (sp > XB_SPIN_CAP) { atomicAdd(&bar[XB_TMO], 1u); break; } }
    }
    nloc = mine > 0u ? mine : 1u; nx = cnt > 0u ? cnt : 1u;
}

__device__ __forceinline__ void xcd_barrier(const XcdBarrier& b) {
    asm volatile("s_waitcnt vmcnt(0)" ::: "memory");
    __syncthreads();
    if (threadIdx.x == 0) {
        unsigned* bar = b.bar;
        __builtin_amdgcn_s_waitcnt(0);
        unsigned nloc = b.st[0], nx = b.st[1];
        if (nloc == 0u) { xcd_barrier_complete(bar, b.x, nloc, nx); b.st[0] = nloc; b.st[1] = nx; }
        const unsigned old = xb_add(&bar[XB_XSUB(b.x)], 1u);
        const unsigned gen = old / nloc;
        if (old + 1u == (gen + 1u) * nloc) {
            __builtin_amdgcn_fence(__ATOMIC_RELEASE, "agent");
            asm volatile("s_waitcnt vmcnt(0)" ::: "memory");
            const unsigned og = xb_add(&bar[XB_TOP], 1u);
            const unsigned tg = og / nx;
            if (og + 1u == (tg + 1u) * nx) xb_add(&bar[XB_TOPGEN], 1u);
            else XB_SPIN(xb_ld(&bar[XB_TOPGEN]) == tg, bar);
            __builtin_amdgcn_fence(__ATOMIC_ACQUIRE, "agent");
            xb_add(&bar[XB_XGEN(b.x)], 1u);
            asm volatile("s_waitcnt vmcnt(0)" ::: "memory");
        } else {
            XB_SPIN(xb_ld(&bar[XB_XGEN(b.x)]) == gen, bar);
            __builtin_amdgcn_fence(__ATOMIC_ACQUIRE, "agent");
            asm volatile("s_waitcnt vmcnt(0)" ::: "memory");
        }
    }
    __syncthreads();
}


constexpr int NWAVES = 8;
#define DUP_SEL 0
#ifndef MK_N_LAUNCHES
#define MK_N_LAUNCHES 1
#endif
constexpr int PER_PHASE = 6;
constexpr int N_LAUNCHES = MK_N_LAUNCHES;

constexpr int DM = 1024, DIN = 3584, LP = 8192, LS = 2048, NBATCH = 8;
constexpr int MP = NBATCH * LP, MS = NBATCH * LS, MT = MP + MS;
constexpr int DHY = 384, NH = 6, NHM = 4, HD = 64, NMEM = 256, DMKV = 512;
constexpr int MMEM = 2 * NBATCH * NMEM;
constexpr float RMS_EPS = 1e-6f;

constexpr size_t MiB = 1u << 20;
constexpr size_t WS_CTL = 0, CTL_ZERO_BYTES = 1 * MiB;
constexpr size_t WS_WTIN = 2 * MiB;
constexpr size_t WS_WTOUT = 10 * MiB;
constexpr size_t WS_WTMKV = 12 * MiB;
constexpr size_t WS_MEMB = 13 * MiB;
constexpr size_t WS_KM = 21 * MiB;
constexpr size_t WS_VM = 23 * MiB;
constexpr size_t WS_H2P = 25 * MiB;
constexpr size_t WS_H2S = 27 * MiB;
constexpr size_t WS_BIAS = 28 * MiB;
constexpr size_t WS_GAINS = 28 * MiB + 65536;
constexpr size_t WS_RSTD = 28 * MiB + 262144;
constexpr size_t WS_CONSTS = 28 * MiB + 131072;
constexpr size_t WS_KSP = 29 * MiB;
constexpr size_t WS_KSS = 77 * MiB;
constexpr size_t WS_XB = 90 * MiB;
constexpr size_t WS_ST = 90 * MiB;
constexpr size_t WS_CT = 150 * MiB;
constexpr size_t WS_ZHY = 250 * MiB;
constexpr size_t WS_Q = 430 * MiB, WS_K = 490 * MiB, WS_V = 550 * MiB;
constexpr size_t WS_MQ = 610 * MiB;
constexpr size_t WS_MIX = 650 * MiB;
constexpr size_t WS_OC = 810 * MiB;
constexpr size_t WS_LC = 990 * MiB;
constexpr size_t WS_END = 996 * MiB;
static_assert(WS_VM - WS_KM >= (size_t)16 * 4 * 256 * 64 * 2 && WS_H2P - WS_VM >= (size_t)16 * 4 * 256 * 64 * 2 && WS_KSS - WS_KSP >= (size_t)384 * 2 * 8192 * 8 && WS_XB - WS_KSS >= (size_t)384 * 2 * 2048 * 8, "ws map");
static_assert(WS_ZHY - WS_XB >= (size_t)81920 * 1024 * 2 && WS_CT - WS_ST >= (size_t)81920 * 384 * 2 && WS_ZHY - WS_CT >= (size_t)81920 * 384 * 2 && WS_Q - WS_ZHY >= (size_t)81920 * 1152 * 2, "ws map");
static_assert(WS_K - WS_Q >= (size_t)81920 * 384 * 2 && WS_MQ - WS_V >= (size_t)81920 * 384 * 2 && WS_MIX - WS_MQ >= (size_t)81920 * 256 * 2 && WS_END - WS_MIX >= (size_t)81920 * 1024 * 2, "ws map");
constexpr int CW_TMO = 0, CW_CODE = 1, CW_BAR = 4096;

constexpr int RING_OFF = 0, RING_BYTES = 131072;
constexpr int LDS_BYTES = 147456;
constexpr int LDSCTL_OFF = LDS_BYTES - 512, MISC_OFF = LDSCTL_OFF + 320;

typedef float cf2 __attribute__((ext_vector_type(2)));
typedef unsigned u32x2 __attribute__((ext_vector_type(2)));
typedef unsigned u32x4 __attribute__((ext_vector_type(4)));

__device__ __forceinline__ float bf2f(unsigned short h) { return __builtin_bit_cast(float, (unsigned)h << 16); }
__device__ __forceinline__ float bflo(unsigned w) { return __builtin_bit_cast(float, w << 16); }
__device__ __forceinline__ float bfhi(unsigned w) { return __builtin_bit_cast(float, w & 0xffff0000u); }
__device__ __forceinline__ cf2 cmul(cf2 a, cf2 b) { return (cf2){a.x * b.x - a.y * b.y, a.x * b.y + a.y * b.x}; }
__device__ __forceinline__ cf2 cmulc(cf2 a, cf2 b) { return (cf2){a.x * b.x + a.y * b.y, a.y * b.x - a.x * b.y}; }

__device__ __forceinline__ int bb_rowbase(int bb) { return bb < 8 ? bb * LP : MP + (bb - 8) * LS; }
__device__ __forceinline__ int bb_len(int bb) { return bb < 8 ? LP : LS; }
__device__ __forceinline__ void row_to_bt(int row, int& bb, int& t) { if (row < MP) { bb = row >> 13; t = row & (LP - 1); } else { const int r = row - MP; bb = 8 + (r >> 11); t = r & (LS - 1); } }

__device__ __forceinline__ int lane_now() { int l; asm volatile("v_mbcnt_lo_u32_b32 %0, -1, 0\n\tv_mbcnt_hi_u32_b32 %0, -1, %0" : "=v"(l)); return l; }
struct Frame {
    LAS unsigned char* lds;
    volatile LAS unsigned* MISC;
    gu32* ctl;
    int tid, lane, wave, vcu, G;
    long woff;
    const float *xp, *xs, *memp, *mems, *norm_in, *w_in, *conv_w, *conv_b, *fw1, *fb1, *ffreq, *fw2, *fb2, *fw3, *skip, *gq, *gk, *mem_norm, *w_mkv, *gmq, *gmk, *w_out, *rel_bias;
    float* out;
    bf16 *WTin, *WTout, *WTmkv, *MEMB, *KM, *VM, *XB, *ST, *CT, *ZHY, *Q, *K, *V, *MQ, *MIX;
    float *H2P, *H2S, *BIAS, *GAINS, *CONSTS, *LC, *FBP, *FBS, *RSTD; bf16* OC;
    cf2 *KSP, *KSS;
};

namespace pg8 {
__device__ __forceinline__ u32x4 pack8(f32x4 a, f32x4 b) { u32x4 w; w.x = cvt_pk_bf16(a[0], a[1]); w.y = cvt_pk_bf16(a[2], a[3]); w.z = cvt_pk_bf16(b[0], b[1]); w.w = cvt_pk_bf16(b[2], b[3]); return w; }
__device__ __forceinline__ float dot4(f32x4 a) { return (a[0] * a[0] + a[1] * a[1]) + (a[2] * a[2] + a[3] * a[3]); }
__device__ __forceinline__ float lane_xor1(float x) { return __builtin_bit_cast(float, __builtin_amdgcn_mov_dpp(__builtin_bit_cast(int, x), 0xB1, 0xF, 0xF, true)); }
__device__ __forceinline__ float asm_add(unsigned a, unsigned b) { float r; asm("v_add_f32_e32 %0, %1, %2" : "=v"(r) : "v"(a), "v"(b)); return r; }
__device__ __forceinline__ float sum_rows4(float x) {
    const unsigned x0 = __builtin_bit_cast(unsigned, x);
    const auto a = __builtin_amdgcn_permlane16_swap(x0, x0, false, false);
    const float y = asm_add(a[0], a[1]);
    const unsigned y0 = __builtin_bit_cast(unsigned, y);
    const auto b = __builtin_amdgcn_permlane32_swap(y0, y0, false, false);
    return asm_add(b[0], b[1]);
}
__device__ __forceinline__ float silu_f(float x) { return x * __builtin_amdgcn_rcpf(1.0f + __builtin_amdgcn_exp2f(-1.4426950408889634f * x)); }
__device__ __forceinline__ f32x4 silu4(f32x4 a) { return (f32x4){silu_f(a[0]), silu_f(a[1]), silu_f(a[2]), silu_f(a[3])}; }

template <int TM = 7> struct EpiZT {
    static constexpr bool PERM = true, AFTER_DRAIN = false;
    unsigned char* ws; const float* gains;
    __device__ __forceinline__ void operator()(const f32x4 (&acc)[2][2][4][2], const Unit& u, int wr, int wc, int fr, int fq) const {
        const int G = u.pn * 4 + wc, hc0 = 8 * fq;
        const int row0 = u.pm * BM + wr * 64 + fr;
        int bb, t0; row_to_bt(u.pm * BM, bb, t0);
        const int rb = bb_rowbase(bb), L = bb_len(bb);
        const bool live = (G < 18) ? (TM & 1) : (G < 40) ? (TM & 2) : (TM & 4);
        if (!live) {
#pragma unroll
            for (int ai = 0; ai < 2; ++ai)
#pragma unroll
                for (int m = 0; m < 4; ++m)
#pragma unroll
                    for (int bj = 0; bj < 2; ++bj)
#pragma unroll
                        for (int n = 0; n < 2; ++n) asm volatile("" :: "v"(acc[ai][bj][m][n]));
        } else if (G < 18) {
            const bool odd = fr & 1;
            bf16_t* zt = (bf16_t*)(ws + WS_ZHY) + (size_t)rb * 1152 + (size_t)(G * 64 + hc0 + (odd ? 32 : 0)) * L;
#pragma unroll
            for (int ai = 0; ai < 2; ++ai)
#pragma unroll
                for (int m = 0; m < 4; ++m) { const int te = (row0 + ai * HALF + m * 16 - rb) & ~1;
#pragma unroll
                    for (int k = 0; k < 8; ++k) { const float lo = acc[ai][0][m][k >> 2][k & 3], hi = acc[ai][1][m][k >> 2][k & 3];
                        const float send = odd ? lo : hi, recv = lane_xor1(send);
                        *(unsigned*)(zt + (size_t)k * L + te) = cvt_pk_bf16(odd ? recv : lo, odd ? hi : recv); } }
        } else if (G < 40) {
            const bool ismq = G >= 36;
            const int part = ismq ? 0 : (G - 18) / 6;
            const int h = ismq ? G - 36 : (G - 18) - 6 * part;
            const bool isv = (part == 2);
            const int nh = ismq ? NHM : NH;
            bf16_t* base = (bf16_t*)(ws + (ismq ? WS_MQ : WS_Q + (size_t)part * (WS_K - WS_Q)));
            const float* gain = gains + (ismq ? 128 : (part == 0 ? 0 : 64));
            const float scale = (ismq || part == 0) ? 0.125f * 1.4426950408889634f : 1.0f;
            if (isv) {
#pragma unroll
                for (int ai = 0; ai < 2; ++ai)
#pragma unroll
                    for (int m = 0; m < 4; ++m) { const int row = row0 + ai * HALF + m * 16; const int t = row - rb;
                        bf16_t* d = base + ((size_t)rb * nh + (size_t)h * L + t) * 64 + hc0;
                        *(u32x4*)d = pack8(acc[ai][0][m][0], acc[ai][0][m][1]); *(u32x4*)(d + 32) = pack8(acc[ai][1][m][0], acc[ai][1][m][1]); }
            } else {
                const f32x4 g0 = *(const f32x4*)(gain + hc0), g1 = *(const f32x4*)(gain + hc0 + 4), g2 = *(const f32x4*)(gain + 32 + hc0), g3 = *(const f32x4*)(gain + 36 + hc0);
#pragma unroll
                for (int ai = 0; ai < 2; ++ai)
#pragma unroll
                    for (int m = 0; m < 4; ++m) { const int row = row0 + ai * HALF + m * 16; const int t = row - rb;
                        f32x4 a0 = acc[ai][0][m][0], a1 = acc[ai][0][m][1], b0 = acc[ai][1][m][0], b1 = acc[ai][1][m][1];
                        const float ss = sum_rows4((dot4(a0) + dot4(a1)) + (dot4(b0) + dot4(b1)));
                        const float r = __builtin_amdgcn_rsqf(ss * (1.0f / 64.0f) + RMS_EPS) * scale;
                        a0 = a0 * r * g0; a1 = a1 * r * g1; b0 = b0 * r * g2; b1 = b1 * r * g3;
                        bf16_t* d = base + ((size_t)rb * nh + (size_t)h * L + t) * 64 + hc0;
                        *(u32x4*)d = pack8(a0, a1); *(u32x4*)(d + 32) = pack8(b0, b1); }
            }
        } else {
            const int col = (G - 40) * 64 + hc0;
#pragma unroll
            for (int ai = 0; ai < 2; ++ai)
#pragma unroll
                for (int m = 0; m < 4; ++m) { const int row = row0 + ai * HALF + m * 16; bf16_t* d = (bf16_t*)(ws + WS_MIX) + (size_t)row * DM + col;
                    *(u32x4*)d = pack8(silu4(acc[ai][0][m][0]), silu4(acc[ai][0][m][1])); *(u32x4*)(d + 32) = pack8(silu4(acc[ai][1][m][0]), silu4(acc[ai][1][m][1])); }
        }
    }
};
typedef EpiZT<7> EpiZ;
struct EpiMKV {
    static constexpr bool PERM = true, AFTER_DRAIN = false;
    bf16_t* km; const float* gmk;
    __device__ __forceinline__ void operator()(const f32x4 (&acc)[2][2][4][2], const Unit& u, int wr, int wc, int fr, int fq) const {
        const int G = u.pn * 4 + wc, hc0 = 8 * fq, h = G & 3; const bool isk = G < 4;
        const int row0 = u.pm * BM + wr * 64 + fr;
        bf16_t* basep = km + (isk ? (size_t)0 : (size_t)(WS_VM - WS_KM) / 2) + hc0;
        if (!isk) {
#pragma unroll
            for (int ai = 0; ai < 2; ++ai)
#pragma unroll
                for (int m = 0; m < 4; ++m) { const int row = row0 + ai * HALF + m * 16; const int bbm = row >> 8, j = row & 255;
                    bf16_t* d = basep + ((size_t)(bbm * NHM + h) * NMEM + j) * 64;
                    *(u32x4*)d = pack8(acc[ai][0][m][0], acc[ai][0][m][1]); *(u32x4*)(d + 32) = pack8(acc[ai][1][m][0], acc[ai][1][m][1]); }
        } else {
            const f32x4 g0 = *(const f32x4*)(gmk + hc0), g1 = *(const f32x4*)(gmk + hc0 + 4), g2 = *(const f32x4*)(gmk + 32 + hc0), g3 = *(const f32x4*)(gmk + 36 + hc0);
#pragma unroll
            for (int ai = 0; ai < 2; ++ai)
#pragma unroll
                for (int m = 0; m < 4; ++m) { const int row = row0 + ai * HALF + m * 16; const int bbm = row >> 8, j = row & 255;
                    f32x4 a0 = acc[ai][0][m][0], a1 = acc[ai][0][m][1], b0 = acc[ai][1][m][0], b1 = acc[ai][1][m][1];
                    const float ss = sum_rows4((dot4(a0) + dot4(a1)) + (dot4(b0) + dot4(b1)));
                    const float r = __builtin_amdgcn_rsqf(ss * (1.0f / 64.0f) + RMS_EPS);
                    a0 = a0 * r * g0; a1 = a1 * r * g1; b0 = b0 * r * g2; b1 = b1 * r * g3;
                    bf16_t* d = basep + ((size_t)(bbm * NHM + h) * NMEM + j) * 64;
                    *(u32x4*)d = pack8(a0, a1); *(u32x4*)(d + 32) = pack8(b0, b1); }
        }
    }
};
struct EpiOut {
    static constexpr bool PERM = false, AFTER_DRAIN = false;
    const bf16_t* xb; const float* rstd; float* out; float osc;
    __device__ __forceinline__ void operator()(const f32x4 (&acc)[2][2][4][2], const Unit& u, int wr, int wc, int fr, int fq) const {
        const int row0 = u.pm * BM + wr * 64 + fr, col0 = u.pn * BM + wc * 32 + 4 * fq;
        u32x2 w[2][4][2][2]; float rms[2][4];
#pragma unroll
        for (int ai = 0; ai < 2; ++ai)
#pragma unroll
            for (int m = 0; m < 4; ++m) { const int row = row0 + ai * HALF + m * 16; rms[ai][m] = rstd[row];
#pragma unroll
                for (int bj = 0; bj < 2; ++bj)
#pragma unroll
                    for (int n = 0; n < 2; ++n) w[ai][m][bj][n] = *(const u32x2*)(xb + (size_t)row * DM + col0 + bj * HALF + n * 16); }
#pragma unroll
        for (int ai = 0; ai < 2; ++ai)
#pragma unroll
            for (int m = 0; m < 4; ++m) { const int row = row0 + ai * HALF + m * 16; const float r = 1.0f / rms[ai][m]; const size_t ro = (size_t)row * DM + col0;
#pragma unroll
                for (int bj = 0; bj < 2; ++bj)
#pragma unroll
                    for (int n = 0; n < 2; ++n) { const u32x2 ww = w[ai][m][bj][n];
                        const f32x4 x0 = {__builtin_bit_cast(float, ww.x << 16), __builtin_bit_cast(float, ww.x & 0xffff0000u), __builtin_bit_cast(float, ww.y << 16), __builtin_bit_cast(float, ww.y & 0xffff0000u)};
                        *(f32x4*)(out + ro + bj * HALF + n * 16) = (x0 * r + acc[ai][bj][m][n]) * osc; } }
    }
};
struct EpiNull { static constexpr bool PERM = false, AFTER_DRAIN = false;
    __device__ __forceinline__ void operator()(const f32x4 (&acc)[2][2][4][2], const Unit& u, int wr, int wc, int fr, int fq) const {
#pragma unroll
        for (int ai = 0; ai < 2; ++ai)
#pragma unroll
            for (int m = 0; m < 4; ++m)
#pragma unroll
                for (int bj = 0; bj < 2; ++bj)
#pragma unroll
                    for (int n = 0; n < 2; ++n) asm volatile("" :: "v"(acc[ai][bj][m][n])); } };
struct EpiStoreOnly { static constexpr bool PERM = false, AFTER_DRAIN = false; float* out;
    __device__ __forceinline__ void operator()(const f32x4 (&acc)[2][2][4][2], const Unit& u, int wr, int wc, int fr, int fq) const {
        const int row0 = u.pm * BM + wr * 64 + fr, col0 = u.pn * BM + wc * 32 + 4 * fq; float* o = out + (size_t)row0 * DM;
#pragma unroll
        for (int ai = 0; ai < 2; ++ai)
#pragma unroll
            for (int m = 0; m < 4; ++m) { const size_t ro = (size_t)(ai * HALF + m * 16) * DM + col0;
#pragma unroll
                for (int bj = 0; bj < 2; ++bj)
#pragma unroll
                    for (int n = 0; n < 2; ++n) *(f32x4*)(o + ro + bj * HALF + n * 16) = acc[ai][bj][m][n]; } } };
}

__device__ __forceinline__ float wave_sum(float v) {
#pragma unroll
    for (int o = 1; o < 64; o <<= 1) v += __shfl_xor(v, o);
    return v;
}
__device__ __forceinline__ int head_perm(int n) { const int o = n & 255; return (n & ~255) + 128 * ((o >> 5) & 1) + 32 * (o >> 6) + (o & 31); }
template <bool HP, bool GAIN>
__device__ __forceinline__ void p0_transpose_item(const float* W, const float* gain, int K, int N, bf16* WT, LAS float* scr, int item, int lane) {
    const int nblk = N / 32, kb = item / nblk, nb = item % nblk, k0 = 64 * kb, n0 = 32 * nb;
    float wv[32], gv[32];
#pragma unroll
    for (int i = 0; i < 32; ++i) { const int kk = 2 * i + (lane >> 5); wv[i] = W[(size_t)(k0 + kk) * N + n0 + (lane & 31)]; gv[i] = GAIN ? gain[k0 + kk] : 1.0f; }
#pragma unroll
    for (int i = 0; i < 32; ++i) { const int kk = 2 * i + (lane >> 5); scr[kk * 33 + (lane & 31)] = GAIN ? wv[i] * gv[i] : wv[i]; }
    LDS_WAIT(); asm volatile("" ::: "memory");
    const int c = lane & 7;
#pragma unroll
    for (int j = 0; j < 4; ++j) { const int n = (lane >> 3) + 8 * j; const LAS float* s = scr + (8 * c) * 33 + n;
        v4u o; o.x = pk2(s[0 * 33], s[1 * 33]); o.y = pk2(s[2 * 33], s[3 * 33]); o.z = pk2(s[4 * 33], s[5 * 33]); o.w = pk2(s[6 * 33], s[7 * 33]);
        const int rowo = HP ? head_perm(n0 + n) : (n0 + n);
        *(GAS v4u*)(WT + (size_t)rowo * K + k0 + 8 * c) = o; }
    LDS_WAIT(); asm volatile("" ::: "memory");
}
template <int NR>
__device__ __forceinline__ void rms_rows_pipe(int lane, const float* src, bf16* dst, float* rstd_out, int g0, int gstep, int ng) {
    if (g0 >= ng) return;
    f32x4 v[NR][4], w[NR][4];
    { const GAS f32x4* xr = (const GAS f32x4*)(src + (size_t)g0 * NR * DM) + lane;
#pragma unroll
      for (int i = 0; i < NR; ++i)
#pragma unroll
          for (int j = 0; j < 4; ++j) v[i][j] = __builtin_nontemporal_load(xr + i * (DM / 4) + 64 * j); }
    for (int g = g0; g < ng; g += gstep) {
        const int gn = g + gstep < ng ? g + gstep : g;
        { const GAS f32x4* xr = (const GAS f32x4*)(src + (size_t)gn * NR * DM) + lane;
#pragma unroll
          for (int i = 0; i < NR; ++i)
#pragma unroll
              for (int j = 0; j < 4; ++j) w[i][j] = __builtin_nontemporal_load(xr + i * (DM / 4) + 64 * j); }
#pragma unroll
        for (int i = 0; i < NR; ++i) { float s = 0.f;
#pragma unroll
            for (int j = 0; j < 4; ++j) s += (v[i][j].x * v[i][j].x + v[i][j].y * v[i][j].y) + (v[i][j].z * v[i][j].z + v[i][j].w * v[i][j].w);
            const float rstd = 1.0f / sqrtf(wave_sum(s) * (1.f / DM) + RMS_EPS);
            if (rstd_out && lane == 0) rstd_out[(size_t)g * NR + i] = rstd;
            GAS unsigned long long* o8 = (GAS unsigned long long*)(dst + ((size_t)g * NR + i) * DM) + lane;
#pragma unroll
            for (int j = 0; j < 4; ++j) o8[64 * j] = (unsigned long long)pk2(v[i][j].x * rstd, v[i][j].y * rstd) | ((unsigned long long)pk2(v[i][j].z * rstd, v[i][j].w * rstd) << 32); }
#pragma unroll
        for (int i = 0; i < NR; ++i)
#pragma unroll
            for (int j = 0; j < 4; ++j) v[i][j] = w[i][j];
    }
}
__device__ __forceinline__ void h2_row(const Frame& F, int t, int L, float* h2) {
    const int j = F.lane;
    const int bi = j & 15;
    const float band = 1e-4f + (float)bi * ((15.0f - 1e-4f) / 15.0f);
    const float xarg = 2.0f * ((float)t * band) / (float)L;
    float sn, cs; sincospif(xarg, &sn, &cs);
    const float tt = (float)t / (float)(L - 1);
    float a = tt * F.fw1[j] + F.fb1[j];
#pragma unroll
    for (int i = 0; i < 16; ++i) { const float c = __shfl(cs, i), s = -__shfl(sn, i); a += c * F.fw1[(1 + i) * 64 + j] + s * F.fw1[(17 + i) * 64 + j]; }
    const float fr = F.ffreq[j];
    const float h1 = sinf(fr * a);
    float b = F.fb2[j];
#pragma unroll 8
    for (int i = 0; i < 64; ++i) b += __shfl(h1, i) * F.fw2[i * 64 + j];
    h2[(size_t)t * 64 + j] = sinf(fr * b);
}
__device__ __forceinline__ int t5_bucket_dev(int rel) {
    const int n = rel < 0 ? -rel : rel;
    int b = n < 8 ? n : n < 15 ? 8 : n < 27 ? 9 : n < 50 ? 10 : n < 91 ? 11 : n < 166 ? 12 : n < 305 ? 13 : n < 559 ? 14 : 15;
    return b + (rel > 0 ? 16 : 0);
}
__device__ __forceinline__ void p0_prologue(Frame& F) {
    LAS float* scr = (LAS float*)(F.lds + RING_OFF + F.wave * 16384);
    const int gw = F.vcu * NWAVES + F.wave, NGW = F.G * NWAVES;
    constexpr int I_IN = (DM / 64) * (DIN / 32), I_OUT = (DM / 64) * (DM / 32), I_MKV = (DM / 64) * (DMKV / 32);
    constexpr int NITEMS = I_IN + I_OUT + I_MKV;
    for (int it = gw; it < NITEMS; it += NGW) {
        int r = it;
        if (r < I_IN) { p0_transpose_item<true, true>(F.w_in, F.norm_in, DM, DIN, F.WTin, scr, r, F.lane); continue; } r -= I_IN;
        if (r < I_OUT) { p0_transpose_item<false, false>(F.w_out, nullptr, DM, DM, F.WTout, scr, r, F.lane); continue; } r -= I_OUT;
        p0_transpose_item<true, true>(F.w_mkv, F.mem_norm, DM, DMKV, F.WTmkv, scr, r, F.lane);
    }
    rms_rows_pipe<4>(F.lane, F.xp, F.XB, F.RSTD, gw, NGW, MP / 4);
    rms_rows_pipe<4>(F.lane, F.xs, F.XB + (size_t)MP * DM, F.RSTD + MP, gw, NGW, MS / 4);
    rms_rows_pipe<2>(F.lane, F.memp, F.MEMB, nullptr, gw, NGW, MMEM / 4);
    rms_rows_pipe<2>(F.lane, F.mems, F.MEMB + (size_t)(MMEM / 2) * DM, nullptr, gw, NGW, MMEM / 4);
    for (int t = gw; t < LP + LS; t += NGW) { if (t < LP) h2_row(F, t, LP, F.H2P); else h2_row(F, t - LP, LS, F.H2S); }
    if (gw == 1) { F.GAINS[F.lane] = F.gq[F.lane]; F.GAINS[64 + F.lane] = F.gk[F.lane]; F.GAINS[128 + F.lane] = F.gmq[F.lane]; F.GAINS[192 + F.lane] = F.gmk[F.lane]; }
    if (gw == 2) { float a = fabsf(F.gq[F.lane]), b = fabsf(F.gk[F.lane]), c = fabsf(F.gmq[F.lane]), d = fabsf(F.gmk[F.lane]);
        float e = fmaxf(fmaxf(fabsf(F.rel_bias[F.lane]), fabsf(F.rel_bias[64 + F.lane])), fabsf(F.rel_bias[128 + F.lane]));
#pragma unroll
        for (int o = 1; o < 64; o <<= 1) { a = fmaxf(a, __shfl_xor(a, o)); b = fmaxf(b, __shfl_xor(b, o)); c = fmaxf(c, __shfl_xor(c, o)); d = fmaxf(d, __shfl_xor(d, o)); e = fmaxf(e, __shfl_xor(e, o)); }
        if (F.lane == 0) { F.CONSTS[0] = (8.0f * a * b * 1.01f + e) * 1.4426950408889634f; F.CONSTS[1] = (8.0f * c * d * 1.01f) * 1.4426950408889634f; } }
    if (gw == 0) { for (int e = F.lane; e < 3 * NH * 129; e += 64) { const int c = e / (NH * 129), h = (e / 129) % NH, jj = e % 129; const int d = c == 0 ? 1 : c == 1 ? 4 : 16;
            F.BIAS[e] = F.rel_bias[t5_bucket_dev((jj - 64) * d) * NH + h]; } }
}

__device__ __forceinline__ int XI(int i) { return i + ((i >> 5) << 1); }
constexpr int NTW = 8192, NTWE = 512;
__device__ __forceinline__ cf2 root16(int k) {
    static constexpr float c[8] = {1.0f, 0.92387953251128674f, 0.70710678118654752f, 0.38268343236508977f, 0.0f, -0.38268343236508977f, -0.70710678118654752f, -0.92387953251128674f};
    static constexpr float s[8] = {0.0f, 0.38268343236508977f, 0.70710678118654752f, 0.92387953251128674f, 1.0f, 0.92387953251128674f, 0.70710678118654752f, 0.38268343236508977f};
    return (cf2){c[k], -s[k]};
}
__device__ __forceinline__ void root16_ri(int k, float& c, float& s) {
    const float cc[8] = {1.0f, 0.92387953251128674f, 0.70710678118654752f, 0.38268343236508977f, 0.0f, -0.38268343236508977f, -0.70710678118654752f, -0.92387953251128674f};
    const float ss[8] = {0.0f, 0.38268343236508977f, 0.70710678118654752f, 0.92387953251128674f, 1.0f, 0.92387953251128674f, 0.70710678118654752f, 0.38268343236508977f};
    c = cc[k]; s = -ss[k];
}
__device__ __forceinline__ cf2 c_add(cf2 a, cf2 b) { cf2 r; asm("v_pk_add_f32 %0, %1, %2" : "=v"(r) : "v"(a), "v"(b)); return r; }
__device__ __forceinline__ cf2 c_sub(cf2 a, cf2 b) { cf2 r; asm("v_pk_add_f32 %0, %1, %2 neg_lo:[0,1] neg_hi:[0,1]" : "=v"(r) : "v"(a), "v"(b)); return r; }
__device__ __forceinline__ cf2 c_sub_mi(cf2 a, cf2 b) { cf2 r; asm("v_pk_add_f32 %0, %1, %2 op_sel:[1,1] op_sel_hi:[0,0] neg_lo:[0,1] neg_hi:[1,0]" : "=v"(r) : "v"(a), "v"(b)); return r; }
__device__ __forceinline__ cf2 c_add_pi(cf2 a, cf2 b) { cf2 r; asm("v_pk_add_f32 %0, %1, %2 op_sel:[0,1] op_sel_hi:[1,0] neg_lo:[0,1]" : "=v"(r) : "v"(a), "v"(b)); return r; }
__device__ __forceinline__ cf2 c_sub_pi(cf2 a, cf2 b) { cf2 r; asm("v_pk_add_f32 %0, %1, %2 op_sel:[0,1] op_sel_hi:[1,0] neg_hi:[0,1]" : "=v"(r) : "v"(a), "v"(b)); return r; }
__device__ __forceinline__ cf2 c_mul(cf2 d, cf2 w) { cf2 r;
    asm("v_pk_mul_f32 %0, %1, %2 op_sel_hi:[0,1]\n\tv_pk_fma_f32 %0, %1, %2, %0 op_sel:[1,1,0] op_sel_hi:[1,0,1] neg_lo:[1,0,0]" : "=&v"(r) : "v"(d), "v"(w)); return r; }
__device__ __forceinline__ cf2 c_mulc(cf2 x, cf2 w) { cf2 r;
    asm("v_pk_mul_f32 %0, %1, %2 op_sel_hi:[0,1]\n\tv_pk_fma_f32 %0, %1, %2, %0 op_sel:[1,1,0] op_sel_hi:[1,0,1] neg_hi:[0,0,1]" : "=&v"(r) : "v"(x), "v"(w)); return r; }
template <int S, bool INV, bool T1ONE>
__device__ __forceinline__ void bfly(cf2 (&v)[1 << S], cf2 t1) {
    constexpr int R = 1 << S;
    cf2 tp[S]; tp[0] = t1;
    if (!T1ONE) {
#pragma unroll
        for (int s = 1; s < S; ++s) tp[s] = c_mul(tp[s - 1], tp[s - 1]); }
#pragma unroll
    for (int ss = 0; ss < S; ++ss) { const int s = INV ? S - 1 - ss : ss; const int half = R >> (s + 1);
        cf2 w[R / 2];
#pragma unroll
        for (int q = 0; q < half; ++q) { const int k16 = q * (8 / half);
            if (k16 == 0) w[q] = T1ONE ? (cf2){1.f, 0.f} : tp[s];
            else if (k16 == 4) w[q] = T1ONE ? (cf2){0.f, -1.f} : (cf2){tp[s].y, -tp[s].x};
            else w[q] = T1ONE ? root16(k16) : c_mul(tp[s], root16(k16)); }
#pragma unroll
        for (int r = 0; r < R; ++r) if ((r % (2 * half)) < half) { const int q = r % half, k16 = q * (8 / half);
            const cf2 u = v[r], x = v[r + half];
            if (!INV) {
                v[r] = c_add(u, x);
                if (T1ONE && k16 == 0) v[r + half] = c_sub(u, x);
                else if (T1ONE && k16 == 4) v[r + half] = c_sub_mi(u, x);
                else v[r + half] = c_mul(c_sub(u, x), w[q]);
            } else {
                if (T1ONE && k16 == 0) { v[r] = c_add(u, x); v[r + half] = c_sub(u, x); }
                else if (T1ONE && k16 == 4) { v[r] = c_add_pi(u, x); v[r + half] = c_sub_pi(u, x); }
                else { const cf2 y = c_mulc(x, w[q]); v[r] = c_add(u, y); v[r + half] = c_sub(u, y); }
            } } }
}
template <int S, int LSTR, bool INV, bool NOV = false>
__device__ __forceinline__ void fft_pass(LAS cf2* x, const LAS cf2* tw, int N, int tl, int NT) {
    constexpr int R = 1 << S, stride = 1 << LSTR;
    for (int g = tl; g < (N >> S); g += NT) {
        const int j0 = g & (stride - 1), base = ((g >> LSTR) << (LSTR + S)) + j0;
        cf2 v[R];
#pragma unroll
        for (int r = 0; r < R; ++r) v[r] = x[XI(base + r * stride)];
        if (!NOV) { if (LSTR == 0) bfly<S, INV, true>(v, (cf2){1.f, 0.f});
        else bfly<S, INV, false>(v, tw[j0 << (13 - S - LSTR)]); }
#pragma unroll
        for (int r = 0; r < R; ++r) x[XI(base + r * stride)] = v[r];
    }
}
#define WAVE_LDS_FENCE() asm volatile("s_waitcnt lgkmcnt(0)" ::: "memory")
template <int S, bool NOV = false>
__device__ __forceinline__ void fft_mid(LAS cf2* x, const cf2 (&kreg)[16], int N, int tl, int NT) {
    constexpr int R = 1 << S;
#pragma unroll
    for (int i = 0; i < 16 / R; ++i) { const int g = tl * (16 / R) + i;
        cf2 v[R];
#pragma unroll
        for (int r = 0; r < R; ++r) v[r] = x[XI(g * R) + r];
        if (!NOV) bfly<S, false, true>(v, (cf2){1.f, 0.f});
#pragma unroll
        for (int r = 0; r < R; ++r) v[r] = c_mul(v[r], kreg[i * R + r]);
        if (!NOV) bfly<S, true, true>(v, (cf2){1.f, 0.f});
#pragma unroll
        for (int r = 0; r < R; ++r) x[XI(g * R) + r] = v[r];
    }
}
template <int LOGN, bool NOV = false>
__device__ __forceinline__ void fft_conv(cf2 (&v)[16], LAS cf2* x, const LAS cf2* tw, const cf2* Kg, int tl) {
    constexpr int N = 1 << LOGN, NT = N >> 4;
    const cf2 t1 = tw[tl << (13 - LOGN)];
    if (!NOV) bfly<4, false, false>(v, t1);
    __syncthreads();
#pragma unroll
    for (int r = 0; r < 16; ++r) x[XI(tl + r * NT)] = v[r];
    cf2 kreg[16];
#pragma unroll
    for (int i = 0; i < 16; ++i) kreg[i] = Kg[tl * 16 + i];
    __syncthreads();
    fft_pass<4, LOGN - 8, false, NOV>(x, tw, N, tl, NT);
    WAVE_LDS_FENCE();
    if (LOGN == 13) { fft_pass<4, 1, false, NOV>(x, tw, N, tl, NT); WAVE_LDS_FENCE(); fft_mid<1, NOV>(x, kreg, N, tl, NT); WAVE_LDS_FENCE(); fft_pass<4, 1, true, NOV>(x, tw, N, tl, NT); }
    else { fft_mid<3, NOV>(x, kreg, N, tl, NT); }
    WAVE_LDS_FENCE();
    fft_pass<4, LOGN - 8, true, NOV>(x, tw, N, tl, NT);
    __syncthreads();
#pragma unroll
    for (int r = 0; r < 16; ++r) v[r] = x[XI(tl + r * NT)];
    if (!NOV) bfly<4, true, false>(v, t1);
}
template <int LOGN>
__device__ __forceinline__ void fft_fwd_store(cf2 (&v)[16], LAS cf2* x, const LAS cf2* tw, cf2* Kout, int tl) {
    constexpr int N = 1 << LOGN, NT = N >> 4;
    const cf2 t1 = tw[tl << (13 - LOGN)];
    bfly<4, false, false>(v, t1);
    __syncthreads();
#pragma unroll
    for (int r = 0; r < 16; ++r) x[XI(tl + r * NT)] = v[r];
    __syncthreads();
    fft_pass<4, LOGN - 8, false>(x, tw, N, tl, NT);
    if (LOGN == 13) { WAVE_LDS_FENCE(); fft_pass<4, 1, false>(x, tw, N, tl, NT); __syncthreads(); fft_pass<1, 0, false>(x, tw, N, tl, NT); }
    else { __syncthreads(); fft_pass<3, 0, false>(x, tw, N, tl, NT); }
    __syncthreads();
    for (int i = tl; i < N; i += NT) Kout[i] = x[XI(i)];
}
constexpr int FFT_XG = 8192 + 512;
constexpr int FFT_X = 0, FFT_TW = FFT_XG * 8, FFT_SCR = FFT_TW + NTWE * 8, FFT_SPK = FFT_SCR + 32768, FFT_AUX = FFT_SPK + 32768;
static_assert(FFT_AUX + 4096 <= LDSCTL_OFF, "FFT LDS map");
__device__ __forceinline__ void fft_init_tw(Frame& F) {
    LAS cf2* tw = (LAS cf2*)(F.lds + FFT_TW);
    for (int k = F.tid; k < NTWE; k += NWAVES * 64) { float s, c; sincospif((float)k * (2.0f / NTW), &s, &c); tw[k] = (cf2){c, -s}; }
    __syncthreads();
}
__device__ __forceinline__ cf2 root32(int r) {
    static constexpr float c[16] = {1.0f, 0.98078528040323043f, 0.92387953251128674f, 0.83146961230254524f, 0.70710678118654752f, 0.55557023301960218f, 0.38268343236508977f, 0.19509032201612825f,
                         0.0f, -0.19509032201612825f, -0.38268343236508977f, -0.55557023301960218f, -0.70710678118654752f, -0.83146961230254524f, -0.92387953251128674f, -0.98078528040323043f};
    static constexpr float s[16] = {0.0f, 0.19509032201612825f, 0.38268343236508977f, 0.55557023301960218f, 0.70710678118654752f, 0.83146961230254524f, 0.92387953251128674f, 0.98078528040323043f,
                         1.0f, 0.98078528040323043f, 0.92387953251128674f, 0.83146961230254524f, 0.70710678118654752f, 0.55557023301960218f, 0.38268343236508977f, 0.19509032201612825f};
    return (cf2){c[r], -s[r]};
}

__device__ __forceinline__ void split_bf16x8(const f32x4 x0, const f32x4 x1, bf16x8& hi, bf16x8& lo) {
    const float x[8] = {x0.x, x0.y, x0.z, x0.w, x1.x, x1.y, x1.z, x1.w};
    unsigned h[4], l[4];
#pragma unroll
    for (int i = 0; i < 4; ++i) { h[i] = pk2(x[2 * i], x[2 * i + 1]); l[i] = pk2(x[2 * i] - bflo(h[i]), x[2 * i + 1] - bfhi(h[i])); }
    hi = __builtin_bit_cast(bf16x8, (v4u){h[0], h[1], h[2], h[3]}); lo = __builtin_bit_cast(bf16x8, (v4u){l[0], l[1], l[2], l[3]});
}
__device__ __forceinline__ void filterA_phase(Frame& F) {
    constexpr int WP = 72;
    LAS bf16* wh = (LAS bf16*)(F.lds); LAS bf16* wl = wh + 64 * WP;
    const int NI = 80 * 12;
    for (int it = F.vcu; it < NI; it += F.G) {
        int tid = F.tid; asm volatile("" : "+v"(tid));
        const int lane = tid & 63, w = F.wave, n16 = lane & 15, g4 = lane >> 4;
        const int tt_ = it / 12, cc = it % 12; const bool prm = tt_ < 64; const int N = prm ? LP : LS, t0 = (prm ? tt_ : tt_ - 64) * 128 + 16 * w;
        const float* H2 = prm ? F.H2P : F.H2S; float* FB = prm ? F.FBP : F.FBS;
        const float* hr = H2 + (size_t)(t0 + n16) * 64 + 8 * g4;
        const f32x4 x00 = *(const f32x4*)(hr), x01 = *(const f32x4*)(hr + 4), x10 = *(const f32x4*)(hr + 32), x11 = *(const f32x4*)(hr + 36);
        float wv[8];
#pragma unroll
        for (int i = 0; i < 8; ++i) { const int e = tid + 512 * i; wv[i] = F.fw3[(size_t)(e >> 6) * 768 + cc * 64 + (e & 63)]; }
        __syncthreads();
#pragma unroll
        for (int i = 0; i < 8; ++i) { const int e = tid + 512 * i, k = e >> 6, c = e & 63; const unsigned h = f2bf(wv[i]); wh[c * WP + k] = (bf16)h; wl[c * WP + k] = (bf16)f2bf(wv[i] - __builtin_bit_cast(float, h << 16)); }
        __syncthreads();
        bf16x8 ah[2], al[2];
        split_bf16x8(x00, x01, ah[0], al[0]); split_bf16x8(x10, x11, ah[1], al[1]);
        const float tb = (float)(t0 + 4 * g4), rn = 1.0f / (float)(N - 1);
#pragma unroll
        for (int nt = 0; nt < 4; ++nt) {
            f32x4 acc = {0.f, 0.f, 0.f, 0.f};
#pragma unroll
            for (int s2 = 0; s2 < 2; ++s2) {
                const bf16x8 bh = *(const LAS bf16x8*)(wh + (nt * 16 + n16) * WP + 32 * s2 + 8 * g4), bl = *(const LAS bf16x8*)(wl + (nt * 16 + n16) * WP + 32 * s2 + 8 * g4);
                acc = __builtin_amdgcn_mfma_f32_16x16x32_bf16(ah[s2], bh, acc, 0, 0, 0);
                acc = __builtin_amdgcn_mfma_f32_16x16x32_bf16(ah[s2], bl, acc, 0, 0, 0);
                acc = __builtin_amdgcn_mfma_f32_16x16x32_bf16(al[s2], bh, acc, 0, 0, 0); }
            const int col = cc * 64 + nt * 16 + n16, c = col >= DHY ? col - DHY : col;
            const float delta = 3.0701134573253944f + (float)c * ((15.350567286626972f - 3.0701134573253944f) / 383.0f);
            f32x4 o;
#pragma unroll
            for (int j = 0; j < 4; ++j) { const float tt = (tb + (float)j) * rn; o[j] = acc[j] * expf(-tt * delta); }
            *(f32x4*)(FB + (size_t)col * N + t0 + 4 * g4) = o; }
    }
    __syncthreads();
}
template <int LOGN>
__device__ __forceinline__ void filter_item(Frame& F, int c, int gi, int tl, const float* FB, cf2* Kout) {
    constexpr int N = 1 << LOGN, NT = N >> 4;
    LAS cf2* x = (LAS cf2*)(F.lds + FFT_X) + gi * (N + N / 16);
    const LAS cf2* tw = (const LAS cf2*)(F.lds + FFT_TW);
    LAS float* red = (LAS float*)(F.lds + FFT_AUX + 2048) + gi * 16;
    const float* fwd = FB + (size_t)c * N; const float* bwd = FB + (size_t)(DHY + c) * N;
    float ka[16], kb[16]; float ss = 0.f;
#pragma unroll
    for (int r = 0; r < 16; ++r) { const int t = tl + r * NT; const float f = fwd[t], b = bwd[(N - t) & (N - 1)];
        ka[r] = (t == 0) ? f + b : f; kb[r] = (t == 0) ? 0.f : b; ss += ka[r] * ka[r] + kb[r] * kb[r]; }
    ss = wave_sum(ss);
    __syncthreads();
    if ((tl & 63) == 0) red[tl >> 6] = ss;
    __syncthreads();
    float tot = 0.f;
    for (int w = 0; w < NT / 64; ++w) tot += red[w];
    const float sc = (1.0f / sqrtf(tot + 1e-12f)) * (0.5f / (float)N);
    float sn, cs; sincospif((float)tl / (float)N, &sn, &cs); const cf2 wt = (cf2){cs, -sn};
    cf2 v[16];
#pragma unroll
    for (int r = 0; r < 16; ++r) v[r] = (cf2){(ka[r] + kb[r]) * sc, 0.f};
    fft_fwd_store<LOGN>(v, x, tw, Kout, tl);
#pragma unroll
    for (int r = 0; r < 16; ++r) v[r] = cmul(wt, root32(r)) * ((ka[r] - kb[r]) * sc);
    fft_fwd_store<LOGN>(v, x, tw, Kout + N, tl);
}
__device__ __forceinline__ void filter_phase(Frame& F) {
    fft_init_tw(F);
    const int NI = DHY + DHY / 4;
    for (int it = F.vcu; it < NI; it += F.G) {
        int tid = F.tid; asm volatile("" : "+v"(tid));
        if (it < DHY) filter_item<13>(F, it, 0, tid, F.FBP, F.KSP + (size_t)it * 2 * LP);
        else { const int gi = tid >> 7, c = (it - DHY) * 4 + gi; filter_item<11>(F, c, gi, tid & 127, F.FBS, F.KSS + (size_t)c * 2 * LS); }
    }
    __syncthreads();
}

__device__ __forceinline__ void conv3_16(const LAS bf16* row, int t0, int N, float w0, float w1, float w2, float b, float (&u)[16]) {
    const v4u a = *(const LAS v4u*)(row + t0), c = *(const LAS v4u*)(row + t0 + 8);
    float e[18];
    e[0] = bf2f(row[t0 > 0 ? t0 - 1 : 0]); e[17] = bf2f(row[t0 + 16 < N ? t0 + 16 : t0]);
    e[0] = t0 > 0 ? e[0] : 0.f; e[17] = t0 + 16 < N ? e[17] : 0.f;
    e[1] = bflo(a.x); e[2] = bfhi(a.x); e[3] = bflo(a.y); e[4] = bfhi(a.y); e[5] = bflo(a.z); e[6] = bfhi(a.z); e[7] = bflo(a.w); e[8] = bfhi(a.w);
    e[9] = bflo(c.x); e[10] = bfhi(c.x); e[11] = bflo(c.y); e[12] = bfhi(c.y); e[13] = bflo(c.z); e[14] = bfhi(c.z); e[15] = bflo(c.w); e[16] = bfhi(c.w);
#pragma unroll
    for (int k = 0; k < 16; ++k) u[k] = w0 * e[k] + w1 * e[k + 1] + w2 * e[k + 2] + b;
}
template <int LOGN, int MODE>
__device__ __forceinline__ void hyena_item(Frame& F, int c, int bb1, int bb2, int gi, int tl, const cf2* Kc) {
    constexpr int N = 1 << LOGN, NT = N >> 4;
    LAS cf2* x = (LAS cf2*)(F.lds + FFT_X) + gi * (N + N / 16);
    const LAS cf2* tw = (const LAS cf2*)(F.lds + FFT_TW);
    LAS bf16* R = (LAS bf16*)(F.lds + FFT_SCR) + gi * (4 * N);
    LAS unsigned* ysc = (LAS unsigned*)(F.lds + FFT_SCR) + gi * N + tl;
    LAS unsigned* spk = (LAS unsigned*)(F.lds + FFT_SPK) + gi * N + tl;
    const bf16* z1 = F.ZHY + (size_t)bb_rowbase(bb1) * 1152 + (size_t)c * N;
    const bf16* z2 = F.ZHY + (size_t)bb_rowbase(bb2) * 1152 + (size_t)c * N;
    const float* cw = F.conv_w; const float* cb = F.conv_b;
    float sn, cs; sincospif((float)tl / (float)N, &sn, &cs); const cf2 wt = (cf2){cs, -sn};
    const int t0 = 16 * tl;
    cf2 v[16];
    if (MODE & 1) {
    { v4u stg[8];
#pragma unroll
      for (int i = 0; i < 8; ++i) { const int id = tl + i * NT, row = id / (N / 8), ch = id % (N / 8);
          stg[i] = *(const GAS v4u*)(((row & 2) ? z2 : z1) + (size_t)((row & 1) ? 2 * DHY : DHY) * N + ch * 8); }
      __syncthreads();
#pragma unroll
      for (int i = 0; i < 8; ++i) { const int id = tl + i * NT, row = id / (N / 8), ch = id % (N / 8); *(LAS v4u*)(R + row * N + ch * 8) = stg[i]; } }
    __syncthreads();
    { const float a0 = cw[DHY + c], a1 = cw[1152 + DHY + c], a2 = cw[2304 + DHY + c], ab = cb[DHY + c];
      const float v0 = cw[2 * DHY + c], v1 = cw[1152 + 2 * DHY + c], v2 = cw[2304 + 2 * DHY + c], vb = cb[2 * DHY + c];
      float ua[16], ub[16]; LAS f32x4* xw = (LAS f32x4*)(x + XI(t0));
      conv3_16(R, t0, N, a0, a1, a2, ab, ua); conv3_16(R + N, t0, N, v0, v1, v2, vb, ub);
#pragma unroll
      for (int k = 0; k < 16; ++k) ua[k] *= ub[k];
      float uc[16];
      conv3_16(R + 2 * N, t0, N, a0, a1, a2, ab, uc); conv3_16(R + 3 * N, t0, N, v0, v1, v2, vb, ub);
#pragma unroll
      for (int k = 0; k < 16; ++k) uc[k] *= ub[k];
#pragma unroll
      for (int k = 0; k < 8; ++k) xw[k] = (f32x4){ua[2 * k], uc[2 * k], ua[2 * k + 1], uc[2 * k + 1]}; }
    __syncthreads();
#pragma unroll
    for (int r = 0; r < 16; ++r) { v[r] = x[XI(tl + r * NT)]; spk[r * NT] = pk2(v[r].x, v[r].y); }
    } else {
#pragma unroll
    for (int r = 0; r < 16; ++r) v[r] = (cf2){(float)(tl + r), 1.0f};
    }
    if (MODE & 2) {
    fft_conv<LOGN, (MODE & 8) != 0>(v, x, tw, Kc, tl);
#pragma unroll
    for (int r = 0; r < 16; ++r) ysc[r * NT] = pk2(v[r].x, v[r].y);
#pragma unroll
    for (int r = 0; r < 16; ++r) { const unsigned sw = spk[r * NT]; v[r] = c_mul((cf2){bflo(sw), bfhi(sw)}, c_mul(wt, root32(r))); }
    fft_conv<LOGN, (MODE & 8) != 0>(v, x, tw, Kc + N, tl);
    }
    if (MODE & 4) {
    cf2 wt2 = wt; asm volatile("" : "+v"(wt2));
    const float sk = F.skip[c];
    v4u stg0[4];
#pragma unroll
    for (int i = 0; i < 4; ++i) { const int id = tl + i * NT, row = id / (N / 8), ch = id % (N / 8); stg0[i] = *(const GAS v4u*)((row ? z2 : z1) + ch * 8); }
#pragma unroll
    for (int r = 0; r < 16; ++r) { const unsigned yw = ysc[r * NT], sw = spk[r * NT]; const cf2 z = (cf2){bflo(yw), bfhi(yw)} + c_mulc(v[r], c_mul(wt2, root32(r))); v[r] = (cf2){z.x + bflo(sw) * sk, z.y + bfhi(sw) * sk}; }
    __syncthreads();
#pragma unroll
    for (int r = 0; r < 16; ++r) x[XI(tl + r * NT)] = v[r];
#pragma unroll
    for (int i = 0; i < 4; ++i) { const int id = tl + i * NT, row = id / (N / 8), ch = id % (N / 8); *(LAS v4u*)(R + row * N + ch * 8) = stg0[i]; }
    __syncthreads();
    { const float x0w0 = cw[c], x0w1 = cw[1152 + c], x0w2 = cw[2304 + c], x0b = cb[c];
      float ua[16], uc[16]; const LAS f32x4* xr = (const LAS f32x4*)(x + XI(t0));
      conv3_16(R, t0, N, x0w0, x0w1, x0w2, x0b, ua); conv3_16(R + N, t0, N, x0w0, x0w1, x0w2, x0b, uc);
      v4u q1[2], q2[2];
#pragma unroll
      for (int k = 0; k < 8; ++k) { const f32x4 zz = xr[k]; const unsigned w1 = pk2(ua[2 * k] * zz.x, ua[2 * k + 1] * zz.z), w2 = pk2(uc[2 * k] * zz.y, uc[2 * k + 1] * zz.w);
          q1[k >> 2][k & 3] = w1; q2[k >> 2][k & 3] = w2; }
      GAS v4u* o1 = (GAS v4u*)(F.ZHY + (size_t)bb_rowbase(bb1) * 1152 + (size_t)c * N + t0);
      GAS v4u* o2 = (GAS v4u*)(F.ZHY + (size_t)bb_rowbase(bb2) * 1152 + (size_t)c * N + t0);
      if (MODE == 7) { o1[0] = q1[0]; o1[1] = q1[1]; o2[0] = q2[0]; o2[1] = q2[1]; } else asm volatile("" :: "v"(q1[0]), "v"(q1[1]), "v"(q2[0]), "v"(q2[1])); }
    } else {
#pragma unroll
    for (int r = 0; r < 16; ++r) asm volatile("" :: "v"(v[r].x), "v"(v[r].y));
    }
}
template <int MODE>
__device__ __forceinline__ void hyena_phase(Frame& F) {
    fft_init_tw(F);
    const int NI = DHY * 4 + DHY;
    for (int it = F.vcu; it < NI; it += F.G) {
        int tid = F.tid; asm volatile("" : "+v"(tid));
        if (it < DHY * 4) { const int c = it >> 2, bp = it & 3; hyena_item<13, MODE>(F, c, 2 * bp, 2 * bp + 1, 0, tid, F.KSP + (size_t)c * 2 * LP); }
        else { const int c = it - DHY * 4, gi = tid >> 7; hyena_item<11, MODE>(F, c, 8 + 2 * gi, 9 + 2 * gi, gi, tid & 127, F.KSS + (size_t)c * 2 * LS); }
    }
    __syncthreads();
}

constexpr int TP = 65;
__device__ __forceinline__ void combine_phase(Frame& F) {
    LAS float* Y = (LAS float*)(F.lds);
    const int NI = (MT / 128) * 6;
    for (int it = F.vcu; it < NI; it += F.G) {
        const int cg = it % 6, tile = it / 6; int bb, t0; row_to_bt(tile * 128, bb, t0); const int rb = bb_rowbase(bb), L = bb_len(bb);
        __syncthreads();
        const int tt = F.tid & 127, cq = F.tid >> 7;
        unsigned short cv[16]; v4u gv[2];
#pragma unroll
        for (int k = 0; k < 16; ++k) cv[k] = F.ZHY[(size_t)rb * 1152 + (size_t)(cg * 64 + cq * 16 + k) * L + t0 + tt];
#pragma unroll
        for (int j = 0; j < 2; ++j) { const int id = F.tid + j * NWAVES * 64; gv[j] = *(const GAS v4u*)(F.MIX + (size_t)(rb + t0 + (id >> 3)) * DM + cg * 64 + (id & 7) * 8); }
#pragma unroll
        for (int k = 0; k < 16; ++k) Y[tt * TP + cq * 16 + k] = bf2f(cv[k]);
        __syncthreads();
#pragma unroll
        for (int j = 0; j < 2; ++j) { const int id = F.tid + j * NWAVES * 64, i = id >> 3, ch8 = id & 7;
            GAS v4u* p = (GAS v4u*)(F.MIX + F.woff + (size_t)(rb + t0 + i) * DM + cg * 64 + ch8 * 8); const v4u g = gv[j]; const LAS float* y = Y + i * TP + ch8 * 8;
            v4u o; o.x = pk2(bflo(g.x) * y[0], bfhi(g.x) * y[1]); o.y = pk2(bflo(g.y) * y[2], bfhi(g.y) * y[3]); o.z = pk2(bflo(g.z) * y[4], bfhi(g.z) * y[5]); o.w = pk2(bflo(g.w) * y[6], bfhi(g.w) * y[7]);
            *p = o; }
    }
    __syncthreads();
}

typedef float f32x16 __attribute__((ext_vector_type(16)));
typedef short s16x4 __attribute__((ext_vector_type(4)));
constexpr int AT_K = 0;
constexpr int AT_V = 49152;
constexpr int AT_VH = 384 * 64 + 64;
constexpr int AT_B = AT_V + 2 * AT_VH;
constexpr int AT_L = AT_B + 20480;
constexpr int AT_O = AT_L + 1024;
static_assert(AT_O + 8192 <= LDSCTL_OFF && (AT_B % 16) == 0 && (AT_O % 16) == 0, "attention LDS map");
__device__ __forceinline__ int crow(int r, int hi) { return (r & 3) + 8 * (r >> 2) + 4 * hi; }
__device__ __forceinline__ s16x4 vtr(const LAS unsigned char* p) { typedef short v4i16_t __attribute__((ext_vector_type(4))); return __builtin_bit_cast(s16x4, __builtin_amdgcn_ds_read_tr16_b64_v4i16((LAS v4i16_t*)p)); }

template <int NK>
__device__ __forceinline__ void attn_stage_load(int tid, v4u (&kd)[NK / 64], v4u (&vd)[NK / 64], const bf16* Kg, const bf16* Vg, int idx0, int n, long tok0, int tstride) {
#pragma unroll
    for (int i = 0; i < NK / 64; ++i) { const int id = tid + i * NWAVES * 64, kk = id >> 3, c8 = id & 7; const int idx = idx0 + kk;
        const bool ok = idx >= 0 && idx < n; const size_t off = ok ? (size_t)(tok0 + (long)kk * tstride) * 64 + c8 * 8 : 0;
        kd[i] = *(const GAS v4u*)(Kg + off); vd[i] = *(const GAS v4u*)(Vg + off); }
}
template <int NK>
__device__ __forceinline__ void attn_stage_write(Frame& F, int tid, const v4u (&kd)[NK / 64], const v4u (&vd)[NK / 64], int idx0, int n) {
#pragma unroll
    for (int i = 0; i < NK / 64; ++i) { const int id = tid + i * NWAVES * 64, kk = id >> 3, c8 = id & 7; const int idx = idx0 + kk;
        const bool ok = idx >= 0 && idx < n; const v4u z = {0u, 0u, 0u, 0u};
        *(LAS v4u*)(F.lds + AT_K + kk * 128 + ((c8 ^ ((kk >> 1) & 7)) << 4)) = ok ? kd[i] : z;
        *(LAS v4u*)(F.lds + AT_V + (c8 >> 2) * AT_VH + kk * 64 + ((c8 & 3) << 4)) = ok ? vd[i] : z; }
}
__device__ __forceinline__ void attn_kread(const LAS unsigned char* lds, int T, int lane, bf16x8 (&kf)[4]) {
    const int ql = lane & 31, hi = lane >> 5; const LAS unsigned char* kp = lds + AT_K + (32 * T + ql) * 128; const int sw = (ql >> 1) & 7;
#pragma unroll
    for (int d0 = 0; d0 < 4; ++d0) kf[d0] = *(const LAS bf16x8*)(kp + (((2 * d0 + hi) ^ sw) << 4));
}
__device__ __forceinline__ void attn_vread(const LAS unsigned char* lds, int T, int lane, s16x4 (&vf)[8]) {
    const int hi = lane >> 5; const LAS unsigned char* vp = lds + AT_V + (32 * T + 4 * hi + ((lane & 15) >> 2)) * 64 + ((lane >> 4) & 1) * 32 + (lane & 3) * 8;
#pragma unroll
    for (int db = 0; db < 2; ++db)
#pragma unroll
        for (int q = 0; q < 4; ++q) vf[db * 4 + q] = vtr(vp + db * AT_VH + q * 512);
}
__device__ __forceinline__ void attn_tile(const LAS unsigned char* lds, int T, int Tn, const LAS unsigned char* bnext, bf16x8 (&kf)[4], f32x16& p, const bf16x8 (&qr)[4], bool bnd, int idxbase, int n, float& lsum, f32x16& o0, f32x16& o1, int lane) {
    const int hi = lane >> 5;
    __builtin_amdgcn_sched_barrier(0);
    s16x4 vf[8];
    attn_vread(lds, T, lane, vf);
#pragma unroll
    for (int d0 = 0; d0 < 4; ++d0) p = __builtin_amdgcn_mfma_f32_32x32x16_bf16(kf[d0], qr[d0], p, 0, 0, 0);
    if (Tn >= 0) attn_kread(lds, Tn, lane, kf);
    if (bnd) {
#pragma unroll
        for (int r = 0; r < 16; ++r) { const int idx = idxbase + crow(r, hi); if (idx < 0 || idx >= n) p[r] = -1e30f; } }
    float s = 0.f;
#pragma unroll
    for (int r = 0; r < 16; ++r) { p[r] = __builtin_amdgcn_exp2f(p[r]); s += p[r]; }
    lsum += s;
    u32x4 w0, w1;
    w0.x = pg8::cvt_pk_bf16(p[0], p[1]); w0.y = pg8::cvt_pk_bf16(p[2], p[3]); w0.z = pg8::cvt_pk_bf16(p[4], p[5]); w0.w = pg8::cvt_pk_bf16(p[6], p[7]);
    w1.x = pg8::cvt_pk_bf16(p[8], p[9]); w1.y = pg8::cvt_pk_bf16(p[10], p[11]); w1.z = pg8::cvt_pk_bf16(p[12], p[13]); w1.w = pg8::cvt_pk_bf16(p[14], p[15]);
    if (bnext) {
#pragma unroll
        for (int r4 = 0; r4 < 4; ++r4) { const f32x4 b = *(const LAS f32x4*)(bnext + (r4 * 64 + lane) * 16); p[4 * r4] = b.x; p[4 * r4 + 1] = b.y; p[4 * r4 + 2] = b.z; p[4 * r4 + 3] = b.w; } }
    const bf16x8 pa0 = __builtin_bit_cast(bf16x8, w0), pa1 = __builtin_bit_cast(bf16x8, w1);
    const bf16x8 v00 = (bf16x8){vf[0][0], vf[0][1], vf[0][2], vf[0][3], vf[1][0], vf[1][1], vf[1][2], vf[1][3]}, v01 = (bf16x8){vf[2][0], vf[2][1], vf[2][2], vf[2][3], vf[3][0], vf[3][1], vf[3][2], vf[3][3]};
    const bf16x8 v10 = (bf16x8){vf[4][0], vf[4][1], vf[4][2], vf[4][3], vf[5][0], vf[5][1], vf[5][2], vf[5][3]}, v11 = (bf16x8){vf[6][0], vf[6][1], vf[6][2], vf[6][3], vf[7][0], vf[7][1], vf[7][2], vf[7][3]};
    o0 = __builtin_amdgcn_mfma_f32_32x32x16_bf16(pa0, v00, o0, 0, 0, 0); o1 = __builtin_amdgcn_mfma_f32_32x32x16_bf16(pa0, v10, o1, 0, 0, 0);
    o0 = __builtin_amdgcn_mfma_f32_32x32x16_bf16(pa1, v01, o0, 0, 0, 0); o1 = __builtin_amdgcn_mfma_f32_32x32x16_bf16(pa1, v11, o1, 0, 0, 0);
}
template <int NTILES, bool BIAS>
__device__ __forceinline__ void attn_tiles(const LAS unsigned char* lds, int T0, const bf16x8 (&qr)[4], float cinit, bool bnd, int idxbase0, int n, float& lsum, f32x16& o0, f32x16& o1, int lane) {
    const int hi = lane >> 5;
    bf16x8 kf[4]; f32x16 p[2];
#define AT_PINIT(P, TAU) do { if (BIAS) { _Pragma("unroll") for (int r4 = 0; r4 < 4; ++r4) { const f32x4 b_ = *(const LAS f32x4*)(lds + AT_B + (TAU) * 4096 + (r4 * 64 + lane) * 16); \
        P[4 * r4] = b_.x; P[4 * r4 + 1] = b_.y; P[4 * r4 + 2] = b_.z; P[4 * r4 + 3] = b_.w; } } else { _Pragma("unroll") for (int r = 0; r < 16; ++r) P[r] = cinit; } } while (0)
    attn_kread(lds, T0, lane, kf);
    AT_PINIT(p[0], 0);
#pragma unroll
    for (int d0 = 0; d0 < 4; ++d0) p[0] = __builtin_amdgcn_mfma_f32_32x32x16_bf16(kf[d0], qr[d0], p[0], 0, 0, 0);
    if (NTILES > 1) { attn_kread(lds, T0 + 1, lane, kf); AT_PINIT(p[1], 1); }
#pragma unroll
    for (int tau = 0; tau < NTILES; ++tau) {
        f32x16& pc = p[tau & 1]; f32x16& pn = p[(tau + 1) & 1];
        __builtin_amdgcn_sched_barrier(0);
        s16x4 vf[8];
        attn_vread(lds, T0 + tau, lane, vf);
        if (tau + 1 < NTILES) {
#pragma unroll
            for (int d0 = 0; d0 < 4; ++d0) pn = __builtin_amdgcn_mfma_f32_32x32x16_bf16(kf[d0], qr[d0], pn, 0, 0, 0);
            if (tau + 2 < NTILES) attn_kread(lds, T0 + tau + 2, lane, kf);
        }
        __builtin_amdgcn_sched_barrier(0);
        if (bnd) { const int idxbase = idxbase0 + 32 * tau;
#pragma unroll
            for (int r = 0; r < 16; ++r) { const int idx = idxbase + crow(r, hi); if (idx < 0 || idx >= n) pc[r] = -1e30f; } }
        float s = 0.f;
#pragma unroll
        for (int r = 0; r < 16; ++r) { pc[r] = __builtin_amdgcn_exp2f(pc[r]); s += pc[r]; }
        lsum += s;
        u32x4 w0, w1;
        w0.x = pg8::cvt_pk_bf16(pc[0], pc[1]); w0.y = pg8::cvt_pk_bf16(pc[2], pc[3]); w0.z = pg8::cvt_pk_bf16(pc[4], pc[5]); w0.w = pg8::cvt_pk_bf16(pc[6], pc[7]);
        w1.x = pg8::cvt_pk_bf16(pc[8], pc[9]); w1.y = pg8::cvt_pk_bf16(pc[10], pc[11]); w1.z = pg8::cvt_pk_bf16(pc[12], pc[13]); w1.w = pg8::cvt_pk_bf16(pc[14], pc[15]);
        if (tau + 2 < NTILES) AT_PINIT(pc, tau + 2);
        const bf16x8 pa0 = __builtin_bit_cast(bf16x8, w0), pa1 = __builtin_bit_cast(bf16x8, w1);
        const bf16x8 v00 = (bf16x8){vf[0][0], vf[0][1], vf[0][2], vf[0][3], vf[1][0], vf[1][1], vf[1][2], vf[1][3]}, v01 = (bf16x8){vf[2][0], vf[2][1], vf[2][2], vf[2][3], vf[3][0], vf[3][1], vf[3][2], vf[3][3]};
        const bf16x8 v10 = (bf16x8){vf[4][0], vf[4][1], vf[4][2], vf[4][3], vf[5][0], vf[5][1], vf[5][2], vf[5][3]}, v11 = (bf16x8){vf[6][0], vf[6][1], vf[6][2], vf[6][3], vf[7][0], vf[7][1], vf[7][2], vf[7][3]};
        o0 = __builtin_amdgcn_mfma_f32_32x32x16_bf16(pa0, v00, o0, 0, 0, 0); o1 = __builtin_amdgcn_mfma_f32_32x32x16_bf16(pa0, v10, o1, 0, 0, 0);
        o0 = __builtin_amdgcn_mfma_f32_32x32x16_bf16(pa1, v01, o0, 0, 0, 0); o1 = __builtin_amdgcn_mfma_f32_32x32x16_bf16(pa1, v11, o1, 0, 0, 0);
    }
#undef AT_PINIT
}
struct DilUnit { int bb, h, c, rho, i0, n, d, rb, L; size_t hb; };
__device__ __forceinline__ DilUnit dil_decode(int it) {
    DilUnit u;
    if (it < 4608) { const int g = it >> 5, q = it & 31; u.bb = g / 18; u.h = (g / 3) % 6; u.c = g % 3; u.n = LP >> (2 * u.c); const int nb = u.n >> 8; u.rho = q / nb; u.i0 = (q % nb) << 8; }
    else { const int r = it - 4608, g = r >> 5, q = r & 31; u.bb = 8 + g / 6; u.h = g % 6;
        if (q < 8) { u.c = 0; u.n = LS; u.rho = 0; u.i0 = q << 8; } else if (q < 16) { u.c = 1; u.n = LS / 4; u.rho = (q - 8) >> 1; u.i0 = ((q - 8) & 1) << 8; } else { u.c = 2; u.n = LS / 16; u.rho = q - 16; u.i0 = 0; } }
    u.d = 1 << (2 * u.c); u.rb = bb_rowbase(u.bb); u.L = bb_len(u.bb); u.hb = ((size_t)u.rb * NH + (size_t)u.h * u.L) * 64;
    return u;
}
__device__ __forceinline__ void dil_prefetch(Frame& F, int tid, const DilUnit& u, v4u (&kd)[6], v4u (&vd)[6], bf16x8 (&qr)[4]) {
    attn_stage_load<384>(tid, kd, vd, F.K + u.hb, F.V + u.hb, u.i0 - 64, u.n, (long)u.rho + (long)u.d * (u.i0 - 64), u.d);
    const int ql = tid & 31, hi = (tid >> 5) & 1; const bool wact = u.i0 + 32 * F.wave < u.n;
    const bf16* qp = F.Q + u.hb + (size_t)(u.rho + u.d * (wact ? u.i0 + 32 * F.wave + ql : 0)) * 64 + 8 * hi;
#pragma unroll
    for (int d0 = 0; d0 < 4; ++d0) qr[d0] = *(const GAS bf16x8*)(qp + 16 * d0);
}
template <int MODE>
__device__ __forceinline__ void attn_dilated_phase(Frame& F) {
#ifndef DIL_WGS
#define DIL_WGS 0
#endif
    const int GA = DIL_WGS ? DIL_WGS : F.G;
    const int NU = 6144, ub = F.vcu < GA ? (int)(((long)F.vcu * NU) / GA) : 0, ue = F.vcu < GA ? (int)(((long)(F.vcu + 1) * NU) / GA) : 0;
    const int w = F.wave;
    const float cshift = F.CONSTS[0];
    int prev_ch = -1;
    v4u kd[6], vd[6]; bf16x8 qn[4];
    if (!(MODE & 1)) {
#pragma unroll
        for (int i = 0; i < 6; ++i) { kd[i] = (v4u){0u, 0u, 0u, 0u}; vd[i] = kd[i]; }
#pragma unroll
        for (int i = 0; i < 4; ++i) qn[i] = (bf16x8){0, 0, 0, 0, 0, 0, 0, 0}; }
    if ((MODE & 1) && ub < ue) { const DilUnit u0 = dil_decode(ub); dil_prefetch(F, F.tid, u0, kd, vd, qn); }
    for (int it = ub; it < ue; ++it) {
        int tid = F.tid; asm volatile("" : "+v"(tid));
        const int lane = tid & 63, ql = lane & 31, hi = lane >> 5;
        const DilUnit u = dil_decode(it);
        const int c = u.c, h = u.h, rho = u.rho, i0 = u.i0, n = u.n, d = u.d, rb = u.rb;
        __syncthreads();
        if (c * 8 + h != prev_ch) { prev_ch = c * 8 + h; const float* bias = F.BIAS + (c * NH + h) * 129;
            for (int e = tid; e < 5 * 16 * 64; e += NWAVES * 64) { const int tau = e >> 10, r = (e >> 6) & 15, ln = e & 63; const int rel = 32 * tau + crow(r, ln >> 5) - 64 - (ln & 31);
                const float v = (rel >= -64 && rel <= 64) ? bias[rel + 64] * 1.4426950408889634f - cshift : -1e30f;
                ((LAS float*)(F.lds + AT_B))[((tau * 4 + (r >> 2)) * 64 + ln) * 4 + (r & 3)] = v; } }
        if (MODE & 1) attn_stage_write<384>(F, tid, kd, vd, i0 - 64, n);
        bf16x8 qr[4];
#pragma unroll
        for (int d0 = 0; d0 < 4; ++d0) qr[d0] = qn[d0];
        __syncthreads();
        if ((MODE & 1) && it + 1 < ue) { const DilUnit un = dil_decode(it + 1); dil_prefetch(F, tid, un, kd, vd, qn); }
        const bool wact = i0 + 32 * w < n;
        const int qi = i0 + 32 * w + ql;
        if (wact) {
            f32x16 o0, o1;
#pragma unroll
            for (int r = 0; r < 16; ++r) { o0[r] = 0.f; o1[r] = 0.f; }
            float lsum = 0.f;
            const bool bnd = (i0 == 0) || (i0 + 256 + 64 > n);
            if (MODE & 2) attn_tiles<5, true>(F.lds, w, qr, 0.f, bnd, i0 - 64 + 32 * w, n, lsum, o0, o1, lane);
            lsum += __shfl_xor(lsum, 32);
            LAS bf16* ost = (LAS bf16*)(F.lds + AT_O) + w * 512;
            bf16* ocp = F.OC + ((size_t)c * MT + rb) * DHY + h * 64 + (lane & 7) * 8;
            if (!(MODE & 4)) { asm volatile("" :: "v"(o0), "v"(o1), "v"(lsum)); }
            if (MODE & 4)
#pragma unroll
            for (int g = 0; g < 4; ++g) {
#pragma unroll
                for (int j = 0; j < 4; ++j) { ost[(4 * hi + j) * 64 + ql] = (bf16)f2bf(o0[4 * g + j]); ost[(4 * hi + j) * 64 + 32 + ql] = (bf16)f2bf(o1[4 * g + j]); }
                asm volatile("s_waitcnt lgkmcnt(0)" ::: "memory");
                const v4u ov = *(const LAS v4u*)(ost + (lane >> 3) * 64 + (lane & 7) * 8);
                asm volatile("s_waitcnt lgkmcnt(0)" ::: "memory");
                const size_t tok = (size_t)(rho + d * (i0 + 32 * w + 8 * g + (lane >> 3)));
                if (MODE == 7) *(GAS v4u*)(ocp + tok * DHY) = ov; else asm volatile("" :: "v"(ov)); }
            if (MODE == 7 && hi == 0) F.LC[((size_t)c * MT + rb + rho + d * qi) * NH + h] = lsum;
        }
    }
    __syncthreads();
}
struct MemUnit { int bb, hm, rb, L, t0; };
__device__ __forceinline__ MemUnit mem_decode(int it, int w) {
    MemUnit u; int blk;
    if (it < 1024) { u.bb = it >> 7; u.hm = (it >> 5) & 3; blk = it & 31; } else { const int r = it - 1024; u.bb = 8 + (r >> 5); u.hm = (r >> 3) & 3; blk = r & 7; }
    u.rb = bb_rowbase(u.bb); u.L = bb_len(u.bb); u.t0 = blk * 256 + 32 * w; return u;
}
__device__ __forceinline__ void attn_memory_phase(Frame& F) {
    const int NU = 1280, ub = (int)(((long)F.vcu * NU) / F.G), ue = (int)(((long)(F.vcu + 1) * NU) / F.G);
    const int lane = F.lane, ql = lane & 31, hi = lane >> 5, w = F.wave;
    const float cshift = F.CONSTS[1];
    int prev = -1;
    bf16x8 qn[4];
    if (ub < ue) { const MemUnit u0 = mem_decode(ub, w); const bf16* qp = F.MQ + ((size_t)u0.rb * NHM + (size_t)u0.hm * u0.L + u0.t0 + ql) * 64 + 8 * hi;
#pragma unroll
        for (int d0 = 0; d0 < 4; ++d0) qn[d0] = *(const GAS bf16x8*)(qp + 16 * d0); }
    for (int it = ub; it < ue; ++it) {
        const MemUnit u = mem_decode(it, w); const int bb = u.bb, hm = u.hm, rb = u.rb, t0 = u.t0;
        if (bb * 4 + hm != prev) { prev = bb * 4 + hm;
            const size_t mb = (size_t)(bb * NHM + hm) * NMEM * 64;
            v4u kd[4], vd[4];
            attn_stage_load<256>(F.tid, kd, vd, F.KM + mb, F.VM + mb, 0, 256, 0, 1);
            __syncthreads();
            attn_stage_write<256>(F, F.tid, kd, vd, 0, 256);
            __syncthreads(); }
        bf16x8 qr[4];
#pragma unroll
        for (int d0 = 0; d0 < 4; ++d0) qr[d0] = qn[d0];
        bf16* mp = F.MIX + (size_t)(rb + t0 + (lane >> 3)) * DM + 2 * DHY + hm * 64 + (lane & 7) * 8;
        v4u gv[4];
#pragma unroll
        for (int g = 0; g < 4; ++g) gv[g] = *(const GAS v4u*)(mp + (size_t)(8 * g) * DM);
        if (it + 1 < ue) { const MemUnit un = mem_decode(it + 1, w); const bf16* qp = F.MQ + ((size_t)un.rb * NHM + (size_t)un.hm * un.L + un.t0 + ql) * 64 + 8 * hi;
#pragma unroll
            for (int d0 = 0; d0 < 4; ++d0) qn[d0] = *(const GAS bf16x8*)(qp + 16 * d0); }
        f32x16 o0, o1;
#pragma unroll
        for (int r = 0; r < 16; ++r) { o0[r] = 0.f; o1[r] = 0.f; }
        float lsum = 0.f;
        attn_tiles<8, false>(F.lds, 0, qr, -cshift, false, 0, 256, lsum, o0, o1, lane);
        lsum += __shfl_xor(lsum, 32);
        LAS float* lsc = (LAS float*)(F.lds + AT_L) + w * 32;
        if (hi == 0) lsc[ql] = lsum;
        asm volatile("s_waitcnt lgkmcnt(0)" ::: "memory");
        LAS bf16* ost = (LAS bf16*)(F.lds + AT_O) + w * 512;
#pragma unroll
        for (int g = 0; g < 4; ++g) {
#pragma unroll
            for (int j = 0; j < 4; ++j) { const float inv = 1.0f / lsc[8 * g + 4 * hi + j]; ost[(4 * hi + j) * 64 + ql] = (bf16)f2bf(o0[4 * g + j] * inv); ost[(4 * hi + j) * 64 + 32 + ql] = (bf16)f2bf(o1[4 * g + j] * inv); }
            asm volatile("s_waitcnt lgkmcnt(0)" ::: "memory");
            const v4u ov = *(const LAS v4u*)(ost + (lane >> 3) * 64 + (lane & 7) * 8);
            asm volatile("s_waitcnt lgkmcnt(0)" ::: "memory");
            const v4u gg = gv[g]; v4u q;
            q.x = pk2(bflo(gg.x) * bflo(ov.x), bfhi(gg.x) * bfhi(ov.x)); q.y = pk2(bflo(gg.y) * bflo(ov.y), bfhi(gg.y) * bfhi(ov.y));
            q.z = pk2(bflo(gg.z) * bflo(ov.z), bfhi(gg.z) * bfhi(ov.z)); q.w = pk2(bflo(gg.w) * bflo(ov.w), bfhi(gg.w) * bfhi(ov.w));
            *(GAS v4u*)(mp + F.woff + (size_t)(8 * g) * DM) = q; }
    }
    __syncthreads();
}
struct ACLoad { v4u x0, x1, x2, g; float l0, l1, l2; };
__device__ __forceinline__ ACLoad ac_load(const bf16* OC, const float* LC, const bf16* MIX, long id) {
    const int m = (int)(id / 48), ch = (int)(id % 48), h = ch >> 3; ACLoad r;
    r.x0 = *(const GAS v4u*)(OC + (size_t)m * DHY + ch * 8); r.x1 = *(const GAS v4u*)(OC + ((size_t)MT + m) * DHY + ch * 8); r.x2 = *(const GAS v4u*)(OC + ((size_t)2 * MT + m) * DHY + ch * 8);
    r.l0 = LC[(size_t)m * NH + h]; r.l1 = LC[((size_t)MT + m) * NH + h]; r.l2 = LC[((size_t)2 * MT + m) * NH + h];
    r.g = *(const GAS v4u*)(MIX + (size_t)m * DM + DHY + ch * 8); return r;
}
__device__ __forceinline__ void attn_combine_phase(Frame& F) {
    const long NT8 = (long)MT * 48, stride = (long)F.G * (NWAVES * 64);
    long id = (long)F.vcu * (NWAVES * 64) + F.tid;
    if (id >= NT8) return;
    ACLoad cur = ac_load(F.OC, F.LC, F.MIX, id);
    for (; id < NT8; id += stride) {
        const long nx = id + stride < NT8 ? id + stride : id;
        const ACLoad nxt = ac_load(F.OC, F.LC, F.MIX, nx);
        const int m = (int)(id / 48), ch = (int)(id % 48);
        const float inv = 1.0f / (cur.l0 + cur.l1 + cur.l2);
        float o[8];
        o[0] = bflo(cur.x0.x) + bflo(cur.x1.x) + bflo(cur.x2.x); o[1] = bfhi(cur.x0.x) + bfhi(cur.x1.x) + bfhi(cur.x2.x); o[2] = bflo(cur.x0.y) + bflo(cur.x1.y) + bflo(cur.x2.y); o[3] = bfhi(cur.x0.y) + bfhi(cur.x1.y) + bfhi(cur.x2.y);
        o[4] = bflo(cur.x0.z) + bflo(cur.x1.z) + bflo(cur.x2.z); o[5] = bfhi(cur.x0.z) + bfhi(cur.x1.z) + bfhi(cur.x2.z); o[6] = bflo(cur.x0.w) + bflo(cur.x1.w) + bflo(cur.x2.w); o[7] = bfhi(cur.x0.w) + bfhi(cur.x1.w) + bfhi(cur.x2.w);
        const v4u g = cur.g; v4u q;
        q.x = pk2(bflo(g.x) * o[0] * inv, bfhi(g.x) * o[1] * inv); q.y = pk2(bflo(g.y) * o[2] * inv, bfhi(g.y) * o[3] * inv);
        q.z = pk2(bflo(g.z) * o[4] * inv, bfhi(g.z) * o[5] * inv); q.w = pk2(bflo(g.w) * o[6] * inv, bfhi(g.w) * o[7] * inv);
        *(GAS v4u*)(F.MIX + F.woff + (size_t)m * DM + DHY + ch * 8) = q;
        cur = nxt;
    }
}

#define DUP_SEL_UNUSED 0
#ifndef TS_I
#define TS_I -1
#define TS_J -1
#endif
struct Args { const float* in[23]; float* out; unsigned char* ws; int ph_lo, ph_hi, li, pad; };
__global__ void __launch_bounds__(NWAVES * 64, 2) hymba_fwd(Args args) {
    extern __shared__ __attribute__((aligned(16))) unsigned char lds[];
    Frame F;
    F.lds = (LAS unsigned char*)lds;
    F.MISC = (volatile LAS unsigned*)(F.lds + MISC_OFF);
    F.tid = threadIdx.x; F.lane = F.tid & 63; F.wave = __builtin_amdgcn_readfirstlane(F.tid >> 6);
    F.G = gridDim.x; { const int bx = blockIdx.x; F.vcu = (F.G % 8 == 0) ? (bx % 8) * (F.G / 8) + bx / 8 : bx; }
    unsigned char* ws = args.ws;
    F.ctl = (gu32*)(ws + WS_CTL);
    F.xp = args.in[0]; F.xs = args.in[1]; F.memp = args.in[2]; F.mems = args.in[3]; F.norm_in = args.in[4]; F.w_in = args.in[5]; F.conv_w = args.in[6]; F.conv_b = args.in[7];
    F.fw1 = args.in[8]; F.fb1 = args.in[9]; F.ffreq = args.in[10]; F.fw2 = args.in[11]; F.fb2 = args.in[12]; F.fw3 = args.in[13]; F.skip = args.in[14]; F.gq = args.in[15]; F.gk = args.in[16];
    F.mem_norm = args.in[17]; F.w_mkv = args.in[18]; F.gmq = args.in[19]; F.gmk = args.in[20]; F.w_out = args.in[21]; F.rel_bias = args.in[22]; F.out = args.out;
    F.WTin = (bf16*)(ws + WS_WTIN); F.WTout = (bf16*)(ws + WS_WTOUT); F.WTmkv = (bf16*)(ws + WS_WTMKV); F.MEMB = (bf16*)(ws + WS_MEMB); F.KM = (bf16*)(ws + WS_KM); F.VM = (bf16*)(ws + WS_VM);
    F.XB = (bf16*)(ws + WS_XB); F.ST = (bf16*)(ws + WS_ST); F.CT = (bf16*)(ws + WS_CT); F.ZHY = (bf16*)(ws + WS_ZHY); F.Q = (bf16*)(ws + WS_Q); F.K = (bf16*)(ws + WS_K); F.V = (bf16*)(ws + WS_V);
    F.MQ = (bf16*)(ws + WS_MQ); F.MIX = (bf16*)(ws + WS_MIX); F.woff = 0; F.H2P = (float*)(ws + WS_H2P); F.H2S = (float*)(ws + WS_H2S); F.BIAS = (float*)(ws + WS_BIAS); F.GAINS = (float*)(ws + WS_GAINS); F.CONSTS = (float*)(ws + WS_CONSTS); F.RSTD = (float*)(ws + WS_RSTD); F.LC = (float*)(ws + WS_LC); F.OC = (bf16*)(ws + WS_OC); F.FBP = (float*)(ws + WS_OC); F.FBS = (float*)(ws + WS_OC + 24 * MiB);
    F.KSP = (cf2*)(ws + WS_KSP); F.KSS = (cf2*)(ws + WS_KSS);
    for (int u = F.tid; u < (LDS_BYTES - LDSCTL_OFF) / 4; u += NWAVES * 64) ((LAS unsigned*)(F.lds + LDSCTL_OFF))[u] = 0u;
    __syncthreads();
    XcdBarrier bar; bar.bar = (unsigned*)(F.ctl + CW_BAR); bar.x = 0; bar.st = nullptr;
    if (N_LAUNCHES != PER_PHASE) bar = xcd_barrier_post((unsigned*)(F.ctl + CW_BAR), F.MISC + 8);
#define GRID_BAR(seam) do { if (N_LAUNCHES == PER_PHASE) { if (F.tid == 0) __hip_atomic_store(F.ctl + CW_TMO, 0xBADBA0u | (unsigned)(seam), RLX_AGENT); } else { xcd_barrier(bar); } } while (0)
    const int lo = args.ph_lo, hi = args.ph_hi;
    unsigned long long* const tsb = (unsigned long long*)(ws + WS_CTL + 524288);
#define STAMP(k) do { if (TS_I >= 0 && blockIdx.x == 0 && F.tid == 0) __hip_atomic_store(tsb + (k), rt(), RLX_AGENT); } while (0)
    STAMP(0);
#ifndef PH_MASK
#define PH_MASK 63
#endif
#define IN(k) (((PH_MASK >> (k)) & 1) && lo <= (k) && (k) < hi)
#define BOTH(k) (IN(k) && IN((k) + 1))

    if (IN(0)) { p0_prologue(F); if (DUP_SEL == 30) p0_prologue(F); STAMP(1); if (BOTH(0)) GRID_BAR(0); STAMP(2); if (DUP_SEL == 20) { for (int k = 0; k < 10; ++k) GRID_BAR(0); } }
    if (IN(1)) {
#ifndef NO_G1
        { pg8::Gemm g{F.XB, F.WTin, MT, DIN, DM}; pg8::StaticOrder S; S.init(MT, DIN, F.G, (int)blockIdx.x);
          pg8::EpiZ E{args.ws, F.GAINS};
          static_assert(WS_V - WS_K == WS_K - WS_Q, "Q | K | V equally spaced");
          pg8::gemm_phase<pg8::EpiZ, pg8::StaticOrder, true, true>(F.lds + RING_OFF, g, S, E);
          if (DUP_SEL == 10) pg8::gemm_phase<pg8::EpiZ, pg8::StaticOrder, true, true>(F.lds + RING_OFF, g, S, E);
          if (DUP_SEL == 11) { pg8::EpiZT<0> E1{args.ws, F.GAINS}; pg8::gemm_phase<pg8::EpiZT<0>, pg8::StaticOrder, true, true>(F.lds + RING_OFF, g, S, E1); }
          if (DUP_SEL == 12) { pg8::EpiZT<1> E1{args.ws, F.GAINS}; pg8::gemm_phase<pg8::EpiZT<1>, pg8::StaticOrder, true, true>(F.lds + RING_OFF, g, S, E1); }
          if (DUP_SEL == 13) { pg8::EpiZT<2> E1{args.ws, F.GAINS}; pg8::gemm_phase<pg8::EpiZT<2>, pg8::StaticOrder, true, true>(F.lds + RING_OFF, g, S, E1); }
          if (DUP_SEL == 14) { pg8::EpiZT<4> E1{args.ws, F.GAINS}; pg8::gemm_phase<pg8::EpiZT<4>, pg8::StaticOrder, true, true>(F.lds + RING_OFF, g, S, E1); } }
#endif
        STAMP(3);
#ifndef NO_MKV
        { pg8::Gemm g{F.MEMB, F.WTmkv, MMEM, DMKV, DM}; pg8::StaticOrder S; S.init(MMEM, DMKV, F.G, (int)((blockIdx.x + F.G / 2) % F.G));
          pg8::EpiMKV E{F.KM, F.GAINS + 192};
          pg8::gemm_phase<pg8::EpiMKV, pg8::StaticOrder, true, true>(F.lds + RING_OFF, g, S, E); }
#endif
        STAMP(4);
#ifndef NO_FILT
        filterA_phase(F);
#endif
        STAMP(5); if (BOTH(1)) GRID_BAR(1); STAMP(6);
    }
    if (IN(2)) { filter_phase(F); if (DUP_SEL == 21) filter_phase(F); attn_memory_phase(F); if (DUP_SEL == 31) { F.woff = (long)(WS_OC - WS_MIX) / 2; attn_memory_phase(F); F.woff = 0; } STAMP(7); if (BOTH(2)) GRID_BAR(2); STAMP(8); }
    if (IN(3)) {
#define P3_HY() do { F.lane = lane_now(); F.tid = F.wave * 64 + F.lane; hyena_phase<7>(F); if (DUP_SEL == 15) hyena_phase<1>(F); if (DUP_SEL == 16) hyena_phase<2>(F); if (DUP_SEL == 18) hyena_phase<10>(F); if (DUP_SEL == 17) hyena_phase<4>(F); if (DUP_SEL == 34) hyena_phase<3>(F); STAMP(9); } while (0)
#define P3_AT() do { F.lane = lane_now(); F.tid = F.wave * 64 + F.lane; attn_dilated_phase<7>(F); if (DUP_SEL == 2) attn_dilated_phase<7>(F); if (DUP_SEL == 8) attn_dilated_phase<1>(F); if (DUP_SEL == 9) attn_dilated_phase<2>(F); if (DUP_SEL == 4) attn_dilated_phase<4>(F); STAMP(10); } while (0)
        if (F.vcu & 1) { P3_AT(); P3_HY(); } else { P3_HY(); P3_AT(); }
 if (BOTH(3)) GRID_BAR(3); STAMP(12); }
    if (IN(4)) { combine_phase(F); STAMP(13); attn_combine_phase(F); STAMP(14); if (DUP_SEL == 32) { F.woff = (long)(WS_Q - WS_MIX) / 2; combine_phase(F); F.woff = 0; } if (DUP_SEL == 33) { F.woff = (long)(WS_Q - WS_MIX) / 2; attn_combine_phase(F); F.woff = 0; } if (BOTH(4)) GRID_BAR(4); }
    if (IN(5)) {
        pg8::Gemm g{F.MIX, F.WTout, MT, DM, DM}; pg8::StaticOrder S; S.init(MT, DM, F.G, (int)blockIdx.x);
        float osc = 1.0f;
        if (TS_I >= 0) { const unsigned long long ta = __hip_atomic_load(tsb + (TS_I < 0 ? 0 : TS_I), RLX_AGENT), tb = __hip_atomic_load(tsb + (TS_J < 0 ? 0 : TS_J), RLX_AGENT); osc = 1.0f + (float)(((long long)(tb - ta) + 2500) / 5000) * 5e-3f; }
        pg8::EpiOut E{F.XB, F.RSTD, F.out, osc};
        pg8::gemm_phase<pg8::EpiOut, pg8::StaticOrder, true, true>(F.lds + RING_OFF, g, S, E);
        if (DUP_SEL == 3) pg8::gemm_phase<pg8::EpiOut, pg8::StaticOrder, true, true>(F.lds + RING_OFF, g, S, E);
        if (DUP_SEL == 5) { pg8::EpiNull E0; pg8::gemm_phase<pg8::EpiNull, pg8::StaticOrder, true, true>(F.lds + RING_OFF, g, S, E0); }
        if (DUP_SEL == 6) { pg8::EpiStoreOnly E1{(float*)(ws + WS_ZHY)}; pg8::gemm_phase<pg8::EpiStoreOnly, pg8::StaticOrder, true, true>(F.lds + RING_OFF, g, S, E1); }
    }
#undef IN
#undef BOTH
}

extern "C" void kernel_launch(void* const* d_in, const int* in_sizes, int n_in, void* d_out, int out_size, void* d_ws, size_t ws_size, hipStream_t stream) {
    static int grid = 0;
    if (grid == 0) {
        if (n_in != 23 || in_sizes[0] != MP * DM || out_size != MT * DM || ws_size < WS_END) { fprintf(stderr, "kernel_launch: unexpected shapes (n_in %d, in0 %d, out %d, ws %zu)\n", n_in, n_in > 0 ? in_sizes[0] : -1, out_size, ws_size); grid = -1; return; }
        int dev = 0, cus = 0;
        if (hipGetDevice(&dev) != hipSuccess || hipDeviceGetAttribute(&cus, hipDeviceAttributeMultiprocessorCount, dev) != hipSuccess) { grid = -1; return; }
        if (hipFuncSetAttribute((const void*)hymba_fwd, hipFuncAttributeMaxDynamicSharedMemorySize, LDS_BYTES) != hipSuccess) { fprintf(stderr, "kernel_launch: hipFuncSetAttribute failed\n"); grid = -1; return; }
        (void)hipGetLastError();
        grid = cus;
    }
    if (grid < 0) return;
    if (hipMemsetAsync((char*)d_ws + WS_CTL, 0, CTL_ZERO_BYTES, stream) != hipSuccess) return;
    Args a{};
    for (int i = 0; i < 23; ++i) a.in[i] = (const float*)d_in[i];
    a.out = (float*)d_out; a.ws = (unsigned char*)d_ws;
    for (int li = 0; li < N_LAUNCHES; ++li) {
        a.ph_lo = (N_LAUNCHES == PER_PHASE) ? li : 0; a.ph_hi = (N_LAUNCHES == PER_PHASE) ? li + 1 : PER_PHASE; a.li = li;
        hipLaunchKernelGGL(hymba_fwd, dim3(grid), dim3(NWAVES * 64), LDS_BYTES, stream, a);
        const hipError_t le = hipPeekAtLastError();
        if (le != hipSuccess) { fprintf(stderr, "kernel_launch: launch %d failed: %s\n", li, hipGetErrorName(le)); break; }
    }
}
```

```cpp
#include <hip/hip_runtime.h>
#include <cstdio>
#include <cstdint>
namespace pg8 {
#define PG8_LAS __attribute__((address_space(3)))
typedef unsigned short bf16_t;
typedef short bf16x8 __attribute__((ext_vector_type(8)));
typedef float f32x4 __attribute__((ext_vector_type(4)));
typedef unsigned u32x4 __attribute__((ext_vector_type(4)));
constexpr int BM = 256, BK = 64, HALF = 128, HTB = HALF * BK * 2  , STAGE_BYTES = 8 * HTB, NXCD = 8, WGM = 8;

__host__ __device__ __forceinline__ int lds_byte(int r, int c) { const int st = (r >> 4) * 2 + (c >> 5), rr = r & 15, cc = c & 31, ob = rr * 64 + cc * 2; return st * 1024 + (ob ^ (((ob >> 9) & 1) << 5)); }
__host__ __device__ __forceinline__ void stage_rc(int b, int& R, int& C) { const int st = b / 1024, sb = b % 1024, swz = sb ^ (((sb >> 9) & 1) << 5); R = (st >> 1) * 16 + swz / 64; C = (st & 1) * 32 + (swz % 64) / 2; }
__host__ __device__ __forceinline__ int perm32(int rho) { const int n = rho >> 4, i = rho & 15; return 8 * (i >> 2) + 4 * n + (i & 3); }

struct Unit { int pm, pn; };
struct Gemm { const bf16_t* A; const bf16_t* Bt; int M, N, K; };

struct StaticOrder {
    int nM, nN, nwg, G, c;
    __host__ __device__ void init(int M, int N, int G_, int c_) { nM = M / BM; nN = N / BM; nwg = nM * nN; G = G_; c = c_; }
    __host__ __device__ bool next(int i, Unit& u) const {
        const long L = (long)i * G + c; if (L >= nwg) return false;
        int wgid = (int)L; { const int q = nwg / NXCD, r = nwg % NXCD, xcd = wgid % NXCD, off = wgid / NXCD; wgid = (xcd < r ? xcd * (q + 1) : r * (q + 1) + (xcd - r) * q) + off; }
        const int nig = WGM * nN, gid = wgid / nig, fm = gid * WGM, gsz = (nM - fm) < WGM ? (nM - fm) : WGM;
        u.pm = fm + ((wgid % nig) % gsz); u.pn = (wgid % nig) / gsz; return true;
    }
    __device__ __forceinline__ void a_ready(const Unit&) const {}
    __device__ __forceinline__ void done(const Unit&) const {}
};

__device__ __forceinline__ unsigned cvt_pk_bf16(float lo, float hi) { unsigned r; asm volatile("v_cvt_pk_bf16_f32 %0, %1, %2" : "=v"(r) : "v"(lo), "v"(hi)); return r; }
typedef float f32x2 __attribute__((ext_vector_type(2)));
template <class Epi, class Sched, bool ALIGN_EPI = false, bool SP2 = false>
__device__ __forceinline__ void gemm_phase(PG8_LAS unsigned char* lds, const Gemm g, const Sched& S, const Epi& E) {
    const int tid = threadIdx.x, wid = __builtin_amdgcn_readfirstlane(tid >> 6), lane = tid & 63, wr = wid >> 2, wc = wid & 3, fr = lane & 15, fq = lane >> 4;
    const int K = g.K, nt = K / BK;
    unsigned voffA[2], voffB[2];
#pragma unroll
    for (int i = 0; i < 2; ++i) { int R, C; stage_rc(tid * 16 + i * 8192, R, C); const int Rb = Epi::PERM ? ((R & ~31) + perm32(R & 31)) : R;
        voffA[i] = (unsigned)(R * K + C) * 2u; voffB[i] = (unsigned)(Rb * K + C) * 2u; }
    const size_t kstep = (size_t)(BK * 2);
    const size_t hstep = (size_t)HALF * K * 2;
    const size_t tstep = 2 * hstep;
    const unsigned ldsw = (unsigned)wid * 1024u;
    const int aoff = lds_byte(wr * 64 + fr, fq * 8), boff = lds_byte(wc * 32 + fr, fq * 8);
#define PG8_SA(b, h) (((b) * 2 + (h)) * HTB)
#define PG8_SB(b, h) ((4 + (b) * 2 + (h)) * HTB)
#define PG8_STAGE(bufoff, gbase, voff) do { _Pragma("unroll") for (int _i = 0; _i < 2; ++_i) \
        __builtin_amdgcn_global_load_lds((const unsigned*)((const char*)(gbase) + (voff)[_i]), (PG8_LAS unsigned*)(lds + (bufoff) + ldsw + _i * 8192), 16, 0, 0); } while (0)
#define PG8_LDA(dst, b, h) do { _Pragma("unroll") for (int m = 0; m < 4; ++m) _Pragma("unroll") for (int k = 0; k < 2; ++k) dst[m][k] = *(const PG8_LAS bf16x8*)(lds + PG8_SA(b, h) + aoff + m * 2048 + k * 1024); } while (0)
#define PG8_LDB(dst, b, h) do { _Pragma("unroll") for (int n = 0; n < 2; ++n) _Pragma("unroll") for (int k = 0; k < 2; ++k) dst[n][k] = *(const PG8_LAS bf16x8*)(lds + PG8_SB(b, h) + boff + n * 2048 + k * 1024); } while (0)
#define PG8_MMA(ai, bj, At, Bt) do { __builtin_amdgcn_s_setprio(1); _Pragma("unroll") for (int m = 0; m < 4; ++m) _Pragma("unroll") for (int n = 0; n < 2; ++n) _Pragma("unroll") for (int k = 0; k < 2; ++k) \
        acc[ai][bj][m][n] = __builtin_amdgcn_mfma_f32_16x16x32_bf16(Bt[n][k], At[m][k], acc[ai][bj][m][n], 0, 0, 0); __builtin_amdgcn_s_setprio(0); } while (0)
#define PG8_WAIT_V(n) asm volatile("s_waitcnt vmcnt(" #n ")" ::: "memory")
#define PG8_WAIT_L(n) asm volatile("s_waitcnt lgkmcnt(" #n ")" ::: "memory")
#define PG8_BAR __builtin_amdgcn_s_barrier()
#define PG8_SCHED __builtin_amdgcn_sched_barrier(0)
    Unit cur, nxt; int ui = 0;
    if (!S.next(0, cur)) return;
    f32x4 acc[2][2][4][2];
#pragma unroll
    for (int a = 0; a < 2; ++a)
#pragma unroll
        for (int b = 0; b < 2; ++b)
#pragma unroll
            for (int m = 0; m < 4; ++m)
#pragma unroll
                for (int n = 0; n < 2; ++n) acc[a][b][m][n] = (f32x4){0.f, 0.f, 0.f, 0.f};
    bf16x8 At[4][2], B0[2][2], B1[2][2];
    const char* cA = (const char*)g.A + (size_t)cur.pm * tstep; const char* cB = (const char*)g.Bt + (size_t)cur.pn * tstep;
    S.a_ready(cur);
    if constexpr (SP2) {
        PG8_STAGE(PG8_SB(0, 0), cB, voffB); PG8_STAGE(PG8_SB(0, 1), cB + hstep, voffB); PG8_STAGE(PG8_SA(0, 0), cA, voffA); PG8_STAGE(PG8_SA(0, 1), cA + hstep, voffA);
        if (wr == 1) PG8_BAR;
        PG8_WAIT_V(2); PG8_BAR;
        PG8_STAGE(PG8_SB(1, 0), cB + kstep, voffB); PG8_STAGE(PG8_SA(1, 0), cA + kstep, voffA); PG8_STAGE(PG8_SB(1, 1), cB + hstep + kstep, voffB);
        PG8_WAIT_V(6); PG8_BAR;
    } else {
        PG8_STAGE(PG8_SB(0, 0), cB, voffB); PG8_STAGE(PG8_SA(0, 0), cA, voffA); PG8_STAGE(PG8_SB(0, 1), cB + hstep, voffB); PG8_STAGE(PG8_SA(0, 1), cA + hstep, voffA);
        if (wr == 1) PG8_BAR;
        PG8_WAIT_V(4); PG8_BAR;
        PG8_STAGE(PG8_SB(1, 0), cB + kstep, voffB); PG8_STAGE(PG8_SA(1, 0), cA + kstep, voffA); PG8_STAGE(PG8_SB(1, 1), cB + hstep + kstep, voffB);
        PG8_WAIT_V(6); PG8_BAR;
    }
    for (;;) {
        const bool has_next = S.next(ui + 1, nxt);
        const char* nA = has_next ? (const char*)g.A + (size_t)nxt.pm * tstep : cA; const char* nB = has_next ? (const char*)g.Bt + (size_t)nxt.pn * tstep : cB;
        for (int t = 0; t < nt; t += 2) {
            const bool last = (t == nt - 2);
            const char* a1 = cA + (size_t)(t + 1) * kstep;
            const char* a2 = last ? nA : cA + (size_t)(t + 2) * kstep; const char* b2 = last ? nB : cB + (size_t)(t + 2) * kstep;
            const char* a3 = a2 + kstep; const char* b3 = b2 + kstep;
            if (last && has_next) S.a_ready(nxt);
            if constexpr (SP2) {
            PG8_LDB(B0, 0, 0); PG8_LDB(B1, 0, 1); PG8_SCHED; PG8_LDA(At, 0, 0); PG8_STAGE(PG8_SA(1, 1), a1 + hstep, voffA);
            PG8_WAIT_V(8); PG8_WAIT_L(0); PG8_BAR; PG8_MMA(0, 0, At, B0); PG8_MMA(0, 1, At, B1); PG8_BAR; PG8_SCHED;
            PG8_LDA(At, 0, 1); PG8_STAGE(PG8_SB(0, 0), b2, voffB); PG8_STAGE(PG8_SB(0, 1), b2 + hstep, voffB); PG8_STAGE(PG8_SA(0, 0), a2, voffA);
            PG8_WAIT_V(8); PG8_WAIT_L(0); PG8_BAR; PG8_MMA(1, 0, At, B0); PG8_MMA(1, 1, At, B1); PG8_BAR; PG8_SCHED;
            PG8_LDB(B0, 1, 0); PG8_LDB(B1, 1, 1); PG8_SCHED; PG8_LDA(At, 1, 0); PG8_STAGE(PG8_SA(0, 1), a2 + hstep, voffA);
            PG8_WAIT_V(8); PG8_WAIT_L(0); PG8_BAR; PG8_MMA(0, 0, At, B0); PG8_MMA(0, 1, At, B1); PG8_BAR; PG8_SCHED;
            PG8_LDA(At, 1, 1); PG8_STAGE(PG8_SB(1, 0), b3, voffB); PG8_STAGE(PG8_SB(1, 1), b3 + hstep, voffB); PG8_STAGE(PG8_SA(1, 0), a3, voffA);
            PG8_WAIT_V(8); PG8_WAIT_L(0); PG8_BAR; PG8_MMA(1, 0, At, B0); PG8_MMA(1, 1, At, B1); PG8_BAR; PG8_SCHED;
            } else {
            PG8_LDB(B0, 0, 0); PG8_SCHED; PG8_LDA(At, 0, 0); PG8_STAGE(PG8_SA(1, 1), a1 + hstep, voffA);
            PG8_WAIT_L(8); PG8_BAR; PG8_WAIT_L(0); PG8_MMA(0, 0, At, B0); PG8_BAR; PG8_SCHED;
            PG8_LDB(B1, 0, 1); PG8_STAGE(PG8_SB(0, 0), b2, voffB);
            PG8_BAR; PG8_WAIT_L(0); PG8_MMA(0, 1, At, B1); PG8_BAR;
            PG8_LDA(At, 0, 1); PG8_STAGE(PG8_SA(0, 0), a2, voffA);
            PG8_BAR; PG8_WAIT_L(0); PG8_MMA(1, 0, At, B0); PG8_BAR; PG8_SCHED;
            PG8_STAGE(PG8_SB(0, 1), b2 + hstep, voffB);
            PG8_WAIT_V(6); PG8_BAR; PG8_MMA(1, 1, At, B1); PG8_BAR;
            PG8_LDB(B0, 1, 0); PG8_SCHED; PG8_LDA(At, 1, 0); PG8_STAGE(PG8_SA(0, 1), a2 + hstep, voffA);
            PG8_WAIT_L(8); PG8_BAR; PG8_WAIT_L(0); PG8_MMA(0, 0, At, B0); PG8_BAR; PG8_SCHED;
            PG8_LDB(B1, 1, 1); PG8_STAGE(PG8_SB(1, 0), b3, voffB);
            PG8_BAR; PG8_WAIT_L(0); PG8_MMA(0, 1, At, B1); PG8_BAR;
            PG8_LDA(At, 1, 1); PG8_STAGE(PG8_SA(1, 0), a3, voffA);
            PG8_BAR; PG8_WAIT_L(0); PG8_MMA(1, 0, At, B0); PG8_BAR; PG8_SCHED;
            PG8_STAGE(PG8_SB(1, 1), b3 + hstep, voffB);
            PG8_WAIT_V(6); PG8_BAR; PG8_MMA(1, 1, At, B1); PG8_BAR;
            }
        }
        if constexpr (ALIGN_EPI) { if (wr == 0) PG8_BAR; }
        if constexpr (!Epi::AFTER_DRAIN) { E(acc, cur, wr, wc, fr, fq); S.done(cur); }
        if (!has_next) break;
#pragma unroll
        for (int a = 0; a < 2; ++a)
#pragma unroll
            for (int b = 0; b < 2; ++b)
#pragma unroll
                for (int m = 0; m < 4; ++m)
#pragma unroll
                    for (int n = 0; n < 2; ++n) acc[a][b][m][n] = (f32x4){0.f, 0.f, 0.f, 0.f};
        cur = nxt; cA = nA; cB = nB; ++ui;
        if constexpr (ALIGN_EPI) { if (wr == 1) PG8_BAR; }
    }
    PG8_WAIT_V(0);
    if constexpr (!ALIGN_EPI) { if (wr == 0) PG8_BAR; }
    PG8_BAR;
    if constexpr (Epi::AFTER_DRAIN) { E.fused(acc, cur, wr, wc, fr, fq, lds, wid, lane); S.done(cur); }
#undef PG8_SA
#undef PG8_SB
#undef PG8_STAGE
#undef PG8_LDA
#undef PG8_LDB
#undef PG8_MMA
#undef PG8_WAIT_V
#undef PG8_WAIT_L
#undef PG8_BAR
#undef PG8_SCHED
}
}

#define GAS __attribute__((address_space(1)))
#define LAS __attribute__((address_space(3)))
typedef unsigned short bf16;
typedef unsigned v4u __attribute__((ext_vector_type(4)));
typedef float f32x4 __attribute__((ext_vector_type(4)));
typedef short bf16x8 __attribute__((ext_vector_type(8)));
typedef GAS unsigned gu32;
typedef GAS unsigned long long gu64;
#define RLX_AGENT __ATOMIC_RELAXED, __HIP_MEMORY_SCOPE_AGENT
#define LDS_WAIT() asm volatile("s_waitcnt lgkmcnt(0)" ::: "memory")
#define VM_WAIT() asm volatile("s_waitcnt vmcnt(0)" ::: "memory")
__device__ __forceinline__ unsigned long long rt() { return __builtin_amdgcn_s_memrealtime(); }
__device__ __forceinline__ unsigned f2bf(float f) { unsigned u = __builtin_bit_cast(unsigned, f); return (u + 0x7fffu + ((u >> 16) & 1u)) >> 16; }
__device__ __forceinline__ unsigned pk2(float lo, float hi) { return f2bf(lo) | (f2bf(hi) << 16); }

#define XB_TMO      128
#define XB_XCNT(j)  (256  + 64 * (j))
#define XB_XSUB(j)  (1280 + 64 * (j))
#define XB_XGEN(j)  (2304 + 64 * (j))
#define XB_TOP      3328
#define XB_TOPGEN   3392
#define XCD_BAR_WORDS 3456
#define XB_SPIN_CAP (1u << 18)

__device__ __forceinline__ unsigned xb_ld(unsigned* p)              { return __hip_atomic_load(p, __ATOMIC_RELAXED, __HIP_MEMORY_SCOPE_AGENT); }
__device__ __forceinline__ unsigned xb_add(unsigned* p, unsigned v) { return __hip_atomic_fetch_add(p, v, __ATOMIC_RELAXED, __HIP_MEMORY_SCOPE_AGENT); }
__device__ __forceinline__ unsigned xb_xcc_id() { return (unsigned)__builtin_amdgcn_s_getreg((3 << 11) | 20) & 0xFu; }
#define XB_SPIN(cond, bar) do { unsigned _sp = 0; while (cond) { __builtin_amdgcn_s_sleep(1); \
    if ((++_sp & 255u) == 0u) { if (xb_ld(&(bar)[XB_TMO])) break; if (_sp > XB_SPIN_CAP) { atomicAdd(&(bar)[XB_TMO], 1u); break; } } } } while (0)

struct XcdBarrier {
    unsigned* bar; unsigned x;
    volatile LAS unsigned* st;
};

__device__ __forceinline__ XcdBarrier xcd_barrier_post(unsigned* bar, volatile LAS unsigned* st) {
    XcdBarrier b; b.bar = bar; b.x = xb_xcc_id(); b.st = st;
    if (threadIdx.x == 0) (void)xb_add(&bar[XB_XCNT(b.x)], 1u);
    return b;
}
__device__ __forceinline__ void xcd_barrier_complete(unsigned* bar, unsigned x, unsigned& nloc, unsigned& nx) {
    const unsigned G = gridDim.x * gridDim.y * gridDim.z;
    unsigned sum, cnt, mine, sp = 0u;
    for (;;) {
        sum = 0u; cnt = 0u; mine = 0u;
#pragma unroll
        for (unsigned j = 0; j < 16; ++j) { const unsigned c = xb_ld(&bar[XB_XCNT(j)]); sum += c; cnt += (c > 0u) ? 1u : 0u; mine = (j == x) ? c : mine; }
        if (sum == G) break;
        __builtin_amdgcn_s_sleep(1);
        if ((++sp & 255u) == 0u) { if (xb_ld(&bar[XB_TMO])) break; if (sp > XB_SPIN_CAP) { atomicAdd(&bar[XB_TMO], 1u); break; } }
    }
    nloc = mine > 0u ? mine : 1u; nx = cnt > 0u ? cnt : 1u;
}

__device__ __forceinline__ void xcd_barrier(const XcdBarrier& b) {
    asm volatile("s_waitcnt vmcnt(0)" ::: "memory");
    __syncthreads();
    if (threadIdx.x == 0) {
        unsigned* bar = b.bar;
        __builtin_amdgcn_s_waitcnt(0);
        unsigned nloc = b.st[0], nx = b.st[1];
        if (nloc == 0u) { xcd_barrier_complete(bar, b.x, nloc, nx); b.st[0] = nloc; b.st[1] = nx; }
        const unsigned old = xb_add(&bar[XB_XSUB(b.x)], 1u);
        const unsigned gen = old / nloc;
        if (old + 1u == (gen + 1u) * nloc) {
            __builtin_amdgcn_fence(__ATOMIC_RELEASE, "agent");
            asm volatile("s_waitcnt vmcnt(0)" ::: "memory");
            const unsigned og = xb_add(&bar[XB_TOP], 1u);
            const unsigned tg = og / nx;
            if (og + 1u == (tg + 1u) * nx) xb_add(&bar[XB_TOPGEN], 1u);
            else XB_SPIN(xb_ld(&bar[XB_TOPGEN]) == tg, bar);
            __builtin_amdgcn_fence(__ATOMIC_ACQUIRE, "agent");
            xb_add(&bar[XB_XGEN(b.x)], 1u);
            asm volatile("s_waitcnt vmcnt(0)" ::: "memory");
        } else {
            XB_SPIN(xb_ld(&bar[XB_XGEN(b.x)]) == gen, bar);
            __builtin_amdgcn_fence(__ATOMIC_ACQUIRE, "agent");
            asm volatile("s_waitcnt vmcnt(0)" ::: "memory");
        }
    }
    __syncthreads();
}


constexpr int NWAVES = 8;
#define DUP_SEL 0
#ifndef MK_N_LAUNCHES
#define MK_N_LAUNCHES 1
#endif
constexpr int PER_PHASE = 6;
constexpr int N_LAUNCHES = MK_N_LAUNCHES;

constexpr int DM = 1024, DIN = 3584, LP = 8192, LS = 2048, NBATCH = 8;
constexpr int MP = NBATCH * LP, MS = NBATCH * LS, MT = MP + MS;
constexpr int DHY = 384, NH = 6, NHM = 4, HD = 64, NMEM = 256, DMKV = 512;
constexpr int MMEM = 2 * NBATCH * NMEM;
constexpr float RMS_EPS = 1e-6f;

constexpr size_t MiB = 1u << 20;
constexpr size_t WS_CTL = 0, CTL_ZERO_BYTES = 1 * MiB;
constexpr size_t WS_WTIN = 2 * MiB;
constexpr size_t WS_WTOUT = 10 * MiB;
constexpr size_t WS_WTMKV = 12 * MiB;
constexpr size_t WS_MEMB = 13 * MiB;
constexpr size_t WS_KM = 21 * MiB;
constexpr size_t WS_VM = 23 * MiB;
constexpr size_t WS_H2P = 25 * MiB;
constexpr size_t WS_H2S = 27 * MiB;
constexpr size_t WS_BIAS = 28 * MiB;
constexpr size_t WS_GAINS = 28 * MiB + 65536;
constexpr size_t WS_RSTD = 28 * MiB + 262144;
constexpr size_t WS_CONSTS = 28 * MiB + 131072;
constexpr size_t WS_KSP = 29 * MiB;
constexpr size_t WS_KSS = 77 * MiB;
constexpr size_t WS_XB = 90 * MiB;
constexpr size_t WS_ST = 90 * MiB;
constexpr size_t WS_CT = 150 * MiB;
constexpr size_t WS_ZHY = 250 * MiB;
constexpr size_t WS_Q = 430 * MiB, WS_K = 490 * MiB, WS_V = 550 * MiB;
constexpr size_t WS_MQ = 610 * MiB;
constexpr size_t WS_MIX = 650 * MiB;
constexpr size_t WS_OC = 810 * MiB;
constexpr size_t WS_LC = 990 * MiB;
constexpr size_t WS_END = 996 * MiB;
static_assert(WS_VM - WS_KM >= (size_t)16 * 4 * 256 * 64 * 2 && WS_H2P - WS_VM >= (size_t)16 * 4 * 256 * 64 * 2 && WS_KSS - WS_KSP >= (size_t)384 * 2 * 8192 * 8 && WS_XB - WS_KSS >= (size_t)384 * 2 * 2048 * 8, "ws map");
static_assert(WS_ZHY - WS_XB >= (size_t)81920 * 1024 * 2 && WS_CT - WS_ST >= (size_t)81920 * 384 * 2 && WS_ZHY - WS_CT >= (size_t)81920 * 384 * 2 && WS_Q - WS_ZHY >= (size_t)81920 * 1152 * 2, "ws map");
static_assert(WS_K - WS_Q >= (size_t)81920 * 384 * 2 && WS_MQ - WS_V >= (size_t)81920 * 384 * 2 && WS_MIX - WS_MQ >= (size_t)81920 * 256 * 2 && WS_END - WS_MIX >= (size_t)81920 * 1024 * 2, "ws map");
constexpr int CW_TMO = 0, CW_CODE = 1, CW_BAR = 4096;

constexpr int RING_OFF = 0, RING_BYTES = 131072;
constexpr int LDS_BYTES = 147456;
constexpr int LDSCTL_OFF = LDS_BYTES - 512, MISC_OFF = LDSCTL_OFF + 320;

typedef float cf2 __attribute__((ext_vector_type(2)));
typedef unsigned u32x2 __attribute__((ext_vector_type(2)));
typedef unsigned u32x4 __attribute__((ext_vector_type(4)));

__device__ __forceinline__ float bf2f(unsigned short h) { return __builtin_bit_cast(float, (unsigned)h << 16); }
__device__ __forceinline__ float bflo(unsigned w) { return __builtin_bit_cast(float, w << 16); }
__device__ __forceinline__ float bfhi(unsigned w) { return __builtin_bit_cast(float, w & 0xffff0000u); }
__device__ __forceinline__ cf2 cmul(cf2 a, cf2 b) { return (cf2){a.x * b.x - a.y * b.y, a.x * b.y + a.y * b.x}; }
__device__ __forceinline__ cf2 cmulc(cf2 a, cf2 b) { return (cf2){a.x * b.x + a.y * b.y, a.y * b.x - a.x * b.y}; }

__device__ __forceinline__ int bb_rowbase(int bb) { return bb < 8 ? bb * LP : MP + (bb - 8) * LS; }
__device__ __forceinline__ int bb_len(int bb) { return bb < 8 ? LP : LS; }
__device__ __forceinline__ void row_to_bt(int row, int& bb, int& t) { if (row < MP) { bb = row >> 13; t = row & (LP - 1); } else { const int r = row - MP; bb = 8 + (r >> 11); t = r & (LS - 1); } }

__device__ __forceinline__ int lane_now() { int l; asm volatile("v_mbcnt_lo_u32_b32 %0, -1, 0\n\tv_mbcnt_hi_u32_b32 %0, -1, %0" : "=v"(l)); return l; }
struct Frame {
    LAS unsigned char* lds;
    volatile LAS unsigned* MISC;
    gu32* ctl;
    int tid, lane, wave, vcu, G;
    long woff;
    const float *xp, *xs, *memp, *mems, *norm_in, *w_in, *conv_w, *conv_b, *fw1, *fb1, *ffreq, *fw2, *fb2, *fw3, *skip, *gq, *gk, *mem_norm, *w_mkv, *gmq, *gmk, *w_out, *rel_bias;
    float* out;
    bf16 *WTin, *WTout, *WTmkv, *MEMB, *KM, *VM, *XB, *ST, *CT, *ZHY, *Q, *K, *V, *MQ, *MIX;
    float *H2P, *H2S, *BIAS, *GAINS, *CONSTS, *LC, *FBP, *FBS, *RSTD; bf16* OC;
    cf2 *KSP, *KSS;
};

namespace pg8 {
__device__ __forceinline__ u32x4 pack8(f32x4 a, f32x4 b) { u32x4 w; w.x = cvt_pk_bf16(a[0], a[1]); w.y = cvt_pk_bf16(a[2], a[3]); w.z = cvt_pk_bf16(b[0], b[1]); w.w = cvt_pk_bf16(b[2], b[3]); return w; }
__device__ __forceinline__ float dot4(f32x4 a) { return (a[0] * a[0] + a[1] * a[1]) + (a[2] * a[2] + a[3] * a[3]); }
__device__ __forceinline__ float lane_xor1(float x) { return __builtin_bit_cast(float, __builtin_amdgcn_mov_dpp(__builtin_bit_cast(int, x), 0xB1, 0xF, 0xF, true)); }
__device__ __forceinline__ float asm_add(unsigned a, unsigned b) { float r; asm("v_add_f32_e32 %0, %1, %2" : "=v"(r) : "v"(a), "v"(b)); return r; }
__device__ __forceinline__ float sum_rows4(float x) {
    const unsigned x0 = __builtin_bit_cast(unsigned, x);
    const auto a = __builtin_amdgcn_permlane16_swap(x0, x0, false, false);
    const float y = asm_add(a[0], a[1]);
    const unsigned y0 = __builtin_bit_cast(unsigned, y);
    const auto b = __builtin_amdgcn_permlane32_swap(y0, y0, false, false);
    return asm_add(b[0], b[1]);
}
__device__ __forceinline__ float silu_f(float x) { return x * __builtin_amdgcn_rcpf(1.0f + __builtin_amdgcn_exp2f(-1.4426950408889634f * x)); }
__device__ __forceinline__ f32x4 silu4(f32x4 a) { return (f32x4){silu_f(a[0]), silu_f(a[1]), silu_f(a[2]), silu_f(a[3])}; }

template <int TM = 7> struct EpiZT {
    static constexpr bool PERM = true, AFTER_DRAIN = false;
    unsigned char* ws; const float* gains;
    __device__ __forceinline__ void operator()(const f32x4 (&acc)[2][2][4][2], const Unit& u, int wr, int wc, int fr, int fq) const {
        const int G = u.pn * 4 + wc, hc0 = 8 * fq;
        const int row0 = u.pm * BM + wr * 64 + fr;
        int bb, t0; row_to_bt(u.pm * BM, bb, t0);
        const int rb = bb_rowbase(bb), L = bb_len(bb);
        const bool live = (G < 18) ? (TM & 1) : (G < 40) ? (TM & 2) : (TM & 4);
        if (!live) {
#pragma unroll
            for (int ai = 0; ai < 2; ++ai)
#pragma unroll
                for (int m = 0; m < 4; ++m)
#pragma unroll
                    for (int bj = 0; bj < 2; ++bj)
#pragma unroll
                        for (int n = 0; n < 2; ++n) asm volatile("" :: "v"(acc[ai][bj][m][n]));
        } else if (G < 18) {
            const bool odd = fr & 1;
            bf16_t* zt = (bf16_t*)(ws + WS_ZHY) + (size_t)rb * 1152 + (size_t)(G * 64 + hc0 + (odd ? 32 : 0)) * L;
#pragma unroll
            for (int ai = 0; ai < 2; ++ai)
#pragma unroll
                for (int m = 0; m < 4; ++m) { const int te = (row0 + ai * HALF + m * 16 - rb) & ~1;
#pragma unroll
                    for (int k = 0; k < 8; ++k) { const float lo = acc[ai][0][m][k >> 2][k & 3], hi = acc[ai][1][m][k >> 2][k & 3];
                        const float send = odd ? lo : hi, recv = lane_xor1(send);
                        *(unsigned*)(zt + (size_t)k * L + te) = cvt_pk_bf16(odd ? recv : lo, odd ? hi : recv); } }
        } else if (G < 40) {
            const bool ismq = G >= 36;
            const int part = ismq ? 0 : (G - 18) / 6;
            const int h = ismq ? G - 36 : (G - 18) - 6 * part;
            const bool isv = (part == 2);
            const int nh = ismq ? NHM : NH;
            bf16_t* base = (bf16_t*)(ws + (ismq ? WS_MQ : WS_Q + (size_t)part * (WS_K - WS_Q)));
            const float* gain = gains + (ismq ? 128 : (part == 0 ? 0 : 64));
            const float scale = (ismq || part == 0) ? 0.125f * 1.4426950408889634f : 1.0f;
            if (isv) {
#pragma unroll
                for (int ai = 0; ai < 2; ++ai)
#pragma unroll
                    for (int m = 0; m < 4; ++m) { const int row = row0 + ai * HALF + m * 16; const int t = row - rb;
                        bf16_t* d = base + ((size_t)rb * nh + (size_t)h * L + t) * 64 + hc0;
                        *(u32x4*)d = pack8(acc[ai][0][m][0], acc[ai][0][m][1]); *(u32x4*)(d + 32) = pack8(acc[ai][1][m][0], acc[ai][1][m][1]); }
            } else {
                const f32x4 g0 = *(const f32x4*)(gain + hc0), g1 = *(const f32x4*)(gain + hc0 + 4), g2 = *(const f32x4*)(gain + 32 + hc0), g3 = *(const f32x4*)(gain + 36 + hc0);
#pragma unroll
                for (int ai = 0; ai < 2; ++ai)
#pragma unroll
                    for (int m = 0; m < 4; ++m) { const int row = row0 + ai * HALF + m * 16; const int t = row - rb;
                        f32x4 a0 = acc[ai][0][m][0], a1 = acc[ai][0][m][1], b0 = acc[ai][1][m][0], b1 = acc[ai][1][m][1];
                        const float ss = sum_rows4((dot4(a0) + dot4(a1)) + (dot4(b0) + dot4(b1)));
                        const float r = __builtin_amdgcn_rsqf(ss * (1.0f / 64.0f) + RMS_EPS) * scale;
                        a0 = a0 * r * g0; a1 = a1 * r * g1; b0 = b0 * r * g2; b1 = b1 * r * g3;
                        bf16_t* d = base + ((size_t)rb * nh + (size_t)h * L + t) * 64 + hc0;
                        *(u32x4*)d = pack8(a0, a1); *(u32x4*)(d + 32) = pack8(b0, b1); }
            }
        } else {
            const int col = (G - 40) * 64 + hc0;
#pragma unroll
            for (int ai = 0; ai < 2; ++ai)
#pragma unroll
                for (int m = 0; m < 4; ++m) { const int row = row0 + ai * HALF + m * 16; bf16_t* d = (bf16_t*)(ws + WS_MIX) + (size_t)row * DM + col;
                    *(u32x4*)d = pack8(silu4(acc[ai][0][m][0]), silu4(acc[ai][0][m][1])); *(u32x4*)(d + 32) = pack8(silu4(acc[ai][1][m][0]), silu4(acc[ai][1][m][1])); }
        }
    }
};
typedef EpiZT<7> EpiZ;
struct EpiMKV {
    static constexpr bool PERM = true, AFTER_DRAIN = false;
    bf16_t* km; const float* gmk;
    __device__ __forceinline__ void operator()(const f32x4 (&acc)[2][2][4][2], const Unit& u, int wr, int wc, int fr, int fq) const {
        const int G = u.pn * 4 + wc, hc0 = 8 * fq, h = G & 3; const bool isk = G < 4;
        const int row0 = u.pm * BM + wr * 64 + fr;
        bf16_t* basep = km + (isk ? (size_t)0 : (size_t)(WS_VM - WS_KM) / 2) + hc0;
        if (!isk) {
#pragma unroll
            for (int ai = 0; ai < 2; ++ai)
#pragma unroll
                for (int m = 0; m < 4; ++m) { const int row = row0 + ai * HALF + m * 16; const int bbm = row >> 8, j = row & 255;
                    bf16_t* d = basep + ((size_t)(bbm * NHM + h) * NMEM + j) * 64;
                    *(u32x4*)d = pack8(acc[ai][0][m][0], acc[ai][0][m][1]); *(u32x4*)(d + 32) = pack8(acc[ai][1][m][0], acc[ai][1][m][1]); }
        } else {
            const f32x4 g0 = *(const f32x4*)(gmk + hc0), g1 = *(const f32x4*)(gmk + hc0 + 4), g2 = *(const f32x4*)(gmk + 32 + hc0), g3 = *(const f32x4*)(gmk + 36 + hc0);
#pragma unroll
            for (int ai = 0; ai < 2; ++ai)
#pragma unroll
                for (int m = 0; m < 4; ++m) { const int row = row0 + ai * HALF + m * 16; const int bbm = row >> 8, j = row & 255;
                    f32x4 a0 = acc[ai][0][m][0], a1 = acc[ai][0][m][1], b0 = acc[ai][1][m][0], b1 = acc[ai][1][m][1];
                    const float ss = sum_rows4((dot4(a0) + dot4(a1)) + (dot4(b0) + dot4(b1)));
                    const float r = __builtin_amdgcn_rsqf(ss * (1.0f / 64.0f) + RMS_EPS);
                    a0 = a0 * r * g0; a1 = a1 * r * g1; b0 = b0 * r * g2; b1 = b1 * r * g3;
                    bf16_t* d = basep + ((size_t)(bbm * NHM + h) * NMEM + j) * 64;
                    *(u32x4*)d = pack8(a0, a1); *(u32x4*)(d + 32) = pack8(b0, b1); }
        }
    }
};
struct EpiOut {
    static constexpr bool PERM = false, AFTER_DRAIN = false;
    const bf16_t* xb; const float* rstd; float* out; float osc;
    __device__ __forceinline__ void operator()(const f32x4 (&acc)[2][2][4][2], const Unit& u, int wr, int wc, int fr, int fq) const {
        const int row0 = u.pm * BM + wr * 64 + fr, col0 = u.pn * BM + wc * 32 + 4 * fq;
        u32x2 w[2][4][2][2]; float rms[2][4];
#pragma unroll
        for (int ai = 0; ai < 2; ++ai)
#pragma unroll
            for (int m = 0; m < 4; ++m) { const int row = row0 + ai * HALF + m * 16; rms[ai][m] = rstd[row];
#pragma unroll
                for (int bj = 0; bj < 2; ++bj)
#pragma unroll
                    for (int n = 0; n < 2; ++n) w[ai][m][bj][n] = *(const u32x2*)(xb + (size_t)row * DM + col0 + bj * HALF + n * 16); }
#pragma unroll
        for (int ai = 0; ai < 2; ++ai)
#pragma unroll
            for (int m = 0; m < 4; ++m) { const int row = row0 + ai * HALF + m * 16; const float r = 1.0f / rms[ai][m]; const size_t ro = (size_t)row * DM + col0;
#pragma unroll
                for (int bj = 0; bj < 2; ++bj)
#pragma unroll
                    for (int n = 0; n < 2; ++n) { const u32x2 ww = w[ai][m][bj][n];
                        const f32x4 x0 = {__builtin_bit_cast(float, ww.x << 16), __builtin_bit_cast(float, ww.x & 0xffff0000u), __builtin_bit_cast(float, ww.y << 16), __builtin_bit_cast(float, ww.y & 0xffff0000u)};
                        *(f32x4*)(out + ro + bj * HALF + n * 16) = (x0 * r + acc[ai][bj][m][n]) * osc; } }
    }
};
struct EpiNull { static constexpr bool PERM = false, AFTER_DRAIN = false;
    __device__ __forceinline__ void operator()(const f32x4 (&acc)[2][2][4][2], const Unit& u, int wr, int wc, int fr, int fq) const {
#pragma unroll
        for (int ai = 0; ai < 2; ++ai)
#pragma unroll
            for (int m = 0; m < 4; ++m)
#pragma unroll
                for (int bj = 0; bj < 2; ++bj)
#pragma unroll
                    for (int n = 0; n < 2; ++n) asm volatile("" :: "v"(acc[ai][bj][m][n])); } };
struct EpiStoreOnly { static constexpr bool PERM = false, AFTER_DRAIN = false; float* out;
    __device__ __forceinline__ void operator()(const f32x4 (&acc)[2][2][4][2], const Unit& u, int wr, int wc, int fr, int fq) const {
        const int row0 = u.pm * BM + wr * 64 + fr, col0 = u.pn * BM + wc * 32 + 4 * fq; float* o = out + (size_t)row0 * DM;
#pragma unroll
        for (int ai = 0; ai < 2; ++ai)
#pragma unroll
            for (int m = 0; m < 4; ++m) { const size_t ro = (size_t)(ai * HALF + m * 16) * DM + col0;
#pragma unroll
                for (int bj = 0; bj < 2; ++bj)
#pragma unroll
                    for (int n = 0; n < 2; ++n) *(f32x4*)(o + ro + bj * HALF + n * 16) = acc[ai][bj][m][n]; } } };
}

__device__ __forceinline__ float wave_sum(float v) {
#pragma unroll
    for (int o = 1; o < 64; o <<= 1) v += __shfl_xor(v, o);
    return v;
}
__device__ __forceinline__ int head_perm(int n) { const int o = n & 255; return (n & ~255) + 128 * ((o >> 5) & 1) + 32 * (o >> 6) + (o & 31); }
template <bool HP, bool GAIN>
__device__ __forceinline__ void p0_transpose_item(const float* W, const float* gain, int K, int N, bf16* WT, LAS float* scr, int item, int lane) {
    const int nblk = N / 32, kb = item / nblk, nb = item % nblk, k0 = 64 * kb, n0 = 32 * nb;
    float wv[32], gv[32];
#pragma unroll
    for (int i = 0; i < 32; ++i) { const int kk = 2 * i + (lane >> 5); wv[i] = W[(size_t)(k0 + kk) * N + n0 + (lane & 31)]; gv[i] = GAIN ? gain[k0 + kk] : 1.0f; }
#pragma unroll
    for (int i = 0; i < 32; ++i) { const int kk = 2 * i + (lane >> 5); scr[kk * 33 + (lane & 31)] = GAIN ? wv[i] * gv[i] : wv[i]; }
    LDS_WAIT(); asm volatile("" ::: "memory");
    const int c = lane & 7;
#pragma unroll
    for (int j = 0; j < 4; ++j) { const int n = (lane >> 3) + 8 * j; const LAS float* s = scr + (8 * c) * 33 + n;
        v4u o; o.x = pk2(s[0 * 33], s[1 * 33]); o.y = pk2(s[2 * 33], s[3 * 33]); o.z = pk2(s[4 * 33], s[5 * 33]); o.w = pk2(s[6 * 33], s[7 * 33]);
        const int rowo = HP ? head_perm(n0 + n) : (n0 + n);
        *(GAS v4u*)(WT + (size_t)rowo * K + k0 + 8 * c) = o; }
    LDS_WAIT(); asm volatile("" ::: "memory");
}
template <int NR>
__device__ __forceinline__ void rms_rows_pipe(int lane, const float* src, bf16* dst, float* rstd_out, int g0, int gstep, int ng) {
    if (g0 >= ng) return;
    f32x4 v[NR][4], w[NR][4];
    { const GAS f32x4* xr = (const GAS f32x4*)(src + (size_t)g0 * NR * DM) + lane;
#pragma unroll
      for (int i = 0; i < NR; ++i)
#pragma unroll
          for (int j = 0; j < 4; ++j) v[i][j] = __builtin_nontemporal_load(xr + i * (DM / 4) + 64 * j); }
    for (int g = g0; g < ng; g += gstep) {
        const int gn = g + gstep < ng ? g + gstep : g;
        { const GAS f32x4* xr = (const GAS f32x4*)(src + (size_t)gn * NR * DM) + lane;
#pragma unroll
          for (int i = 0; i < NR; ++i)
#pragma unroll
              for (int j = 0; j < 4; ++j) w[i][j] = __builtin_nontemporal_load(xr + i * (DM / 4) + 64 * j); }
#pragma unroll
        for (int i = 0; i < NR; ++i) { float s = 0.f;
#pragma unroll
            for (int j = 0; j < 4; ++j) s += (v[i][j].x * v[i][j].x + v[i][j].y * v[i][j].y) + (v[i][j].z * v[i][j].z + v[i][j].w * v[i][j].w);
            const float rstd = 1.0f / sqrtf(wave_sum(s) * (1.f / DM) + RMS_EPS);
            if (rstd_out && lane == 0) rstd_out[(size_t)g * NR + i] = rstd;
            GAS unsigned long long* o8 = (GAS unsigned long long*)(dst + ((size_t)g * NR + i) * DM) + lane;
#pragma unroll
            for (int j = 0; j < 4; ++j) o8[64 * j] = (unsigned long long)pk2(v[i][j].x * rstd, v[i][j].y * rstd) | ((unsigned long long)pk2(v[i][j].z * rstd, v[i][j].w * rstd) << 32); }
#pragma unroll
        for (int i = 0; i < NR; ++i)
#pragma unroll
            for (int j = 0; j < 4; ++j) v[i][j] = w[i][j];
    }
}
__device__ __forceinline__ void h2_row(const Frame& F, int t, int L, float* h2) {
    const int j = F.lane;
    const int bi = j & 15;
    const float band = 1e-4f + (float)bi * ((15.0f - 1e-4f) / 15.0f);
    const float xarg = 2.0f * ((float)t * band) / (float)L;
    float sn, cs; sincospif(xarg, &sn, &cs);
    const float tt = (float)t / (float)(L - 1);
    float a = tt * F.fw1[j] + F.fb1[j];
#pragma unroll
    for (int i = 0; i < 16; ++i) { const float c = __shfl(cs, i), s = -__shfl(sn, i); a += c * F.fw1[(1 + i) * 64 + j] + s * F.fw1[(17 + i) * 64 + j]; }
    const float fr = F.ffreq[j];
    const float h1 = sinf(fr * a);
    float b = F.fb2[j];
#pragma unroll 8
    for (int i = 0; i < 64; ++i) b += __shfl(h1, i) * F.fw2[i * 64 + j];
    h2[(size_t)t * 64 + j] = sinf(fr * b);
}
__device__ __forceinline__ int t5_bucket_dev(int rel) {
    const int n = rel < 0 ? -rel : rel;
    int b = n < 8 ? n : n < 15 ? 8 : n < 27 ? 9 : n < 50 ? 10 : n < 91 ? 11 : n < 166 ? 12 : n < 305 ? 13 : n < 559 ? 14 : 15;
    return b + (rel > 0 ? 16 : 0);
}
__device__ __forceinline__ void p0_prologue(Frame& F) {
    LAS float* scr = (LAS float*)(F.lds + RING_OFF + F.wave * 16384);
    const int gw = F.vcu * NWAVES + F.wave, NGW = F.G * NWAVES;
    constexpr int I_IN = (DM / 64) * (DIN / 32), I_OUT = (DM / 64) * (DM / 32), I_MKV = (DM / 64) * (DMKV / 32);
    constexpr int NITEMS = I_IN + I_OUT + I_MKV;
    for (int it = gw; it < NITEMS; it += NGW) {
        int r = it;
        if (r < I_IN) { p0_transpose_item<true, true>(F.w_in, F.norm_in, DM, DIN, F.WTin, scr, r, F.lane); continue; } r -= I_IN;
        if (r < I_OUT) { p0_transpose_item<false, false>(F.w_out, nullptr, DM, DM, F.WTout, scr, r, F.lane); continue; } r -= I_OUT;
        p0_transpose_item<true, true>(F.w_mkv, F.mem_norm, DM, DMKV, F.WTmkv, scr, r, F.lane);
    }
    rms_rows_pipe<4>(F.lane, F.xp, F.XB, F.RSTD, gw, NGW, MP / 4);
    rms_rows_pipe<4>(F.lane, F.xs, F.XB + (size_t)MP * DM, F.RSTD + MP, gw, NGW, MS / 4);
    rms_rows_pipe<2>(F.lane, F.memp, F.MEMB, nullptr, gw, NGW, MMEM / 4);
    rms_rows_pipe<2>(F.lane, F.mems, F.MEMB + (size_t)(MMEM / 2) * DM, nullptr, gw, NGW, MMEM / 4);
    for (int t = gw; t < LP + LS; t += NGW) { if (t < LP) h2_row(F, t, LP, F.H2P); else h2_row(F, t - LP, LS, F.H2S); }
    if (gw == 1) { F.GAINS[F.lane] = F.gq[F.lane]; F.GAINS[64 + F.lane] = F.gk[F.lane]; F.GAINS[128 + F.lane] = F.gmq[F.lane]; F.GAINS[192 + F.lane] = F.gmk[F.lane]; }
    if (gw == 2) { float a = fabsf(F.gq[F.lane]), b = fabsf(F.gk[F.lane]), c = fabsf(F.gmq[F.lane]), d = fabsf(F.gmk[F.lane]);
        float e = fmaxf(fmaxf(fabsf(F.rel_bias[F.lane]), fabsf(F.rel_bias[64 + F.lane])), fabsf(F.rel_bias[128 + F.lane]));
#pragma unroll
        for (int o = 1; o < 64; o <<= 1) { a = fmaxf(a, __shfl_xor(a, o)); b = fmaxf(b, __shfl_xor(b, o)); c = fmaxf(c, __shfl_xor(c, o)); d = fmaxf(d, __shfl_xor(d, o)); e = fmaxf(e, __shfl_xor(e, o)); }
        if (F.lane == 0) { F.CONSTS[0] = (8.0f * a * b * 1.01f + e) * 1.4426950408889634f; F.CONSTS[1] = (8.0f * c * d * 1.01f) * 1.4426950408889634f; } }
    if (gw == 0) { for (int e = F.lane; e < 3 * NH * 129; e += 64) { const int c = e / (NH * 129), h = (e / 129) % NH, jj = e % 129; const int d = c == 0 ? 1 : c == 1 ? 4 : 16;
            F.BIAS[e] = F.rel_bias[t5_bucket_dev((jj - 64) * d) * NH + h]; } }
}

__device__ __forceinline__ int XI(int i) { return i + ((i >> 5) << 1); }
constexpr int NTW = 8192, NTWE = 512;
__device__ __forceinline__ cf2 root16(int k) {
    static constexpr float c[8] = {1.0f, 0.92387953251128674f, 0.70710678118654752f, 0.38268343236508977f, 0.0f, -0.38268343236508977f, -0.70710678118654752f, -0.92387953251128674f};
    static constexpr float s[8] = {0.0f, 0.38268343236508977f, 0.70710678118654752f, 0.92387953251128674f, 1.0f, 0.92387953251128674f, 0.70710678118654752f, 0.38268343236508977f};
    return (cf2){c[k], -s[k]};
}
__device__ __forceinline__ void root16_ri(int k, float& c, float& s) {
    const float cc[8] = {1.0f, 0.92387953251128674f, 0.70710678118654752f, 0.38268343236508977f, 0.0f, -0.38268343236508977f, -0.70710678118654752f, -0.92387953251128674f};
    const float ss[8] = {0.0f, 0.38268343236508977f, 0.70710678118654752f, 0.92387953251128674f, 1.0f, 0.92387953251128674f, 0.70710678118654752f, 0.38268343236508977f};
    c = cc[k]; s = -ss[k];
}
__device__ __forceinline__ cf2 c_add(cf2 a, cf2 b) { cf2 r; asm("v_pk_add_f32 %0, %1, %2" : "=v"(r) : "v"(a), "v"(b)); return r; }
__device__ __forceinline__ cf2 c_sub(cf2 a, cf2 b) { cf2 r; asm("v_pk_add_f32 %0, %1, %2 neg_lo:[0,1] neg_hi:[0,1]" : "=v"(r) : "v"(a), "v"(b)); return r; }
__device__ __forceinline__ cf2 c_sub_mi(cf2 a, cf2 b) { cf2 r; asm("v_pk_add_f32 %0, %1, %2 op_sel:[1,1] op_sel_hi:[0,0] neg_lo:[0,1] neg_hi:[1,0]" : "=v"(r) : "v"(a), "v"(b)); return r; }
__device__ __forceinline__ cf2 c_add_pi(cf2 a, cf2 b) { cf2 r; asm("v_pk_add_f32 %0, %1, %2 op_sel:[0,1] op_sel_hi:[1,0] neg_lo:[0,1]" : "=v"(r) : "v"(a), "v"(b)); return r; }
__device__ __forceinline__ cf2 c_sub_pi(cf2 a, cf2 b) { cf2 r; asm("v_pk_add_f32 %0, %1, %2 op_sel:[0,1] op_sel_hi:[1,0] neg_hi:[0,1]" : "=v"(r) : "v"(a), "v"(b)); return r; }
__device__ __forceinline__ cf2 c_mul(cf2 d, cf2 w) { cf2 r;
    asm("v_pk_mul_f32 %0, %1, %2 op_sel_hi:[0,1]\n\tv_pk_fma_f32 %0, %1, %2, %0 op_sel:[1,1,0] op_sel_hi:[1,0,1] neg_lo:[1,0,0]" : "=&v"(r) : "v"(d), "v"(w)); return r; }
__device__ __forceinline__ cf2 c_mulc(cf2 x, cf2 w) { cf2 r;
    asm("v_pk_mul_f32 %0, %1, %2 op_sel_hi:[0,1]\n\tv_pk_fma_f32 %0, %1, %2, %0 op_sel:[1,1,0] op_sel_hi:[1,0,1] neg_hi:[0,0,1]" : "=&v"(r) : "v"(x), "v"(w)); return r; }
template <int S, bool INV, bool T1ONE>
__device__ __forceinline__ void bfly(cf2 (&v)[1 << S], cf2 t1) {
    constexpr int R = 1 << S;
    cf2 tp[S]; tp[0] = t1;
    if (!T1ONE) {
#pragma unroll
        for (int s = 1; s < S; ++s) tp[s] = c_mul(tp[s - 1], tp[s - 1]); }
#pragma unroll
    for (int ss = 0; ss < S; ++ss) { const int s = INV ? S - 1 - ss : ss; const int half = R >> (s + 1);
        cf2 w[R / 2];
#pragma unroll
        for (int q = 0; q < half; ++q) { const int k16 = q * (8 / half);
            if (k16 == 0) w[q] = T1ONE ? (cf2){1.f, 0.f} : tp[s];
            else if (k16 == 4) w[q] = T1ONE ? (cf2){0.f, -1.f} : (cf2){tp[s].y, -tp[s].x};
            else w[q] = T1ONE ? root16(k16) : c_mul(tp[s], root16(k16)); }
#pragma unroll
        for (int r = 0; r < R; ++r) if ((r % (2 * half)) < half) { const int q = r % half, k16 = q * (8 / half);
            const cf2 u = v[r], x = v[r + half];
            if (!INV) {
                v[r] = c_add(u, x);
                if (T1ONE && k16 == 0) v[r + half] = c_sub(u, x);
                else if (T1ONE && k16 == 4) v[r + half] = c_sub_mi(u, x);
                else v[r + half] = c_mul(c_sub(u, x), w[q]);
            } else {
                if (T1ONE && k16 == 0) { v[r] = c_add(u, x); v[r + half] = c_sub(u, x); }
                else if (T1ONE && k16 == 4) { v[r] = c_add_pi(u, x); v[r + half] = c_sub_pi(u, x); }
                else { const cf2 y = c_mulc(x, w[q]); v[r] = c_add(u, y); v[r + half] = c_sub(u, y); }
            } } }
}
template <int S, int LSTR, bool INV, bool NOV = false>
__device__ __forceinline__ void fft_pass(LAS cf2* x, const LAS cf2* tw, int N, int tl, int NT) {
    constexpr int R = 1 << S, stride = 1 << LSTR;
    for (int g = tl; g < (N >> S); g += NT) {
        const int j0 = g & (stride - 1), base = ((g >> LSTR) << (LSTR + S)) + j0;
        cf2 v[R];
#pragma unroll
        for (int r = 0; r < R; ++r) v[r] = x[XI(base + r * stride)];
        if (!NOV) { if (LSTR == 0) bfly<S, INV, true>(v, (cf2){1.f, 0.f});
        else bfly<S, INV, false>(v, tw[j0 << (13 - S - LSTR)]); }
#pragma unroll
        for (int r = 0; r < R; ++r) x[XI(base + r * stride)] = v[r];
    }
}
#define WAVE_LDS_FENCE() asm volatile("s_waitcnt lgkmcnt(0)" ::: "memory")
template <int S, bool NOV = false>
__device__ __forceinline__ void fft_mid(LAS cf2* x, const cf2 (&kreg)[16], int N, int tl, int NT) {
    constexpr int R = 1 << S;
#pragma unroll
    for (int i = 0; i < 16 / R; ++i) { const int g = tl * (16 / R) + i;
        cf2 v[R];
#pragma unroll
        for (int r = 0; r < R; ++r) v[r] = x[XI(g * R) + r];
        if (!NOV) bfly<S, false, true>(v, (cf2){1.f, 0.f});
#pragma unroll
        for (int r = 0; r < R; ++r) v[r] = c_mul(v[r], kreg[i * R + r]);
        if (!NOV) bfly<S, true, true>(v, (cf2){1.f, 0.f});
#pragma unroll
        for (int r = 0; r < R; ++r) x[XI(g * R) + r] = v[r];
    }
}
template <int LOGN, bool NOV = false>
__device__ __forceinline__ void fft_conv(cf2 (&v)[16], LAS cf2* x, const LAS cf2* tw, const cf2* Kg, int tl) {
    constexpr int N = 1 << LOGN, NT = N >> 4;
    const cf2 t1 = tw[tl << (13 - LOGN)];
    if (!NOV) bfly<4, false, false>(v, t1);
    __syncthreads();
#pragma unroll
    for (int r = 0; r < 16; ++r) x[XI(tl + r * NT)] = v[r];
    cf2 kreg[16];
#pragma unroll
    for (int i = 0; i < 16; ++i) kreg[i] = Kg[tl * 16 + i];
    __syncthreads();
    fft_pass<4, LOGN - 8, false, NOV>(x, tw, N, tl, NT);
    WAVE_LDS_FENCE();
    if (LOGN == 13) { fft_pass<4, 1, false, NOV>(x, tw, N, tl, NT); WAVE_LDS_FENCE(); fft_mid<1, NOV>(x, kreg, N, tl, NT); WAVE_LDS_FENCE(); fft_pass<4, 1, true, NOV>(x, tw, N, tl, NT); }
    else { fft_mid<3, NOV>(x, kreg, N, tl, NT); }
    WAVE_LDS_FENCE();
    fft_pass<4, LOGN - 8, true, NOV>(x, tw, N, tl, NT);
    __syncthreads();
#pragma unroll
    for (int r = 0; r < 16; ++r) v[r] = x[XI(tl + r * NT)];
    if (!NOV) bfly<4, true, false>(v, t1);
}
template <int LOGN>
__device__ __forceinline__ void fft_fwd_store(cf2 (&v)[16], LAS cf2* x, const LAS cf2* tw, cf2* Kout, int tl) {
    constexpr int N = 1 << LOGN, NT = N >> 4;
    const cf2 t1 = tw[tl << (13 - LOGN)];
    bfly<4, false, false>(v, t1);
    __syncthreads();
#pragma unroll
    for (int r = 0; r < 16; ++r) x[XI(tl + r * NT)] = v[r];
    __syncthreads();
    fft_pass<4, LOGN - 8, false>(x, tw, N, tl, NT);
    if (LOGN == 13) { WAVE_LDS_FENCE(); fft_pass<4, 1, false>(x, tw, N, tl, NT); __syncthreads(); fft_pass<1, 0, false>(x, tw, N, tl, NT); }
    else { __syncthreads(); fft_pass<3, 0, false>(x, tw, N, tl, NT); }
    __syncthreads();
    for (int i = tl; i < N; i += NT) Kout[i] = x[XI(i)];
}
constexpr int FFT_XG = 8192 + 512;
constexpr int FFT_X = 0, FFT_TW = FFT_XG * 8, FFT_SCR = FFT_TW + NTWE * 8, FFT_SPK = FFT_SCR + 32768, FFT_AUX = FFT_SPK + 32768;
static_assert(FFT_AUX + 4096 <= LDSCTL_OFF, "FFT LDS map");
__device__ __forceinline__ void fft_init_tw(Frame& F) {
    LAS cf2* tw = (LAS cf2*)(F.lds + FFT_TW);
    for (int k = F.tid; k < NTWE; k += NWAVES * 64) { float s, c; sincospif((float)k * (2.0f / NTW), &s, &c); tw[k] = (cf2){c, -s}; }
    __syncthreads();
}
__device__ __forceinline__ cf2 root32(int r) {
    static constexpr float c[16] = {1.0f, 0.98078528040323043f, 0.92387953251128674f, 0.83146961230254524f, 0.70710678118654752f, 0.55557023301960218f, 0.38268343236508977f, 0.19509032201612825f,
                         0.0f, -0.19509032201612825f, -0.38268343236508977f, -0.55557023301960218f, -0.70710678118654752f, -0.83146961230254524f, -0.92387953251128674f, -0.98078528040323043f};
    static constexpr float s[16] = {0.0f, 0.19509032201612825f, 0.38268343236508977f, 0.55557023301960218f, 0.70710678118654752f, 0.83146961230254524f, 0.92387953251128674f, 0.98078528040323043f,
                         1.0f, 0.98078528040323043f, 0.92387953251128674f, 0.83146961230254524f, 0.70710678118654752f, 0.55557023301960218f, 0.38268343236508977f, 0.19509032201612825f};
    return (cf2){c[r], -s[r]};
}

__device__ __forceinline__ void split_bf16x8(const f32x4 x0, const f32x4 x1, bf16x8& hi, bf16x8& lo) {
    const float x[8] = {x0.x, x0.y, x0.z, x0.w, x1.x, x1.y, x1.z, x1.w};
    unsigned h[4], l[4];
#pragma unroll
    for (int i = 0; i < 4; ++i) { h[i] = pk2(x[2 * i], x[2 * i + 1]); l[i] = pk2(x[2 * i] - bflo(h[i]), x[2 * i + 1] - bfhi(h[i])); }
    hi = __builtin_bit_cast(bf16x8, (v4u){h[0], h[1], h[2], h[3]}); lo = __builtin_bit_cast(bf16x8, (v4u){l[0], l[1], l[2], l[3]});
}
__device__ __forceinline__ void filterA_phase(Frame& F) {
    constexpr int WP = 72;
    LAS bf16* wh = (LAS bf16*)(F.lds); LAS bf16* wl = wh + 64 * WP;
    const int NI = 80 * 12;
    for (int it = F.vcu; it < NI; it += F.G) {
        int tid = F.tid; asm volatile("" : "+v"(tid));
        const int lane = tid & 63, w = F.wave, n16 = lane & 15, g4 = lane >> 4;
        const int tt_ = it / 12, cc = it % 12; const bool prm = tt_ < 64; const int N = prm ? LP : LS, t0 = (prm ? tt_ : tt_ - 64) * 128 + 16 * w;
        const float* H2 = prm ? F.H2P : F.H2S; float* FB = prm ? F.FBP : F.FBS;
        const float* hr = H2 + (size_t)(t0 + n16) * 64 + 8 * g4;
        const f32x4 x00 = *(const f32x4*)(hr), x01 = *(const f32x4*)(hr + 4), x10 = *(const f32x4*)(hr + 32), x11 = *(const f32x4*)(hr + 36);
        float wv[8];
#pragma unroll
        for (int i = 0; i < 8; ++i) { const int e = tid + 512 * i; wv[i] = F.fw3[(size_t)(e >> 6) * 768 + cc * 64 + (e & 63)]; }
        __syncthreads();
#pragma unroll
        for (int i = 0; i < 8; ++i) { const int e = tid + 512 * i, k = e >> 6, c = e & 63; const unsigned h = f2bf(wv[i]); wh[c * WP + k] = (bf16)h; wl[c * WP + k] = (bf16)f2bf(wv[i] - __builtin_bit_cast(float, h << 16)); }
        __syncthreads();
        bf16x8 ah[2], al[2];
        split_bf16x8(x00, x01, ah[0], al[0]); split_bf16x8(x10, x11, ah[1], al[1]);
        const float tb = (float)(t0 + 4 * g4), rn = 1.0f / (float)(N - 1);
#pragma unroll
        for (int nt = 0; nt < 4; ++nt) {
            f32x4 acc = {0.f, 0.f, 0.f, 0.f};
#pragma unroll
            for (int s2 = 0; s2 < 2; ++s2) {
                const bf16x8 bh = *(const LAS bf16x8*)(wh + (nt * 16 + n16) * WP + 32 * s2 + 8 * g4), bl = *(const LAS bf16x8*)(wl + (nt * 16 + n16) * WP + 32 * s2 + 8 * g4);
                acc = __builtin_amdgcn_mfma_f32_16x16x32_bf16(ah[s2], bh, acc, 0, 0, 0);
                acc = __builtin_amdgcn_mfma_f32_16x16x32_bf16(ah[s2], bl, acc, 0, 0, 0);
                acc = __builtin_amdgcn_mfma_f32_16x16x32_bf16(al[s2], bh, acc, 0, 0, 0); }
            const int col = cc * 64 + nt * 16 + n16, c = col >= DHY ? col - DHY : col;
            const float delta = 3.0701134573253944f + (float)c * ((15.350567286626972f - 3.0701134573253944f) / 383.0f);
            f32x4 o;
#pragma unroll
            for (int j = 0; j < 4; ++j) { const float tt = (tb + (float)j) * rn; o[j] = acc[j] * expf(-tt * delta); }
            *(f32x4*)(FB + (size_t)col * N + t0 + 4 * g4) = o; }
    }
    __syncthreads();
}
template <int LOGN>
__device__ __forceinline__ void filter_item(Frame& F, int c, int gi, int tl, const float* FB, cf2* Kout) {
    constexpr int N = 1 << LOGN, NT = N >> 4;
    LAS cf2* x = (LAS cf2*)(F.lds + FFT_X) + gi * (N + N / 16);
    const LAS cf2* tw = (const LAS cf2*)(F.lds + FFT_TW);
    LAS float* red = (LAS float*)(F.lds + FFT_AUX + 2048) + gi * 16;
    const float* fwd = FB + (size_t)c * N; const float* bwd = FB + (size_t)(DHY + c) * N;
    float ka[16], kb[16]; float ss = 0.f;
#pragma unroll
    for (int r = 0; r < 16; ++r) { const int t = tl + r * NT; const float f = fwd[t], b = bwd[(N - t) & (N - 1)];
        ka[r] = (t == 0) ? f + b : f; kb[r] = (t == 0) ? 0.f : b; ss += ka[r] * ka[r] + kb[r] * kb[r]; }
    ss = wave_sum(ss);
    __syncthreads();
    if ((tl & 63) == 0) red[tl >> 6] = ss;
    __syncthreads();
    float tot = 0.f;
    for (int w = 0; w < NT / 64; ++w) tot += red[w];
    const float sc = (1.0f / sqrtf(tot + 1e-12f)) * (0.5f / (float)N);
    float sn, cs; sincospif((float)tl / (float)N, &sn, &cs); const cf2 wt = (cf2){cs, -sn};
    cf2 v[16];
#pragma unroll
    for (int r = 0; r < 16; ++r) v[r] = (cf2){(ka[r] + kb[r]) * sc, 0.f};
    fft_fwd_store<LOGN>(v, x, tw, Kout, tl);
#pragma unroll
    for (int r = 0; r < 16; ++r) v[r] = cmul(wt, root32(r)) * ((ka[r] - kb[r]) * sc);
    fft_fwd_store<LOGN>(v, x, tw, Kout + N, tl);
}
__device__ __forceinline__ void filter_phase(Frame& F) {
    fft_init_tw(F);
    const int NI = DHY + DHY / 4;
    for (int it = F.vcu; it < NI; it += F.G) {
        int tid = F.tid; asm volatile("" : "+v"(tid));
        if (it < DHY) filter_item<13>(F, it, 0, tid, F.FBP, F.KSP + (size_t)it * 2 * LP);
        else { const int gi = tid >> 7, c = (it - DHY) * 4 + gi; filter_item<11>(F, c, gi, tid & 127, F.FBS, F.KSS + (size_t)c * 2 * LS); }
    }
    __syncthreads();
}

__device__ __forceinline__ void conv3_16(const LAS bf16* row, int t0, int N, float w0, float w1, float w2, float b, float (&u)[16]) {
    const v4u a = *(const LAS v4u*)(row + t0), c = *(const LAS v4u*)(row + t0 + 8);
    float e[18];
    e[0] = bf2f(row[t0 > 0 ? t0 - 1 : 0]); e[17] = bf2f(row[t0 + 16 < N ? t0 + 16 : t0]);
    e[0] = t0 > 0 ? e[0] : 0.f; e[17] = t0 + 16 < N ? e[17] : 0.f;
    e[1] = bflo(a.x); e[2] = bfhi(a.x); e[3] = bflo(a.y); e[4] = bfhi(a.y); e[5] = bflo(a.z); e[6] = bfhi(a.z); e[7] = bflo(a.w); e[8] = bfhi(a.w);
    e[9] = bflo(c.x); e[10] = bfhi(c.x); e[11] = bflo(c.y); e[12] = bfhi(c.y); e[13] = bflo(c.z); e[14] = bfhi(c.z); e[15] = bflo(c.w); e[16] = bfhi(c.w);
#pragma unroll
    for (int k = 0; k < 16; ++k) u[k] = w0 * e[k] + w1 * e[k + 1] + w2 * e[k + 2] + b;
}
template <int LOGN, int MODE>
__device__ __forceinline__ void hyena_item(Frame& F, int c, int bb1, int bb2, int gi, int tl, const cf2* Kc) {
    constexpr int N = 1 << LOGN, NT = N >> 4;
    LAS cf2* x = (LAS cf2*)(F.lds + FFT_X) + gi * (N + N / 16);
    const LAS cf2* tw = (const LAS cf2*)(F.lds + FFT_TW);
    LAS bf16* R = (LAS bf16*)(F.lds + FFT_SCR) + gi * (4 * N);
    LAS unsigned* ysc = (LAS unsigned*)(F.lds + FFT_SCR) + gi * N + tl;
    LAS unsigned* spk = (LAS unsigned*)(F.lds + FFT_SPK) + gi * N + tl;
    const bf16* z1 = F.ZHY + (size_t)bb_rowbase(bb1) * 1152 + (size_t)c * N;
    const bf16* z2 = F.ZHY + (size_t)bb_rowbase(bb2) * 1152 + (size_t)c * N;
    const float* cw = F.conv_w; const float* cb = F.conv_b;
    float sn, cs; sincospif((float)tl / (float)N, &sn, &cs); const cf2 wt = (cf2){cs, -sn};
    const int t0 = 16 * tl;
    cf2 v[16];
    if (MODE & 1) {
    { v4u stg[8];
#pragma unroll
      for (int i = 0; i < 8; ++i) { const int id = tl + i * NT, row = id / (N / 8), ch = id % (N / 8);
          stg[i] = *(const GAS v4u*)(((row & 2) ? z2 : z1) + (size_t)((row & 1) ? 2 * DHY : DHY) * N + ch * 8); }
      __syncthreads();
#pragma unroll
      for (int i = 0; i < 8; ++i) { const int id = tl + i * NT, row = id / (N / 8), ch = id % (N / 8); *(LAS v4u*)(R + row * N + ch * 8) = stg[i]; } }
    __syncthreads();
    { const float a0 = cw[DHY + c], a1 = cw[1152 + DHY + c], a2 = cw[2304 + DHY + c], ab = cb[DHY + c];
      const float v0 = cw[2 * DHY + c], v1 = cw[1152 + 2 * DHY + c], v2 = cw[2304 + 2 * DHY + c], vb = cb[2 * DHY + c];
      float ua[16], ub[16]; LAS f32x4* xw = (LAS f32x4*)(x + XI(t0));
      conv3_16(R, t0, N, a0, a1, a2, ab, ua); conv3_16(R + N, t0, N, v0, v1, v2, vb, ub);
#pragma unroll
      for (int k = 0; k < 16; ++k) ua[k] *= ub[k];
      float uc[16];
      conv3_16(R + 2 * N, t0, N, a0, a1, a2, ab, uc); conv3_16(R + 3 * N, t0, N, v0, v1, v2, vb, ub);
#pragma unroll
      for (int k = 0; k < 16; ++k) uc[k] *= ub[k];
#pragma unroll
      for (int k = 0; k < 8; ++k) xw[k] = (f32x4){ua[2 * k], uc[2 * k], ua[2 * k + 1], uc[2 * k + 1]}; }
    __syncthreads();
#pragma unroll
    for (int r = 0; r < 16; ++r) { v[r] = x[XI(tl + r * NT)]; spk[r * NT] = pk2(v[r].x, v[r].y); }
    } else {
#pragma unroll
    for (int r = 0; r < 16; ++r) v[r] = (cf2){(float)(tl + r), 1.0f};
    }
    if (MODE & 2) {
    fft_conv<LOGN, (MODE & 8) != 0>(v, x, tw, Kc, tl);
#pragma unroll
    for (int r = 0; r < 16; ++r) ysc[r * NT] = pk2(v[r].x, v[r].y);
#pragma unroll
    for (int r = 0; r < 16; ++r) { const unsigned sw = spk[r * NT]; v[r] = c_mul((cf2){bflo(sw), bfhi(sw)}, c_mul(wt, root32(r))); }
    fft_conv<LOGN, (MODE & 8) != 0>(v, x, tw, Kc + N, tl);
    }
    if (MODE & 4) {
    cf2 wt2 = wt; asm volatile("" : "+v"(wt2));
    const float sk = F.skip[c];
    v4u stg0[4];
#pragma unroll
    for (int i = 0; i < 4; ++i) { const int id = tl + i * NT, row = id / (N / 8), ch = id % (N / 8); stg0[i] = *(const GAS v4u*)((row ? z2 : z1) + ch * 8); }
#pragma unroll
    for (int r = 0; r < 16; ++r) { const unsigned yw = ysc[r * NT], sw = spk[r * NT]; const cf2 z = (cf2){bflo(yw), bfhi(yw)} + c_mulc(v[r], c_mul(wt2, root32(r))); v[r] = (cf2){z.x + bflo(sw) * sk, z.y + bfhi(sw) * sk}; }
    __syncthreads();
#pragma unroll
    for (int r = 0; r < 16; ++r) x[XI(tl + r * NT)] = v[r];
#pragma unroll
    for (int i = 0; i < 4; ++i) { const int id = tl + i * NT, row = id / (N / 8), ch = id % (N / 8); *(LAS v4u*)(R + row * N + ch * 8) = stg0[i]; }
    __syncthreads();
    { const float x0w0 = cw[c], x0w1 = cw[1152 + c], x0w2 = cw[2304 + c], x0b = cb[c];
      float ua[16], uc[16]; const LAS f32x4* xr = (const LAS f32x4*)(x + XI(t0));
      conv3_16(R, t0, N, x0w0, x0w1, x0w2, x0b, ua); conv3_16(R + N, t0, N, x0w0, x0w1, x0w2, x0b, uc);
      v4u q1[2], q2[2];
#pragma unroll
      for (int k = 0; k < 8; ++k) { const f32x4 zz = xr[k]; const unsigned w1 = pk2(ua[2 * k] * zz.x, ua[2 * k + 1] * zz.z), w2 = pk2(uc[2 * k] * zz.y, uc[2 * k + 1] * zz.w);
          q1[k >> 2][k & 3] = w1; q2[k >> 2][k & 3] = w2; }
      GAS v4u* o1 = (GAS v4u*)(F.ZHY + (size_t)bb_rowbase(bb1) * 1152 + (size_t)c * N + t0);
      GAS v4u* o2 = (GAS v4u*)(F.ZHY + (size_t)bb_rowbase(bb2) * 1152 + (size_t)c * N + t0);
      if (MODE == 7) { o1[0] = q1[0]; o1[1] = q1[1]; o2[0] = q2[0]; o2[1] = q2[1]; } else asm volatile("" :: "v"(q1[0]), "v"(q1[1]), "v"(q2[0]), "v"(q2[1])); }
    } else {
#pragma unroll
    for (int r = 0; r < 16; ++r) asm volatile("" :: "v"(v[r].x), "v"(v[r].y));
    }
}
template <int MODE>
__device__ __forceinline__ void hyena_phase(Frame& F) {
    fft_init_tw(F);
    const int NI = DHY * 4 + DHY;
    for (int it = F.vcu; it < NI; it += F.G) {
        int tid = F.tid; asm volatile("" : "+v"(tid));
        if (it < DHY * 4) { const int c = it >> 2, bp = it & 3; hyena_item<13, MODE>(F, c, 2 * bp, 2 * bp + 1, 0, tid, F.KSP + (size_t)c * 2 * LP); }
        else { const int c = it - DHY * 4, gi = tid >> 7; hyena_item<11, MODE>(F, c, 8 + 2 * gi, 9 + 2 * gi, gi, tid & 127, F.KSS + (size_t)c * 2 * LS); }
    }
    __syncthreads();
}

constexpr int TP = 65;
__device__ __forceinline__ void combine_phase(Frame& F) {
    LAS float* Y = (LAS float*)(F.lds);
    const int NI = (MT / 128) * 6;
    for (int it = F.vcu; it < NI; it += F.G) {
        const int cg = it % 6, tile = it / 6; int bb, t0; row_to_bt(tile * 128, bb, t0); const int rb = bb_rowbase(bb), L = bb_len(bb);
        __syncthreads();
        const int tt = F.tid & 127, cq = F.tid >> 7;
        unsigned short cv[16]; v4u gv[2];
#pragma unroll
        for (int k = 0; k < 16; ++k) cv[k] = F.ZHY[(size_t)rb * 1152 + (size_t)(cg * 64 + cq * 16 + k) * L + t0 + tt];
#pragma unroll
        for (int j = 0; j < 2; ++j) { const int id = F.tid + j * NWAVES * 64; gv[j] = *(const GAS v4u*)(F.MIX + (size_t)(rb + t0 + (id >> 3)) * DM + cg * 64 + (id & 7) * 8); }
#pragma unroll
        for (int k = 0; k < 16; ++k) Y[tt * TP + cq * 16 + k] = bf2f(cv[k]);
        __syncthreads();
#pragma unroll
        for (int j = 0; j < 2; ++j) { const int id = F.tid + j * NWAVES * 64, i = id >> 3, ch8 = id & 7;
            GAS v4u* p = (GAS v4u*)(F.MIX + F.woff + (size_t)(rb + t0 + i) * DM + cg * 64 + ch8 * 8); const v4u g = gv[j]; const LAS float* y = Y + i * TP + ch8 * 8;
            v4u o; o.x = pk2(bflo(g.x) * y[0], bfhi(g.x) * y[1]); o.y = pk2(bflo(g.y) * y[2], bfhi(g.y) * y[3]); o.z = pk2(bflo(g.z) * y[4], bfhi(g.z) * y[5]); o.w = pk2(bflo(g.w) * y[6], bfhi(g.w) * y[7]);
            *p = o; }
    }
    __syncthreads();
}

typedef float f32x16 __attribute__((ext_vector_type(16)));
typedef short s16x4 __attribute__((ext_vector_type(4)));
constexpr int AT_K = 0;
constexpr int AT_V = 49152;
constexpr int AT_VH = 384 * 64 + 64;
constexpr int AT_B = AT_V + 2 * AT_VH;
constexpr int AT_L = AT_B + 20480;
constexpr int AT_O = AT_L + 1024;
static_assert(AT_O + 8192 <= LDSCTL_OFF && (AT_B % 16) == 0 && (AT_O % 16) == 0, "attention LDS map");
__device__ __forceinline__ int crow(int r, int hi) { return (r & 3) + 8 * (r >> 2) + 4 * hi; }
__device__ __forceinline__ s16x4 vtr(const LAS unsigned char* p) { typedef short v4i16_t __attribute__((ext_vector_type(4))); return __builtin_bit_cast(s16x4, __builtin_amdgcn_ds_read_tr16_b64_v4i16((LAS v4i16_t*)p)); }

template <int NK>
__device__ __forceinline__ void attn_stage_load(int tid, v4u (&kd)[NK / 64], v4u (&vd)[NK / 64], const bf16* Kg, const bf16* Vg, int idx0, int n, long tok0, int tstride) {
#pragma unroll
    for (int i = 0; i < NK / 64; ++i) { const int id = tid + i * NWAVES * 64, kk = id >> 3, c8 = id & 7; const int idx = idx0 + kk;
        const bool ok = idx >= 0 && idx < n; const size_t off = ok ? (size_t)(tok0 + (long)kk * tstride) * 64 + c8 * 8 : 0;
        kd[i] = *(const GAS v4u*)(Kg + off); vd[i] = *(const GAS v4u*)(Vg + off); }
}
template <int NK>
__device__ __forceinline__ void attn_stage_write(Frame& F, int tid, const v4u (&kd)[NK / 64], const v4u (&vd)[NK / 64], int idx0, int n) {
#pragma unroll
    for (int i = 0; i < NK / 64; ++i) { const int id = tid + i * NWAVES * 64, kk = id >> 3, c8 = id & 7; const int idx = idx0 + kk;
        const bool ok = idx >= 0 && idx < n; const v4u z = {0u, 0u, 0u, 0u};
        *(LAS v4u*)(F.lds + AT_K + kk * 128 + ((c8 ^ ((kk >> 1) & 7)) << 4)) = ok ? kd[i] : z;
        *(LAS v4u*)(F.lds + AT_V + (c8 >> 2) * AT_VH + kk * 64 + ((c8 & 3) << 4)) = ok ? vd[i] : z; }
}
__device__ __forceinline__ void attn_kread(const LAS unsigned char* lds, int T, int lane, bf16x8 (&kf)[4]) {
    const int ql = lane & 31, hi = lane >> 5; const LAS unsigned char* kp = lds + AT_K + (32 * T + ql) * 128; const int sw = (ql >> 1) & 7;
#pragma unroll
    for (int d0 = 0; d0 < 4; ++d0) kf[d0] = *(const LAS bf16x8*)(kp + (((2 * d0 + hi) ^ sw) << 4));
}
__device__ __forceinline__ void attn_vread(const LAS unsigned char* lds, int T, int lane, s16x4 (&vf)[8]) {
    const int hi = lane >> 5; const LAS unsigned char* vp = lds + AT_V + (32 * T + 4 * hi + ((lane & 15) >> 2)) * 64 + ((lane >> 4) & 1) * 32 + (lane & 3) * 8;
#pragma unroll
    for (int db = 0; db < 2; ++db)
#pragma unroll
        for (int q = 0; q < 4; ++q) vf[db * 4 + q] = vtr(vp + db * AT_VH + q * 512);
}
__device__ __forceinline__ void attn_tile(const LAS unsigned char* lds, int T, int Tn, const LAS unsigned char* bnext, bf16x8 (&kf)[4], f32x16& p, const bf16x8 (&qr)[4], bool bnd, int idxbase, int n, float& lsum, f32x16& o0, f32x16& o1, int lane) {
    const int hi = lane >> 5;
    __builtin_amdgcn_sched_barrier(0);
    s16x4 vf[8];
    attn_vread(lds, T, lane, vf);
#pragma unroll
    for (int d0 = 0; d0 < 4; ++d0) p = __builtin_amdgcn_mfma_f32_32x32x16_bf16(kf[d0], qr[d0], p, 0, 0, 0);
    if (Tn >= 0) attn_kread(lds, Tn, lane, kf);
    if (bnd) {
#pragma unroll
        for (int r = 0; r < 16; ++r) { const int idx = idxbase + crow(r, hi); if (idx < 0 || idx >= n) p[r] = -1e30f; } }
    float s = 0.f;
#pragma unroll
    for (int r = 0; r < 16; ++r) { p[r] = __builtin_amdgcn_exp2f(p[r]); s += p[r]; }
    lsum += s;
    u32x4 w0, w1;
    w0.x = pg8::cvt_pk_bf16(p[0], p[1]); w0.y = pg8::cvt_pk_bf16(p[2], p[3]); w0.z = pg8::cvt_pk_bf16(p[4], p[5]); w0.w = pg8::cvt_pk_bf16(p[6], p[7]);
    w1.x = pg8::cvt_pk_bf16(p[8], p[9]); w1.y = pg8::cvt_pk_bf16(p[10], p[11]); w1.z = pg8::cvt_pk_bf16(p[12], p[13]); w1.w = pg8::cvt_pk_bf16(p[14], p[15]);
    if (bnext) {
#pragma unroll
        for (int r4 = 0; r4 < 4; ++r4) { const f32x4 b = *(const LAS f32x4*)(bnext + (r4 * 64 + lane) * 16); p[4 * r4] = b.x; p[4 * r4 + 1] = b.y; p[4 * r4 + 2] = b.z; p[4 * r4 + 3] = b.w; } }
    const bf16x8 pa0 = __builtin_bit_cast(bf16x8, w0), pa1 = __builtin_bit_cast(bf16x8, w1);
    const bf16x8 v00 = (bf16x8){vf[0][0], vf[0][1], vf[0][2], vf[0][3], vf[1][0], vf[1][1], vf[1][2], vf[1][3]}, v01 = (bf16x8){vf[2][0], vf[2][1], vf[2][2], vf[2][3], vf[3][0], vf[3][1], vf[3][2], vf[3][3]};
    const bf16x8 v10 = (bf16x8){vf[4][0], vf[4][1], vf[4][2], vf[4][3], vf[5][0], vf[5][1], vf[5][2], vf[5][3]}, v11 = (bf16x8){vf[6][0], vf[6][1], vf[6][2], vf[6][3], vf[7][0], vf[7][1], vf[7][2], vf[7][3]};
    o0 = __builtin_amdgcn_mfma_f32_32x32x16_bf16(pa0, v00, o0, 0, 0, 0); o1 = __builtin_amdgcn_mfma_f32_32x32x16_bf16(pa0, v10, o1, 0, 0, 0);
    o0 = __builtin_amdgcn_mfma_f32_32x32x16_bf16(pa1, v01, o0, 0, 0, 0); o1 = __builtin_amdgcn_mfma_f32_32x32x16_bf16(pa1, v11, o1, 0, 0, 0);
}
template <int NTILES, bool BIAS>
__device__ __forceinline__ void attn_tiles(const LAS unsigned char* lds, int T0, const bf16x8 (&qr)[4], float cinit, bool bnd, int idxbase0, int n, float& lsum, f32x16& o0, f32x16& o1, int lane) {
    const int hi = lane >> 5;
    bf16x8 kf[4]; f32x16 p[2];
#define AT_PINIT(P, TAU) do { if (BIAS) { _Pragma("unroll") for (int r4 = 0; r4 < 4; ++r4) { const f32x4 b_ = *(const LAS f32x4*)(lds + AT_B + (TAU) * 4096 + (r4 * 64 + lane) * 16); \
        P[4 * r4] = b_.x; P[4 * r4 + 1] = b_.y; P[4 * r4 + 2] = b_.z; P[4 * r4 + 3] = b_.w; } } else { _Pragma("unroll") for (int r = 0; r < 16; ++r) P[r] = cinit; } } while (0)
    attn_kread(lds, T0, lane, kf);
    AT_PINIT(p[0], 0);
#pragma unroll
    for (int d0 = 0; d0 < 4; ++d0) p[0] = __builtin_amdgcn_mfma_f32_32x32x16_bf16(kf[d0], qr[d0], p[0], 0, 0, 0);
    if (NTILES > 1) { attn_kread(lds, T0 + 1, lane, kf); AT_PINIT(p[1], 1); }
#pragma unroll
    for (int tau = 0; tau < NTILES; ++tau) {
        f32x16& pc = p[tau & 1]; f32x16& pn = p[(tau + 1) & 1];
        __builtin_amdgcn_sched_barrier(0);
        s16x4 vf[8];
        attn_vread(lds, T0 + tau, lane, vf);
        if (tau + 1 < NTILES) {
#pragma unroll
            for (int d0 = 0; d0 < 4; ++d0) pn = __builtin_amdgcn_mfma_f32_32x32x16_bf16(kf[d0], qr[d0], pn, 0, 0, 0);
            if (tau + 2 < NTILES) attn_kread(lds, T0 + tau + 2, lane, kf);
        }
        __builtin_amdgcn_sched_barrier(0);
        if (bnd) { const int idxbase = idxbase0 + 32 * tau;
#pragma unroll
            for (int r = 0; r < 16; ++r) { const int idx = idxbase + crow(r, hi); if (idx < 0 || idx >= n) pc[r] = -1e30f; } }
        float s = 0.f;
#pragma unroll
        for (int r = 0; r < 16; ++r) { pc[r] = __builtin_amdgcn_exp2f(pc[r]); s += pc[r]; }
        lsum += s;
        u32x4 w0, w1;
        w0.x = pg8::cvt_pk_bf16(pc[0], pc[1]); w0.y = pg8::cvt_pk_bf16(pc[2], pc[3]); w0.z = pg8::cvt_pk_bf16(pc[4], pc[5]); w0.w = pg8::cvt_pk_bf16(pc[6], pc[7]);
        w1.x = pg8::cvt_pk_bf16(pc[8], pc[9]); w1.y = pg8::cvt_pk_bf16(pc[10], pc[11]); w1.z = pg8::cvt_pk_bf16(pc[12], pc[13]); w1.w = pg8::cvt_pk_bf16(pc[14], pc[15]);
        if (tau + 2 < NTILES) AT_PINIT(pc, tau + 2);
        const bf16x8 pa0 = __builtin_bit_cast(bf16x8, w0), pa1 = __builtin_bit_cast(bf16x8, w1);
        const bf16x8 v00 = (bf16x8){vf[0][0], vf[0][1], vf[0][2], vf[0][3], vf[1][0], vf[1][1], vf[1][2], vf[1][3]}, v01 = (bf16x8){vf[2][0], vf[2][1], vf[2][2], vf[2][3], vf[3][0], vf[3][1], vf[3][2], vf[3][3]};
        const bf16x8 v10 = (bf16x8){vf[4][0], vf[4][1], vf[4][2], vf[4][3], vf[5][0], vf[5][1], vf[5][2], vf[5][3]}, v11 = (bf16x8){vf[6][0], vf[6][1], vf[6][2], vf[6][3], vf[7][0], vf[7][1], vf[7][2], vf[7][3]};
        o0 = __builtin_amdgcn_mfma_f32_32x32x16_bf16(pa0, v00, o0, 0, 0, 0); o1 = __builtin_amdgcn_mfma_f32_32x32x16_bf16(pa0, v10, o1, 0, 0, 0);
        o0 = __builtin_amdgcn_mfma_f32_32x32x16_bf16(pa1, v01, o0, 0, 0, 0); o1 = __builtin_amdgcn_mfma_f32_32x32x16_bf16(pa1, v11, o1, 0, 0, 0);
    }
#undef AT_PINIT
}
struct DilUnit { int bb, h, c, rho, i0, n, d, rb, L; size_t hb; };
__device__ __forceinline__ DilUnit dil_decode(int it) {
    DilUnit u;
    if (it < 4608) { const int g = it >> 5, q = it & 31; u.bb = g / 18; u.h = (g / 3) % 6; u.c = g % 3; u.n = LP >> (2 * u.c); const int nb = u.n >> 8; u.rho = q / nb; u.i0 = (q % nb) << 8; }
    else { const int r = it - 4608, g = r >> 5, q = r & 31; u.bb = 8 + g / 6; u.h = g % 6;
        if (q < 8) { u.c = 0; u.n = LS; u.rho = 0; u.i0 = q << 8; } else if (q < 16) { u.c = 1; u.n = LS / 4; u.rho = (q - 8) >> 1; u.i0 = ((q - 8) & 1) << 8; } else { u.c = 2; u.n = LS / 16; u.rho = q - 16; u.i0 = 0; } }
    u.d = 1 << (2 * u.c); u.rb = bb_rowbase(u.bb); u.L = bb_len(u.bb); u.hb = ((size_t)u.rb * NH + (size_t)u.h * u.L) * 64;
    return u;
}
__device__ __forceinline__ void dil_prefetch(Frame& F, int tid, const DilUnit& u, v4u (&kd)[6], v4u (&vd)[6], bf16x8 (&qr)[4]) {
    attn_stage_load<384>(tid, kd, vd, F.K + u.hb, F.V + u.hb, u.i0 - 64, u.n, (long)u.rho + (long)u.d * (u.i0 - 64), u.d);
    const int ql = tid & 31, hi = (tid >> 5) & 1; const bool wact = u.i0 + 32 * F.wave < u.n;
    const bf16* qp = F.Q + u.hb + (size_t)(u.rho + u.d * (wact ? u.i0 + 32 * F.wave + ql : 0)) * 64 + 8 * hi;
#pragma unroll
    for (int d0 = 0; d0 < 4; ++d0) qr[d0] = *(const GAS bf16x8*)(qp + 16 * d0);
}
template <int MODE>
__device__ __forceinline__ void attn_dilated_phase(Frame& F) {
#ifndef DIL_WGS
#define DIL_WGS 0
#endif
    const int GA = DIL_WGS ? DIL_WGS : F.G;
    const int NU = 6144, ub = F.vcu < GA ? (int)(((long)F.vcu * NU) / GA) : 0, ue = F.vcu < GA ? (int)(((long)(F.vcu + 1) * NU) / GA) : 0;
    const int w = F.wave;
    const float cshift = F.CONSTS[0];
    int prev_ch = -1;
    v4u kd[6], vd[6]; bf16x8 qn[4];
    if (!(MODE & 1)) {
#pragma unroll
        for (int i = 0; i < 6; ++i) { kd[i] = (v4u){0u, 0u, 0u, 0u}; vd[i] = kd[i]; }
#pragma unroll
        for (int i = 0; i < 4; ++i) qn[i] = (bf16x8){0, 0, 0, 0, 0, 0, 0, 0}; }
    if ((MODE & 1) && ub < ue) { const DilUnit u0 = dil_decode(ub); dil_prefetch(F, F.tid, u0, kd, vd, qn); }
    for (int it = ub; it < ue; ++it) {
        int tid = F.tid; asm volatile("" : "+v"(tid));
        const int lane = tid & 63, ql = lane & 31, hi = lane >> 5;
        const DilUnit u = dil_decode(it);
        const int c = u.c, h = u.h, rho = u.rho, i0 = u.i0, n = u.n, d = u.d, rb = u.rb;
        __syncthreads();
        if (c * 8 + h != prev_ch) { prev_ch = c * 8 + h; const float* bias = F.BIAS + (c * NH + h) * 129;
            for (int e = tid; e < 5 * 16 * 64; e += NWAVES * 64) { const int tau = e >> 10, r = (e >> 6) & 15, ln = e & 63; const int rel = 32 * tau + crow(r, ln >> 5) - 64 - (ln & 31);
                const float v = (rel >= -64 && rel <= 64) ? bias[rel + 64] * 1.4426950408889634f - cshift : -1e30f;
                ((LAS float*)(F.lds + AT_B))[((tau * 4 + (r >> 2)) * 64 + ln) * 4 + (r & 3)] = v; } }
        if (MODE & 1) attn_stage_write<384>(F, tid, kd, vd, i0 - 64, n);
        bf16x8 qr[4];
#pragma unroll
        for (int d0 = 0; d0 < 4; ++d0) qr[d0] = qn[d0];
        __syncthreads();
        if ((MODE & 1) && it + 1 < ue) { const DilUnit un = dil_decode(it + 1); dil_prefetch(F, tid, un, kd, vd, qn); }
        const bool wact = i0 + 32 * w < n;
        const int qi = i0 + 32 * w + ql;
        if (wact) {
            f32x16 o0, o1;
#pragma unroll
            for (int r = 0; r < 16; ++r) { o0[r] = 0.f; o1[r] = 0.f; }
            float lsum = 0.f;
            const bool bnd = (i0 == 0) || (i0 + 256 + 64 > n);
            if (MODE & 2) attn_tiles<5, true>(F.lds, w, qr, 0.f, bnd, i0 - 64 + 32 * w, n, lsum, o0, o1, lane);
            lsum += __shfl_xor(lsum, 32);
            LAS bf16* ost = (LAS bf16*)(F.lds + AT_O) + w * 512;
            bf16* ocp = F.OC + ((size_t)c * MT + rb) * DHY + h * 64 + (lane & 7) * 8;
            if (!(MODE & 4)) { asm volatile("" :: "v"(o0), "v"(o1), "v"(lsum)); }
            if (MODE & 4)
#pragma unroll
            for (int g = 0; g < 4; ++g) {
#pragma unroll
                for (int j = 0; j < 4; ++j) { ost[(4 * hi + j) * 64 + ql] = (bf16)f2bf(o0[4 * g + j]); ost[(4 * hi + j) * 64 + 32 + ql] = (bf16)f2bf(o1[4 * g + j]); }
                asm volatile("s_waitcnt lgkmcnt(0)" ::: "memory");
                const v4u ov = *(const LAS v4u*)(ost + (lane >> 3) * 64 + (lane & 7) * 8);
                asm volatile("s_waitcnt lgkmcnt(0)" ::: "memory");
                const size_t tok = (size_t)(rho + d * (i0 + 32 * w + 8 * g + (lane >> 3)));
                if (MODE == 7) *(GAS v4u*)(ocp + tok * DHY) = ov; else asm volatile("" :: "v"(ov)); }
            if (MODE == 7 && hi == 0) F.LC[((size_t)c * MT + rb + rho + d * qi) * NH + h] = lsum;
        }
    }
    __syncthreads();
}
struct MemUnit { int bb, hm, rb, L, t0; };
__device__ __forceinline__ MemUnit mem_decode(int it, int w) {
    MemUnit u; int blk;
    if (it < 1024) { u.bb = it >> 7; u.hm = (it >> 5) & 3; blk = it & 31; } else { const int r = it - 1024; u.bb = 8 + (r >> 5); u.hm = (r >> 3) & 3; blk = r & 7; }
    u.rb = bb_rowbase(u.bb); u.L = bb_len(u.bb); u.t0 = blk * 256 + 32 * w; return u;
}
__device__ __forceinline__ void attn_memory_phase(Frame& F) {
    const int NU = 1280, ub = (int)(((long)F.vcu * NU) / F.G), ue = (int)(((long)(F.vcu + 1) * NU) / F.G);
    const int lane = F.lane, ql = lane & 31, hi = lane >> 5, w = F.wave;
    const float cshift = F.CONSTS[1];
    int prev = -1;
    bf16x8 qn[4];
    if (ub < ue) { const MemUnit u0 = mem_decode(ub, w); const bf16* qp = F.MQ + ((size_t)u0.rb * NHM + (size_t)u0.hm * u0.L + u0.t0 + ql) * 64 + 8 * hi;
#pragma unroll
        for (int d0 = 0; d0 < 4; ++d0) qn[d0] = *(const GAS bf16x8*)(qp + 16 * d0); }
    for (int it = ub; it < ue; ++it) {
        const MemUnit u = mem_decode(it, w); const int bb = u.bb, hm = u.hm, rb = u.rb, t0 = u.t0;
        if (bb * 4 + hm != prev) { prev = bb * 4 + hm;
            const size_t mb = (size_t)(bb * NHM + hm) * NMEM * 64;
            v4u kd[4], vd[4];
            attn_stage_load<256>(F.tid, kd, vd, F.KM + mb, F.VM + mb, 0, 256, 0, 1);
            __syncthreads();
            attn_stage_write<256>(F, F.tid, kd, vd, 0, 256);
            __syncthreads(); }
        bf16x8 qr[4];
#pragma unroll
        for (int d0 = 0; d0 < 4; ++d0) qr[d0] = qn[d0];
        bf16* mp = F.MIX + (size_t)(rb + t0 + (lane >> 3)) * DM + 2 * DHY + hm * 64 + (lane & 7) * 8;
        v4u gv[4];
#pragma unroll
        for (int g = 0; g < 4; ++g) gv[g] = *(const GAS v4u*)(mp + (size_t)(8 * g) * DM);
        if (it + 1 < ue) { const MemUnit un = mem_decode(it + 1, w); const bf16* qp = F.MQ + ((size_t)un.rb * NHM + (size_t)un.hm * un.L + un.t0 + ql) * 64 + 8 * hi;
#pragma unroll
            for (int d0 = 0; d0 < 4; ++d0) qn[d0] = *(const GAS bf16x8*)(qp + 16 * d0); }
        f32x16 o0, o1;
#pragma unroll
        for (int r = 0; r < 16; ++r) { o0[r] = 0.f; o1[r] = 0.f; }
        float lsum = 0.f;
        attn_tiles<8, false>(F.lds, 0, qr, -cshift, false, 0, 256, lsum, o0, o1, lane);
        lsum += __shfl_xor(lsum, 32);
        LAS float* lsc = (LAS float*)(F.lds + AT_L) + w * 32;
        if (hi == 0) lsc[ql] = lsum;
        asm volatile("s_waitcnt lgkmcnt(0)" ::: "memory");
        LAS bf16* ost = (LAS bf16*)(F.lds + AT_O) + w * 512;
#pragma unroll
        for (int g = 0; g < 4; ++g) {
#pragma unroll
            for (int j = 0; j < 4; ++j) { const float inv = 1.0f / lsc[8 * g + 4 * hi + j]; ost[(4 * hi + j) * 64 + ql] = (bf16)f2bf(o0[4 * g + j] * inv); ost[(4 * hi + j) * 64 + 32 + ql] = (bf16)f2bf(o1[4 * g + j] * inv); }
            asm volatile("s_waitcnt lgkmcnt(0)" ::: "memory");
            const v4u ov = *(const LAS v4u*)(ost + (lane >> 3) * 64 + (lane & 7) * 8);
            asm volatile("s_waitcnt lgkmcnt(0)" ::: "memory");
            const v4u gg = gv[g]; v4u q;
            q.x = pk2(bflo(gg.x) * bflo(ov.x), bfhi(gg.x) * bfhi(ov.x)); q.y = pk2(bflo(gg.y) * bflo(ov.y), bfhi(gg.y) * bfhi(ov.y));
            q.z = pk2(bflo(gg.z) * bflo(ov.z), bfhi(gg.z) * bfhi(ov.z)); q.w = pk2(bflo(gg.w) * bflo(ov.w), bfhi(gg.w) * bfhi(ov.w));
            *(GAS v4u*)(mp + F.woff + (size_t)(8 * g) * DM) = q; }
    }
    __syncthreads();
}
struct ACLoad { v4u x0, x1, x2, g; float l0, l1, l2; };
__device__ __forceinline__ ACLoad ac_load(const bf16* OC, const float* LC, const bf16* MIX, long id) {
    const int m = (int)(id / 48), ch = (int)(id % 48), h = ch >> 3; ACLoad r;
    r.x0 = *(const GAS v4u*)(OC + (size_t)m * DHY + ch * 8); r.x1 = *(const GAS v4u*)(OC + ((size_t)MT + m) * DHY + ch * 8); r.x2 = *(const GAS v4u*)(OC + ((size_t)2 * MT + m) * DHY + ch * 8);
    r.l0 = LC[(size_t)m * NH + h]; r.l1 = LC[((size_t)MT + m) * NH + h]; r.l2 = LC[((size_t)2 * MT + m) * NH + h];
    r.g = *(const GAS v4u*)(MIX + (size_t)m * DM + DHY + ch * 8); return r;
}
__device__ __forceinline__ void attn_combine_phase(Frame& F) {
    const long NT8 = (long)MT * 48, stride = (long)F.G * (NWAVES * 64);
    long id = (long)F.vcu * (NWAVES * 64) + F.tid;
    if (id >= NT8) return;
    ACLoad cur = ac_load(F.OC, F.LC, F.MIX, id);
    for (; id < NT8; id += stride) {
        const long nx = id + stride < NT8 ? id + stride : id;
        const ACLoad nxt = ac_load(F.OC, F.LC, F.MIX, nx);
        const int m = (int)(id / 48), ch = (int)(id % 48);
        const float inv = 1.0f / (cur.l0 + cur.l1 + cur.l2);
        float o[8];
        o[0] = bflo(cur.x0.x) + bflo(cur.x1.x) + bflo(cur.x2.x); o[1] = bfhi(cur.x0.x) + bfhi(cur.x1.x) + bfhi(cur.x2.x); o[2] = bflo(cur.x0.y) + bflo(cur.x1.y) + bflo(cur.x2.y); o[3] = bfhi(cur.x0.y) + bfhi(cur.x1.y) + bfhi(cur.x2.y);
        o[4] = bflo(cur.x0.z) + bflo(cur.x1.z) + bflo(cur.x2.z); o[5] = bfhi(cur.x0.z) + bfhi(cur.x1.z) + bfhi(cur.x2.z); o[6] = bflo(cur.x0.w) + bflo(cur.x1.w) + bflo(cur.x2.w); o[7] = bfhi(cur.x0.w) + bfhi(cur.x1.w) + bfhi(cur.x2.w);
        const v4u g = cur.g; v4u q;
        q.x = pk2(bflo(g.x) * o[0] * inv, bfhi(g.x) * o[1] * inv); q.y = pk2(bflo(g.y) * o[2] * inv, bfhi(g.y) * o[3] * inv);
        q.z = pk2(bflo(g.z) * o[4] * inv, bfhi(g.z) * o[5] * inv); q.w = pk2(bflo(g.w) * o[6] * inv, bfhi(g.w) * o[7] * inv);
        *(GAS v4u*)(F.MIX + F.woff + (size_t)m * DM + DHY + ch * 8) = q;
        cur = nxt;
    }
}

#define DUP_SEL_UNUSED 0
#ifndef TS_I
#define TS_I -1
#define TS_J -1
#endif
struct Args { const float* in[23]; float* out; unsigned char* ws; int ph_lo, ph_hi, li, pad; };
__global__ void __launch_bounds__(NWAVES * 64, 2) hymba_fwd(Args args) {
    extern __shared__ __attribute__((aligned(16))) unsigned char lds[];
    Frame F;
    F.lds = (LAS unsigned char*)lds;
    F.MISC = (volatile LAS unsigned*)(F.lds + MISC_OFF);
    F.tid = threadIdx.x; F.lane = F.tid & 63; F.wave = __builtin_amdgcn_readfirstlane(F.tid >> 6);
    F.G = gridDim.x; { const int bx = blockIdx.x; F.vcu = (F.G % 8 == 0) ? (bx % 8) * (F.G / 8) + bx / 8 : bx; }
    unsigned char* ws = args.ws;
    F.ctl = (gu32*)(ws + WS_CTL);
    F.xp = args.in[0]; F.xs = args.in[1]; F.memp = args.in[2]; F.mems = args.in[3]; F.norm_in = args.in[4]; F.w_in = args.in[5]; F.conv_w = args.in[6]; F.conv_b = args.in[7];
    F.fw1 = args.in[8]; F.fb1 = args.in[9]; F.ffreq = args.in[10]; F.fw2 = args.in[11]; F.fb2 = args.in[12]; F.fw3 = args.in[13]; F.skip = args.in[14]; F.gq = args.in[15]; F.gk = args.in[16];
    F.mem_norm = args.in[17]; F.w_mkv = args.in[18]; F.gmq = args.in[19]; F.gmk = args.in[20]; F.w_out = args.in[21]; F.rel_bias = args.in[22]; F.out = args.out;
    F.WTin = (bf16*)(ws + WS_WTIN); F.WTout = (bf16*)(ws + WS_WTOUT); F.WTmkv = (bf16*)(ws + WS_WTMKV); F.MEMB = (bf16*)(ws + WS_MEMB); F.KM = (bf16*)(ws + WS_KM); F.VM = (bf16*)(ws + WS_VM);
    F.XB = (bf16*)(ws + WS_XB); F.ST = (bf16*)(ws + WS_ST); F.CT = (bf16*)(ws + WS_CT); F.ZHY = (bf16*)(ws + WS_ZHY); F.Q = (bf16*)(ws + WS_Q); F.K = (bf16*)(ws + WS_K); F.V = (bf16*)(ws + WS_V);
    F.MQ = (bf16*)(ws + WS_MQ); F.MIX = (bf16*)(ws + WS_MIX); F.woff = 0; F.H2P = (float*)(ws + WS_H2P); F.H2S = (float*)(ws + WS_H2S); F.BIAS = (float*)(ws + WS_BIAS); F.GAINS = (float*)(ws + WS_GAINS); F.CONSTS = (float*)(ws + WS_CONSTS); F.RSTD = (float*)(ws + WS_RSTD); F.LC = (float*)(ws + WS_LC); F.OC = (bf16*)(ws + WS_OC); F.FBP = (float*)(ws + WS_OC); F.FBS = (float*)(ws + WS_OC + 24 * MiB);
    F.KSP = (cf2*)(ws + WS_KSP); F.KSS = (cf2*)(ws + WS_KSS);
    for (int u = F.tid; u < (LDS_BYTES - LDSCTL_OFF) / 4; u += NWAVES * 64) ((LAS unsigned*)(F.lds + LDSCTL_OFF))[u] = 0u;
    __syncthreads();
    XcdBarrier bar; bar.bar = (unsigned*)(F.ctl + CW_BAR); bar.x = 0; bar.st = nullptr;
    if (N_LAUNCHES != PER_PHASE) bar = xcd_barrier_post((unsigned*)(F.ctl + CW_BAR), F.MISC + 8);
#define GRID_BAR(seam) do { if (N_LAUNCHES == PER_PHASE) { if (F.tid == 0) __hip_atomic_store(F.ctl + CW_TMO, 0xBADBA0u | (unsigned)(seam), RLX_AGENT); } else { xcd_barrier(bar); } } while (0)
    const int lo = args.ph_lo, hi = args.ph_hi;
    unsigned long long* const tsb = (unsigned long long*)(ws + WS_CTL + 524288);
#define STAMP(k) do { if (TS_I >= 0 && blockIdx.x == 0 && F.tid == 0) __hip_atomic_store(tsb + (k), rt(), RLX_AGENT); } while (0)
    STAMP(0);
#ifndef PH_MASK
#define PH_MASK 63
#endif
#define IN(k) (((PH_MASK >> (k)) & 1) && lo <= (k) && (k) < hi)
#define BOTH(k) (IN(k) && IN((k) + 1))

    if (IN(0)) { p0_prologue(F); if (DUP_SEL == 30) p0_prologue(F); STAMP(1); if (BOTH(0)) GRID_BAR(0); STAMP(2); if (DUP_SEL == 20) { for (int k = 0; k < 10; ++k) GRID_BAR(0); } }
    if (IN(1)) {
#ifndef NO_G1
        { pg8::Gemm g{F.XB, F.WTin, MT, DIN, DM}; pg8::StaticOrder S; S.init(MT, DIN, F.G, (int)blockIdx.x);
          pg8::EpiZ E{args.ws, F.GAINS};
          static_assert(WS_V - WS_K == WS_K - WS_Q, "Q | K | V equally spaced");
          pg8::gemm_phase<pg8::EpiZ, pg8::StaticOrder, true, true>(F.lds + RING_OFF, g, S, E);
          if (DUP_SEL == 10) pg8::gemm_phase<pg8::EpiZ, pg8::StaticOrder, true, true>(F.lds + RING_OFF, g, S, E);
          if (DUP_SEL == 11) { pg8::EpiZT<0> E1{args.ws, F.GAINS}; pg8::gemm_phase<pg8::EpiZT<0>, pg8::StaticOrder, true, true>(F.lds + RING_OFF, g, S, E1); }
          if (DUP_SEL == 12) { pg8::EpiZT<1> E1{args.ws, F.GAINS}; pg8::gemm_phase<pg8::EpiZT<1>, pg8::StaticOrder, true, true>(F.lds + RING_OFF, g, S, E1); }
          if (DUP_SEL == 13) { pg8::EpiZT<2> E1{args.ws, F.GAINS}; pg8::gemm_phase<pg8::EpiZT<2>, pg8::StaticOrder, true, true>(F.lds + RING_OFF, g, S, E1); }
          if (DUP_SEL == 14) { pg8::EpiZT<4> E1{args.ws, F.GAINS}; pg8::gemm_phase<pg8::EpiZT<4>, pg8::StaticOrder, true, true>(F.lds + RING_OFF, g, S, E1); } }
#endif
        STAMP(3);
#ifndef NO_MKV
        { pg8::Gemm g{F.MEMB, F.WTmkv, MMEM, DMKV, DM}; pg8::StaticOrder S; S.init(MMEM, DMKV, F.G, (int)((blockIdx.x + F.G / 2) % F.G));
          pg8::EpiMKV E{F.KM, F.GAINS + 192};
          pg8::gemm_phase<pg8::EpiMKV, pg8::StaticOrder, true, true>(F.lds + RING_OFF, g, S, E); }
#endif
        STAMP(4);
#ifndef NO_FILT
        filterA_phase(F);
#endif
        STAMP(5); if (BOTH(1)) GRID_BAR(1); STAMP(6);
    }
    if (IN(2)) { filter_phase(F); if (DUP_SEL == 21) filter_phase(F); attn_memory_phase(F); if (DUP_SEL == 31) { F.woff = (long)(WS_OC - WS_MIX) / 2; attn_memory_phase(F); F.woff = 0; } STAMP(7); if (BOTH(2)) GRID_BAR(2); STAMP(8); }
    if (IN(3)) {
#define P3_HY() do { F.lane = lane_now(); F.tid = F.wave * 64 + F.lane; hyena_phase<7>(F); if (DUP_SEL == 15) hyena_phase<1>(F); if (DUP_SEL == 16) hyena_phase<2>(F); if (DUP_SEL == 18) hyena_phase<10>(F); if (DUP_SEL == 17) hyena_phase<4>(F); if (DUP_SEL == 34) hyena_phase<3>(F); STAMP(9); } while (0)
#define P3_AT() do { F.lane = lane_now(); F.tid = F.wave * 64 + F.lane; attn_dilated_phase<7>(F); if (DUP_SEL == 2) attn_dilated_phase<7>(F); if (DUP_SEL == 8) attn_dilated_phase<1>(F); if (DUP_SEL == 9) attn_dilated_phase<2>(F); if (DUP_SEL == 4) attn_dilated_phase<4>(F); STAMP(10); } while (0)
        if (F.vcu & 1) { P3_AT(); P3_HY(); } else { P3_HY(); P3_AT(); }
 if (BOTH(3)) GRID_BAR(3); STAMP(12); }
    if (IN(4)) { attn_combine_phase(F); STAMP(13); combine_phase(F); STAMP(14); if (DUP_SEL == 32) { F.woff = (long)(WS_Q - WS_MIX) / 2; combine_phase(F); F.woff = 0; } if (DUP_SEL == 33) { F.woff = (long)(WS_Q - WS_MIX) / 2; attn_combine_phase(F); F.woff = 0; } if (BOTH(4)) GRID_BAR(4); }
    if (IN(5)) {
        pg8::Gemm g{F.MIX, F.WTout, MT, DM, DM}; pg8::StaticOrder S; S.init(MT, DM, F.G, (int)blockIdx.x);
        float osc = 1.0f;
        if (TS_I >= 0) { const unsigned long long ta = __hip_atomic_load(tsb + (TS_I < 0 ? 0 : TS_I), RLX_AGENT), tb = __hip_atomic_load(tsb + (TS_J < 0 ? 0 : TS_J), RLX_AGENT); osc = 1.0f + (float)(((long long)(tb - ta) + 2500) / 5000) * 5e-3f; }
        pg8::EpiOut E{F.XB, F.RSTD, F.out, osc};
        pg8::gemm_phase<pg8::EpiOut, pg8::StaticOrder, true, true>(F.lds + RING_OFF, g, S, E);
        if (DUP_SEL == 3) pg8::gemm_phase<pg8::EpiOut, pg8::StaticOrder, true, true>(F.lds + RING_OFF, g, S, E);
        if (DUP_SEL == 5) { pg8::EpiNull E0; pg8::gemm_phase<pg8::EpiNull, pg8::StaticOrder, true, true>(F.lds + RING_OFF, g, S, E0); }
        if (DUP_SEL == 6) { pg8::EpiStoreOnly E1{(float*)(ws + WS_ZHY)}; pg8::gemm_phase<pg8::EpiStoreOnly, pg8::StaticOrder, true, true>(F.lds + RING_OFF, g, S, E1); }
    }
#undef IN
#undef BOTH
}

extern "C" void kernel_launch(void* const* d_in, const int* in_sizes, int n_in, void* d_out, int out_size, void* d_ws, size_t ws_size, hipStream_t stream) {
    static int grid = 0;
    if (grid == 0) {
        if (n_in != 23 || in_sizes[0] != MP * DM || out_size != MT * DM || ws_size < WS_END) { fprintf(stderr, "kernel_launch: unexpected shapes (n_in %d, in0 %d, out %d, ws %zu)\n", n_in, n_in > 0 ? in_sizes[0] : -1, out_size, ws_size); grid = -1; return; }
        int dev = 0, cus = 0;
        if (hipGetDevice(&dev) != hipSuccess || hipDeviceGetAttribute(&cus, hipDeviceAttributeMultiprocessorCount, dev) != hipSuccess) { grid = -1; return; }
        if (hipFuncSetAttribute((const void*)hymba_fwd, hipFuncAttributeMaxDynamicSharedMemorySize, LDS_BYTES) != hipSuccess) { fprintf(stderr, "kernel_launch: hipFuncSetAttribute failed\n"); grid = -1; return; }
        (void)hipGetLastError();
        grid = cus;
    }
    if (grid < 0) return;
    if (hipMemsetAsync((char*)d_ws + WS_CTL, 0, CTL_ZERO_BYTES, stream) != hipSuccess) return;
    Args a{};
    for (int i = 0; i < 23; ++i) a.in[i] = (const float*)d_in[i];
    a.out = (float*)d_out; a.ws = (unsigned char*)d_ws;
    for (int li = 0; li < N_LAUNCHES; ++li) {
        a.ph_lo = (N_LAUNCHES == PER_PHASE) ? li : 0; a.ph_hi = (N_LAUNCHES == PER_PHASE) ? li + 1 : PER_PHASE; a.li = li;
        hipLaunchKernelGGL(hymba_fwd, dim3(grid), dim3(NWAVES * 64), LDS_BYTES, stream, a);
        const hipError_t le = hipPeekAtLastError();
        if (le != hipSuccess) { fprintf(stderr, "kernel_launch: launch %d failed: %s\n", li, hipGetErrorName(le)); break; }
    }
}
```
